# Optimizing an MI355X kernel written in HIP

```python
import math
import jax
import jax.numpy as jnp
from jax import lax
import numpy as np

D_MODEL = 1024
BATCH = 8
SEQ = 4096
DEPTH = 4

GRID_W = 64
CTX_LEN = 256
D_MIX = D_MODEL
HY_W = D_MIX // 4
ATT_W = D_MIX // 2
S5_W = D_MIX - HY_W - ATT_W
HEAD_DIM = 64
N_HEADS = ATT_W // HEAD_DIM
N_KV_HEADS = 2
Q_PER_KV = N_HEADS // N_KV_HEADS
KV_W = N_KV_HEADS * HEAD_DIM
WINDOW = 128
QBLK = 128
KBLK = QBLK + 2 * WINDOW
ROPE_BASE = 10000.0
NEG_INF = -1e30
HY_ORDER = 2
HY_SHORT = 3
HY_BANDS = 16
HY_EMB = 1 + 2 * HY_BANDS
HY_FILTER_HIDDEN = 64
HY_DECAY_MIN = math.log(1e-2) / 1.5
HY_DECAY_MAX = math.log(1e-2) / 0.3
S5_CPG = 16
S5_GROUPS = S5_W // S5_CPG
S5_STATE = 64
S5_DT_MIN = 1e-3
S5_DT_MAX = 1e-1
N_EXPERTS = 16
N_EXPERT_GROUPS = 4
EXPERTS_PER_GROUP = N_EXPERTS // N_EXPERT_GROUPS
TOP_K = 2
D_EXPERT = 1024
MOE_BLK = 128
HY_END = 3 * HY_W
Q_END = HY_END + ATT_W
K_END = Q_END + KV_W
V_END = K_END + KV_W
IN_W = V_END + S5_W
EPS = 1e-6
F32 = jnp.float32

kernel_name = 'hybrid_hyena_swa_s5_moe_dit'


def rms_norm(x, g):
    xf = x.astype(F32)
    y = xf * lax.rsqrt(jnp.mean(xf * xf, axis=-1, keepdims=True) + EPS)
    return (y * g.astype(F32)).astype(x.dtype)


def group_rms_norm(parts, g):
    normed = []
    for p in parts:
        pf = p.astype(F32)
        normed.append(pf * lax.rsqrt(jnp.mean(pf * pf, axis=-1, keepdims=True) + EPS))
    return (jnp.concatenate(normed, axis=-1) * g.astype(F32)).astype(parts[0].dtype)


def modulate(h, shift, scale):
    return h * (1.0 + scale) + shift


def axial_rope(x, rows, cols):
    half = HEAD_DIM // 2
    quarter = half // 2
    inv_freq = ROPE_BASE ** (-jnp.arange(quarter, dtype=F32) / quarter)
    extra = (1,) * (x.ndim - 3)

    def rotate(xa, pos):
        ang = pos.astype(F32)[:, None] * inv_freq[None, :]
        cos = jnp.cos(ang).reshape((1, pos.shape[0]) + extra + (quarter,))
        sin = jnp.sin(ang).reshape((1, pos.shape[0]) + extra + (quarter,))
        x1 = xa[..., :quarter].astype(F32)
        x2 = xa[..., quarter:].astype(F32)
        return jnp.concatenate([x1 * cos - x2 * sin, x1 * sin + x2 * cos], axis=-1)

    out = jnp.concatenate([rotate(x[..., :half], rows), rotate(x[..., half:], cols)], axis=-1)
    return out.astype(x.dtype)


def short_conv(z, w, b):
    L = z.shape[1]
    pad = HY_SHORT // 2
    zp = jnp.pad(z, ((0, 0), (pad, pad), (0, 0)))
    out = b
    for j in range(HY_SHORT):
        out = out + zp[:, j:j + L] * w[j]
    return out


def hyena_filter_spectrum(L, w1, b1, freq1, w2, b2, freq2, w3):
    pos = jnp.arange(L, dtype=F32)
    t = pos / float(max(L - 1, 1))
    bands = jnp.linspace(1e-4, HY_BANDS - 1, HY_BANDS, dtype=F32)
    ang = (2.0 * math.pi / L) * pos[:, None] * bands[None, :]
    feats = jnp.concatenate([t[:, None], jnp.cos(ang), -jnp.sin(ang)], axis=-1)
    hid = jnp.sin(freq1.astype(F32) * (feats @ w1.astype(F32) + b1.astype(F32)))
    hid = jnp.sin(freq2.astype(F32) * (hid @ w2.astype(F32) + b2.astype(F32)))
    taps = (hid @ w3.astype(F32)).reshape(L, HY_ORDER, 2, HY_W)
    decay = jnp.abs(jnp.linspace(HY_DECAY_MIN, HY_DECAY_MAX, HY_W, dtype=F32))
    taps = taps * jnp.exp(-t[:, None, None, None] * decay)
    fwd = taps[:, :, 0]
    bwd = taps[:, :, 1]
    kern = jnp.concatenate([fwd, jnp.zeros((1, HY_ORDER, HY_W), F32), bwd[:0:-1]], axis=0)
    kern = kern / jnp.sum(jnp.abs(kern), axis=0, keepdims=True)
    return jnp.fft.rfft(kern, axis=0)


def fft_long_conv(u, spec, bias):
    L = u.shape[1]
    uf = jnp.fft.rfft(u.astype(F32), n=2 * L, axis=1)
    y = jnp.fft.irfft(uf * spec[None], n=2 * L, axis=1)[:, :L]
    return (y + u.astype(F32) * bias.astype(F32)).astype(u.dtype)


def hyena_mix(z, conv_w, conv_b, w1, b1, freq1, w2, b2, freq2, w3, bias):
    L = z.shape[1]
    z = short_conv(z, conv_w, conv_b)
    v, x1, x2 = jnp.split(z, 3, axis=-1)
    spec = hyena_filter_spectrum(L, w1, b1, freq1, w2, b2, freq2, w3)
    z1 = x1 * fft_long_conv(v, spec[:, 0], bias[0])
    return x2 * fft_long_conv(z1, spec[:, 1], bias[1])


def banded_attention(q, k, v, k_c, v_c, sink):
    B, N = q.shape[0], q.shape[1]
    C = k_c.shape[1]
    scale = HEAD_DIM ** -0.5
    kp = jnp.pad(k, ((0, 0), (WINDOW, WINDOW), (0, 0), (0, 0)))
    vp = jnp.pad(v, ((0, 0), (WINDOW, WINDOW), (0, 0), (0, 0)))
    sink_cols = jnp.broadcast_to(sink[None, :, :, None, None], (B, N_KV_HEADS, Q_PER_KV, QBLK, 1))

    def block(n):
        start = n * QBLK
        qb = lax.dynamic_slice_in_dim(q, start, QBLK, axis=1)
        kb = lax.dynamic_slice_in_dim(kp, start, KBLK, axis=1)
        vb = lax.dynamic_slice_in_dim(vp, start, KBLK, axis=1)
        s_loc = jnp.einsum('bqkgd,bskd->bkgqs', qb, kb).astype(F32) * scale
        s_ctx = jnp.einsum('bqkgd,bckd->bkgqc', qb, k_c).astype(F32) * scale
        q_pos = start + jnp.arange(QBLK)
        k_pos = start - WINDOW + jnp.arange(KBLK)
        valid = (jnp.abs(k_pos[None, :] - q_pos[:, None]) <= WINDOW) & (k_pos >= 0)[None, :] & (k_pos < N)[None, :]
        s_loc = jnp.where(valid, s_loc, NEG_INF)
        p = jax.nn.softmax(jnp.concatenate([s_loc, s_ctx, sink_cols], axis=-1), axis=-1)
        p_loc = p[..., :KBLK].astype(v.dtype)
        p_ctx = p[..., KBLK:KBLK + C].astype(v.dtype)
        return (jnp.einsum('bkgqs,bskd->bqkgd', p_loc, vb)
                + jnp.einsum('bkgqc,bckd->bqkgd', p_ctx, v_c))

    out = lax.map(block, jnp.arange(N // QBLK))
    return jnp.moveaxis(out, 0, 1).reshape(B, N, ATT_W)


def context_attention(q_c, k_c, v_c, sink):
    B, C = q_c.shape[0], q_c.shape[1]
    s = jnp.einsum('bqkgd,bckd->bkgqc', q_c, k_c).astype(F32) * (HEAD_DIM ** -0.5)
    sink_cols = jnp.broadcast_to(sink[None, :, :, None, None], s.shape[:-1] + (1,))
    p = jax.nn.softmax(jnp.concatenate([s, sink_cols], axis=-1), axis=-1)[..., :C].astype(v_c.dtype)
    return jnp.einsum('bkgqc,bckd->bqkgd', p, v_c).reshape(B, C, ATT_W)


def s5_discretize(lam_re, lam_im, log_dt, b_re, b_im):
    lam_re = lam_re.astype(F32)
    lam_im = lam_im.astype(F32)
    b_re = b_re.astype(F32)
    b_im = b_im.astype(F32)
    dt = jnp.exp(log_dt.astype(F32))[:, None]
    mag = jnp.exp(lam_re * dt)
    ab_re = mag * jnp.cos(lam_im * dt)
    ab_im = mag * jnp.sin(lam_im * dt)
    num_re = ab_re - 1.0
    num_im = ab_im
    den = lam_re * lam_re + lam_im * lam_im
    co_re = ((num_re * lam_re + num_im * lam_im) / den)[..., None]
    co_im = ((num_im * lam_re - num_re * lam_im) / den)[..., None]
    bb_re = co_re * b_re - co_im * b_im
    bb_im = co_re * b_im + co_im * b_re
    return ab_re, ab_im, bb_re, bb_im


def s5_combine(e1, e2):
    a1r, a1i, b1r, b1i = e1
    a2r, a2i, b2r, b2i = e2
    return (a1r * a2r - a1i * a2i,
            a1r * a2i + a1i * a2r,
            a2r * b1r - a2i * b1i + b2r,
            a2r * b1i + a2i * b1r + b2i)


def s5_scan(u, ab_re, ab_im, bb_re, bb_im, h0_re, h0_im):
    L = u.shape[0]
    bu_re = jnp.einsum('lbgc,gpc->lbgp', u, bb_re)
    bu_im = jnp.einsum('lbgc,gpc->lbgp', u, bb_im)
    bu_re = bu_re.at[0].add(ab_re * h0_re - ab_im * h0_im)
    bu_im = bu_im.at[0].add(ab_re * h0_im + ab_im * h0_re)
    a_re = jnp.broadcast_to(ab_re[None, None], (L, 1, S5_GROUPS, S5_STATE))
    a_im = jnp.broadcast_to(ab_im[None, None], (L, 1, S5_GROUPS, S5_STATE))
    _, _, s_re, s_im = lax.associative_scan(s5_combine, (a_re, a_im, bu_re, bu_im), axis=0)
    return s_re, s_im


def s5_readout(s_re, s_im, c_re, c_im):
    return (jnp.einsum('lbgp,gcp->lbgc', s_re, c_re.astype(F32))
            - jnp.einsum('lbgp,gcp->lbgc', s_im, c_im.astype(F32)))


def s5_output(y, u, d_skip, glu_w, glu_b):
    Lq, B = y.shape[0], y.shape[1]
    y = y + u * d_skip.astype(F32).reshape(S5_GROUPS, S5_CPG)
    y = jnp.swapaxes(y, 0, 1).reshape(B, Lq, S5_W)
    g = jax.nn.gelu(y)
    return g * jax.nn.sigmoid(g @ glu_w.astype(F32) + glu_b.astype(F32))


def flip_time(a, rev):
    return a[::-1] if rev else a


def s5_mix(u_ctx, u_lat, lam_re, lam_im, log_dt, b_re, b_im, c_re, c_im, d_skip, glu_w, glu_b, with_ctx):
    B = u_lat.shape[0]

    def time_major(u):
        return jnp.swapaxes(u.astype(F32).reshape(B, u.shape[1], S5_GROUPS, S5_CPG), 0, 1)

    uc = time_major(u_ctx)
    ul = time_major(u_lat)
    zero = jnp.zeros((B, S5_GROUPS, S5_STATE), F32)
    y_lat = 0.0
    y_ctx = 0.0
    for d in range(2):
        rev = d == 1
        ab_re, ab_im, bb_re, bb_im = s5_discretize(lam_re[d], lam_im[d], log_dt[d], b_re[d], b_im[d])
        sc_re, sc_im = s5_scan(flip_time(uc, rev), ab_re, ab_im, bb_re, bb_im, zero, zero)
        sl_re, sl_im = s5_scan(flip_time(ul, rev), ab_re, ab_im, bb_re, bb_im, sc_re[-1], sc_im[-1])
        y_lat = y_lat + flip_time(s5_readout(sl_re, sl_im, c_re[d], c_im[d]), rev)
        if with_ctx:
            y_ctx = y_ctx + flip_time(s5_readout(sc_re, sc_im, c_re[d], c_im[d]), rev)
    lat = s5_output(y_lat, ul, d_skip, glu_w, glu_b).astype(u_lat.dtype)
    ctx_out = s5_output(y_ctx, uc, d_skip, glu_w, glu_b).astype(u_ctx.dtype) if with_ctx else None
    return lat, ctx_out


def hybrid_mixer(h, hc, w_in_l, conv_w, conv_b, f_w1, f_b1, f_freq1, f_w2, f_b2, f_freq2, f_w3, hy_bias_l,
                 sink, lam_re, lam_im, log_dt, b_re, b_im, c_re, c_im, d_skip, glu_w, glu_b, out_g,
                 rows, cols, with_ctx):
    def heads_q(a):
        return a.reshape(a.shape[0], a.shape[1], N_KV_HEADS, Q_PER_KV, HEAD_DIM)

    def heads_kv(a):
        return a.reshape(a.shape[0], a.shape[1], N_KV_HEADS, HEAD_DIM)

    p = h @ w_in_l
    if with_ctx:
        pc = hc @ w_in_l
        kvs_c = pc[..., Q_END:]
    else:
        kvs_c = hc @ w_in_l[:, Q_END:]
    k_c = heads_kv(kvs_c[..., :KV_W])
    v_c = heads_kv(kvs_c[..., KV_W:2 * KV_W])
    u_c = kvs_c[..., 2 * KV_W:]
    sink_kg = sink.astype(F32).reshape(N_KV_HEADS, Q_PER_KV)

    hy = hyena_mix(p[..., :HY_END], conv_w, conv_b, f_w1, f_b1, f_freq1, f_w2, f_b2, f_freq2, f_w3, hy_bias_l)
    q = axial_rope(heads_q(p[..., HY_END:Q_END]), rows, cols)
    k = axial_rope(heads_kv(p[..., Q_END:K_END]), rows, cols)
    v = heads_kv(p[..., K_END:V_END])
    att = banded_attention(q, k, v, k_c, v_c, sink_kg)
    s5_lat, s5_ctx = s5_mix(u_c, p[..., V_END:], lam_re, lam_im, log_dt, b_re, b_im, c_re, c_im,
                            d_skip, glu_w, glu_b, with_ctx)
    lat = group_rms_norm([hy, att, s5_lat], out_g)
    if not with_ctx:
        return lat, None
    hy_c = hyena_mix(pc[..., :HY_END], conv_w, conv_b, f_w1, f_b1, f_freq1, f_w2, f_b2, f_freq2, f_w3, hy_bias_l)
    att_c = context_attention(heads_q(pc[..., HY_END:Q_END]), k_c, v_c, sink_kg)
    ctx_out = group_rms_norm([hy_c, att_c, s5_ctx], out_g)
    return lat, ctx_out


def moe_ffn(h, router_w, router_b, w_gate, w_up, w_down):
    T, D = h.shape
    probs = jax.nn.softmax(jnp.dot(h.astype(F32), router_w.astype(F32)), axis=-1)
    sel = (probs + router_b.astype(F32)).reshape(T, N_EXPERT_GROUPS, EXPERTS_PER_GROUP)
    group_score = jnp.sum(lax.top_k(sel, 2)[0], axis=-1)
    g_idx = jnp.argmax(group_score, axis=-1)
    in_group = sel[jnp.arange(T), g_idx]
    _, local = lax.top_k(in_group, TOP_K)
    e_idx = g_idx[:, None] * EXPERTS_PER_GROUP + local
    gates = jnp.take_along_axis(probs, e_idx, axis=1)
    gates = gates / jnp.sum(gates, axis=-1, keepdims=True)
    M = T * TOP_K
    flat_e = e_idx.reshape(-1)
    flat_t = jnp.repeat(jnp.arange(T), TOP_K)
    flat_w = gates.reshape(-1)
    order = jnp.argsort(flat_e)
    se, st, sw = flat_e[order], flat_t[order], flat_w[order]
    counts = jnp.bincount(flat_e, length=N_EXPERTS)
    starts = jnp.cumsum(counts) - counts
    padded = (counts + MOE_BLK - 1) // MOE_BLK * MOE_BLK
    ends = jnp.cumsum(padded)
    pstarts = ends - padded
    dest = pstarts[se] + (jnp.arange(M) - starts[se])
    n_blocks = -(-M // MOE_BLK) + N_EXPERTS
    row_tok = jnp.zeros((n_blocks * MOE_BLK,), jnp.int32).at[dest].set(st)
    row_w = jnp.zeros((n_blocks * MOE_BLK,), F32).at[dest].set(sw)
    block_e = jnp.clip(jnp.searchsorted(ends, jnp.arange(n_blocks) * MOE_BLK, side='right'), 0, N_EXPERTS - 1)
    xb = h[row_tok].reshape(n_blocks, MOE_BLK, D)

    def expert_block(args):
        xblk, e = args
        a = xblk @ w_gate[e]
        u = xblk @ w_up[e]
        return (jax.nn.silu(a) * u) @ w_down[e]

    yb = lax.map(expert_block, (xb, block_e)).reshape(n_blocks * MOE_BLK, D)
    yb = yb * row_w[:, None].astype(yb.dtype)
    return jnp.zeros_like(h).at[row_tok].add(yb)


def setup_inputs(seed: int = 0) -> dict:
    key = jax.random.key(seed)
    ks = iter(jax.random.split(key, 40))

    def nrm(shape, s):
        return jax.random.normal(next(ks), shape, F32) * s

    L = DEPTH
    lam_im_base = jnp.broadcast_to(math.pi * jnp.arange(S5_STATE, dtype=F32), (L, 2, S5_GROUPS, S5_STATE))
    return {
        'x': nrm((BATCH, SEQ, D_MODEL), 1.0),
        'c': nrm((BATCH, D_MODEL), 1.0),
        'ctx': nrm((BATCH, CTX_LEN, D_MODEL), 1.0),
        'c_ctx': nrm((D_MODEL,), 1.0),
        'norm1_g': 1.0 + nrm((L, D_MODEL), 0.02),
        'norm2_g': 1.0 + nrm((L, D_MODEL), 0.02),
        'ada_w': nrm((L, D_MODEL, 6 * D_MODEL), 0.01),
        'ada_b': nrm((L, 6 * D_MODEL), 0.02),
        'w_in': nrm((L, D_MODEL, IN_W), D_MODEL ** -0.5),
        'w_out': nrm((L, D_MIX, D_MODEL), D_MIX ** -0.5),
        'mix_norm_g': 1.0 + nrm((L, D_MIX), 0.02),
        'hy_conv_w': nrm((L, HY_SHORT, 3 * HY_W), HY_SHORT ** -0.5),
        'hy_conv_b': nrm((L, 3 * HY_W), 0.02),
        'hy_f_w1': nrm((L, HY_EMB, HY_FILTER_HIDDEN), HY_EMB ** -0.5),
        'hy_f_b1': nrm((L, HY_FILTER_HIDDEN), 0.1),
        'hy_f_freq1': 1.0 + nrm((L, HY_FILTER_HIDDEN), 0.02),
        'hy_f_w2': nrm((L, HY_FILTER_HIDDEN, HY_FILTER_HIDDEN), HY_FILTER_HIDDEN ** -0.5),
        'hy_f_b2': nrm((L, HY_FILTER_HIDDEN), 0.1),
        'hy_f_freq2': 1.0 + nrm((L, HY_FILTER_HIDDEN), 0.02),
        'hy_f_w3': nrm((L, HY_FILTER_HIDDEN, HY_ORDER * 2 * HY_W), HY_FILTER_HIDDEN ** -0.5),
        'hy_bias': nrm((L, HY_ORDER, HY_W), 1.0),
        'attn_sink': nrm((L, N_HEADS), 0.5),
        's5_lam_re': -0.5 + nrm((L, 2, S5_GROUPS, S5_STATE), 0.01),
        's5_lam_im': lam_im_base + nrm((L, 2, S5_GROUPS, S5_STATE), 0.01),
        's5_log_dt': jax.random.uniform(next(ks), (L, 2, S5_GROUPS), F32,
                                        minval=math.log(S5_DT_MIN), maxval=math.log(S5_DT_MAX)),
        's5_b_re': nrm((L, 2, S5_GROUPS, S5_STATE, S5_CPG), (2 * S5_CPG) ** -0.5),
        's5_b_im': nrm((L, 2, S5_GROUPS, S5_STATE, S5_CPG), (2 * S5_CPG) ** -0.5),
        's5_c_re': nrm((L, 2, S5_GROUPS, S5_CPG, S5_STATE), (2 * S5_STATE) ** -0.5),
        's5_c_im': nrm((L, 2, S5_GROUPS, S5_CPG, S5_STATE), (2 * S5_STATE) ** -0.5),
        's5_d': nrm((L, S5_W), 1.0),
        's5_glu_w': nrm((L, S5_W, S5_W), S5_W ** -0.5),
        's5_glu_b': nrm((L, S5_W), 0.02),
        'router_w': nrm((D_MODEL, N_EXPERTS), D_MODEL ** -0.5),
        'router_b': nrm((N_EXPERTS,), 0.01),
        'moe_w_gate': nrm((L, N_EXPERTS, D_MODEL, D_EXPERT), D_MODEL ** -0.5),
        'moe_w_up': nrm((L, N_EXPERTS, D_MODEL, D_EXPERT), D_MODEL ** -0.5),
        'moe_w_down': nrm((L, N_EXPERTS, D_EXPERT, D_MODEL), D_EXPERT ** -0.5),
        'final_g': 1.0 + nrm((D_MODEL,), 0.02),
    }


def reference(x, c, ctx, c_ctx, norm1_g, norm2_g, ada_w, ada_b, w_in, w_out, mix_norm_g,
              hy_conv_w, hy_conv_b, hy_f_w1, hy_f_b1, hy_f_freq1, hy_f_w2, hy_f_b2, hy_f_freq2, hy_f_w3, hy_bias,
              attn_sink, s5_lam_re, s5_lam_im, s5_log_dt, s5_b_re, s5_b_im, s5_c_re, s5_c_im, s5_d,
              s5_glu_w, s5_glu_b, router_w, router_b, moe_w_gate, moe_w_up, moe_w_down, final_g):
    B, N, D = x.shape
    C = ctx.shape[1]
    ROWS = N // GRID_W
    rows = jnp.repeat(jnp.arange(ROWS), GRID_W)
    cols = jnp.tile(jnp.arange(GRID_W), ROWS)
    xc = ctx
    for l in range(DEPTH):
        with_ctx = l < DEPTH - 1
        mod = jax.nn.silu(c) @ ada_w[l] + ada_b[l]
        mod_c = jax.nn.silu(c_ctx) @ ada_w[l] + ada_b[l]
        sh1, sc1, g1, sh2, sc2, g2 = jnp.split(mod[:, None, :], 6, axis=-1)
        csh1, csc1, cg1, csh2, csc2, cg2 = jnp.split(mod_c, 6)
        h = modulate(rms_norm(x, norm1_g[l]), sh1, sc1)
        hc = modulate(rms_norm(xc, norm1_g[l]), csh1, csc1)
        mix, mix_c = hybrid_mixer(h, hc, w_in[l], hy_conv_w[l], hy_conv_b[l], hy_f_w1[l], hy_f_b1[l],
                                  hy_f_freq1[l], hy_f_w2[l], hy_f_b2[l], hy_f_freq2[l], hy_f_w3[l], hy_bias[l],
                                  attn_sink[l], s5_lam_re[l], s5_lam_im[l], s5_log_dt[l], s5_b_re[l], s5_b_im[l],
                                  s5_c_re[l], s5_c_im[l], s5_d[l], s5_glu_w[l], s5_glu_b[l], mix_norm_g[l],
                                  rows, cols, with_ctx)
        x = x + g1 * (mix @ w_out[l])
        h2 = modulate(rms_norm(x, norm2_g[l]), sh2, sc2)
        if with_ctx:
            xc = xc + cg1 * (mix_c @ w_out[l])
            hc2 = modulate(rms_norm(xc, norm2_g[l]), csh2, csc2)
            tokens = jnp.concatenate([hc2.reshape(B * C, D), h2.reshape(B * N, D)], axis=0)
            y = moe_ffn(tokens, router_w, router_b, moe_w_gate[l], moe_w_up[l], moe_w_down[l])
            xc = xc + cg2 * y[:B * C].reshape(B, C, D)
            x = x + g2 * y[B * C:].reshape(B, N, D)
        else:
            y = moe_ffn(h2.reshape(B * N, D), router_w, router_b, moe_w_gate[l], moe_w_up[l], moe_w_down[l])
            x = x + g2 * y.reshape(B, N, D)
    return rms_norm(x, final_g)
```

```cpp
#include <hip/hip_runtime.h>
#include <stdio.h>
#include <stdint.h>

#ifndef MK_ONE_LAUNCH
#define MK_ONE_LAUNCH 0
#endif

#define GAS __attribute__((address_space(1)))
#define LAS __attribute__((address_space(3)))
typedef unsigned short bf16;
typedef short bf16x8 __attribute__((ext_vector_type(8)));
typedef float f32x2 __attribute__((ext_vector_type(2)));
typedef float f32x4 __attribute__((ext_vector_type(4)));
typedef float f32x16 __attribute__((ext_vector_type(16)));
typedef unsigned u32x2 __attribute__((ext_vector_type(2)));
typedef unsigned u32x4 __attribute__((ext_vector_type(4)));

constexpr int D = 1024, NB = 8, SEQ = 4096, CTXL = 256, DEPTH = 4;
constexpr int NCTX = NB * CTXL, NLAT = NB * SEQ, NTOK = NCTX + NLAT;
constexpr int INW = 1792, HY_END = 768, Q_END = 1280, K_END = 1408, V_END = 1536;
constexpr int NEXP = 16, ECAP = NTOK;
constexpr int XG_ROWS = 2 * NTOK + NEXP * 256;
constexpr float EPS = 1e-6f;
constexpr int NCH = 136;

constexpr size_t MiB = 1u << 20;
constexpr size_t WS_CTL = 0, CTL_BYTES = 1 * MiB;
constexpr size_t WS_WIN = 1 * MiB, WS_WOUT = 15 * MiB, WS_WMOE = 23 * MiB, WS_MOD = 119 * MiB, WS_TG = 120 * MiB, WS_TGC = 152 * MiB, WS_S5T = 154 * MiB;
constexpr size_t WS_XS = 156 * MiB, WS_H = 292 * MiB, WS_LOC = 360 * MiB, WS_SPREV = 377 * MiB, WS_S5Y = 394 * MiB, WS_ELIST = 411 * MiB, WS_WLIST = 414 * MiB, WS_HYC = 417 * MiB;
constexpr size_t WS_U = 418 * MiB;
constexpr size_t U_XG = 0, U_ACT = 144 * MiB, U_YB = 288 * MiB;
constexpr size_t U_P = 0, U_QR = 119 * MiB, U_KR = 153 * MiB, U_HV = 162 * MiB, U_HX1 = 178 * MiB, U_HX2 = 194 * MiB, U_Z1T = 210 * MiB, U_HYT = 226 * MiB, U_ATT = 242 * MiB, U_MIXN = 276 * MiB;
constexpr size_t U_RAWL = 0, U_RAWC = 64 * MiB, U_PART = 68 * MiB;
constexpr size_t WS_END = WS_U + 424 * MiB;
constexpr size_t S5_BBT = 0, S5_CMT = 512 * 1024, S5_AB = 1024 * 1024, S5_A32 = 1088 * 1024, S5_GLUT = 1152 * 1024, S5_ROPE = 1664 * 1024;
constexpr int CW_BAR = 4096, CW_WQ = 8192, CW_CNT = 16384, CW_NORM = 32768;

constexpr int LDS_BYTES = 163840;
constexpr int LDS_MISC = LDS_BYTES - 64;

__device__ __forceinline__ unsigned f2bf(float f) { unsigned u = __builtin_bit_cast(unsigned, f); return (u + 0x7fffu + ((u >> 16) & 1u)) >> 16; }
__device__ __forceinline__ unsigned pk2(float lo, float hi) { return f2bf(lo) | (f2bf(hi) << 16); }
__device__ __forceinline__ float bf2f(unsigned b) { return __builtin_bit_cast(float, b << 16); }
__device__ __forceinline__ float bflo(unsigned w) { return __builtin_bit_cast(float, w << 16); }
__device__ __forceinline__ float bfhi(unsigned w) { return __builtin_bit_cast(float, w & 0xffff0000u); }
__device__ __forceinline__ float lane_xor(float v, int lane, int o) { return __builtin_bit_cast(float, __builtin_amdgcn_ds_bpermute((lane ^ o) << 2, __builtin_bit_cast(int, v))); }
__device__ __forceinline__ float wave_sum(float v, int lane) {
#pragma unroll
    for (int o = 1; o < 64; o <<= 1) v += lane_xor(v, lane, o);
    return v;
}
__device__ __forceinline__ f32x16 zero16() { f32x16 z;
#pragma unroll
    for (int r = 0; r < 16; ++r) z[r] = 0.f;
    asm volatile("" : "+v"(z)); return z; }
__device__ __forceinline__ f32x4 zero4() { f32x4 z = (f32x4){0.f, 0.f, 0.f, 0.f}; asm volatile("" : "+v"(z)); return z; }
#define LDS_WAIT() asm volatile("s_waitcnt lgkmcnt(0)" ::: "memory")
#define VM_WAIT() asm volatile("s_waitcnt vmcnt(0)" ::: "memory")

#define XB_TMO      128
#define XB_XCNT(j)  (256  + 64 * (j))
#define XB_XSUB(j)  (1280 + 64 * (j))
#define XB_XGEN(j)  (2304 + 64 * (j))
#define XB_TOP      3328
#define XB_TOPGEN   3392
#define XCD_BAR_WORDS 3456
#define XB_SPIN_CAP (1u << 18)

__device__ __forceinline__ unsigned xb_ld(unsigned* p)              { return __hip_atomic_load(p, __ATOMIC_RELAXED, __HIP_MEMORY_SCOPE_AGENT); }
__device__ __forceinline__ unsigned xb_add(unsigned* p, unsigned v) { return __hip_atomic_fetch_add(p, v, __ATOMIC_RELAXED, __HIP_MEMORY_SCOPE_AGENT); }
__device__ __forceinline__ unsigned xb_xcc_id() { return (unsigned)__builtin_amdgcn_s_getreg((3 << 11) | 20) & 0xFu; }
#define XB_SPIN(cond, bar) do { unsigned _sp = 0; while (cond) { __builtin_amdgcn_s_sleep(1); \
    if ((++_sp & 255u) == 0u) { if (xb_ld(&(bar)[XB_TMO])) break; if (_sp > XB_SPIN_CAP) { atomicAdd(&(bar)[XB_TMO], 1u); break; } } } } while (0)

struct XcdBarrier {
    unsigned* bar; unsigned x;
    volatile LAS unsigned* st;
};

__device__ __forceinline__ XcdBarrier xcd_barrier_post(unsigned* bar, volatile LAS unsigned* st) {
    XcdBarrier b; b.bar = bar; b.x = xb_xcc_id(); b.st = st;
    if (threadIdx.x == 0) (void)xb_add(&bar[XB_XCNT(b.x)], 1u);
    return b;
}
__device__ __forceinline__ void xcd_barrier_complete(unsigned* bar, unsigned x, unsigned& nloc, unsigned& nx) {
    const unsigned G = gridDim.x * gridDim.y * gridDim.z;
    unsigned sum, cnt, mine, sp = 0u;
    for (;;) {
        sum = 0u; cnt = 0u; mine = 0u;
#pragma unroll
        for (unsigned j = 0; j < 16; ++j) { const unsigned c = xb_ld(&bar[XB_XCNT(j)]); sum += c; cnt += (c > 0u) ? 1u : 0u; mine = (j == x) ? c : mine; }
        if (sum == G) break;
        __builtin_amdgcn_s_sleep(1);
        if ((++sp & 255u) == 0u) { if (xb_ld(&bar[XB_TMO])) break; if (sp > XB_SPIN_CAP) { atomicAdd(&bar[XB_TMO], 1u); break; } }
    }
    nloc = mine > 0u ? mine : 1u; nx = cnt > 0u ? cnt : 1u;
}

__device__ __forceinline__ void xcd_barrier(const XcdBarrier& b) {
    asm volatile("s_waitcnt vmcnt(0)" ::: "memory");
    __syncthreads();
    if (threadIdx.x == 0) {
        unsigned* bar = b.bar;
        __builtin_amdgcn_s_waitcnt(0);
        unsigned nloc = b.st[0], nx = b.st[1];
        if (nloc == 0u) { xcd_barrier_complete(bar, b.x, nloc, nx); b.st[0] = nloc; b.st[1] = nx; }
        const unsigned old = xb_add(&bar[XB_XSUB(b.x)], 1u);
        const unsigned gen = old / nloc;
        if (old + 1u == (gen + 1u) * nloc) {
            __builtin_amdgcn_fence(__ATOMIC_RELEASE, "agent");
            asm volatile("s_waitcnt vmcnt(0)" ::: "memory");
            const unsigned og = xb_add(&bar[XB_TOP], 1u);
            const unsigned tg = og / nx;
            if (og + 1u == (tg + 1u) * nx) xb_add(&bar[XB_TOPGEN], 1u);
            else XB_SPIN(xb_ld(&bar[XB_TOPGEN]) == tg, bar);
            __builtin_amdgcn_fence(__ATOMIC_ACQUIRE, "agent");
            xb_add(&bar[XB_XGEN(b.x)], 1u);
            asm volatile("s_waitcnt vmcnt(0)" ::: "memory");
        } else {
            XB_SPIN(xb_ld(&bar[XB_XGEN(b.x)]) == gen, bar);
            __builtin_amdgcn_fence(__ATOMIC_ACQUIRE, "agent");
            asm volatile("s_waitcnt vmcnt(0)" ::: "memory");
        }
    }
    __syncthreads();
}

struct Params { const float* in[38]; float* out; unsigned char* ws; int ph_lo, ph_hi; };
enum { I_X = 0, I_C, I_CTX, I_CCTX, I_N1G, I_N2G, I_ADAW, I_ADAB, I_WIN, I_WOUT, I_MIXG, I_HCW, I_HCB, I_HW1, I_HB1, I_HF1, I_HW2, I_HB2, I_HF2, I_HW3, I_HBIAS, I_SINK,
       I_LRE, I_LIM, I_LDT, I_BRE, I_BIM, I_CRE, I_CIM, I_S5D, I_GLUW, I_GLUB, I_RW, I_RB, I_WG, I_WU, I_WD, I_FG };

struct Frame {
    LAS unsigned char* lds;
    unsigned* ctl;
    unsigned char* ws;
    const float* const* in;
    float* out;
    int tid, lane, wave, G, bid, z;
};

#define LAUNDER(F) do { asm volatile("s_mov_b32 %0, 0" : "=s"((F).z)); asm volatile("" : "+s"((F).ws), "+s"((F).lds), "+v"((F).tid), "+v"((F).lane)); (F).ctl = (unsigned*)((F).ws + WS_CTL); } while (0)
__device__ __forceinline__ int wq_next(Frame& F, int qid) {
    volatile LAS unsigned* m = (volatile LAS unsigned*)(F.lds + LDS_MISC);
    __syncthreads();
    if (F.tid == 0) m[4] = __hip_atomic_fetch_add(F.ctl + CW_WQ + 64 * qid, 1u, __ATOMIC_RELAXED, __HIP_MEMORY_SCOPE_AGENT);
    __syncthreads();
    return __builtin_amdgcn_readfirstlane((int)m[4]);
}
namespace pg8 {
#define PG8_LAS __attribute__((address_space(3)))
typedef unsigned short bf16_t;
constexpr int BM = 256, BK = 64, HALF = 128, HTB = HALF * BK * 2  , STAGE_BYTES = 8 * HTB, NXCD = 8, WGM = 8;
constexpr size_t ROWB = 2048;

__host__ __device__ __forceinline__ int lds_byte(int r, int c) { const int st = (r >> 4) * 2 + (c >> 5), rr = r & 15, cc = c & 31, ob = rr * 64 + cc * 2; return st * 1024 + (ob ^ (((ob >> 9) & 1) << 5)); }
__host__ __device__ __forceinline__ void stage_rc(int b, int& R, int& C) { const int st = b / 1024, sb = b % 1024, swz = sb ^ (((sb >> 9) & 1) << 5); R = (st >> 1) * 16 + swz / 64; C = (st & 1) * 32 + (swz % 64) / 2; }
__host__ __device__ __forceinline__ int perm32(int rho) { const int n = rho >> 4, i = rho & 15; return 8 * (i >> 2) + 4 * n + (i & 3); }

struct Unit { const char* A; const char* B0; const char* B1; int i0, i1, i2, i3; };

struct StaticOrder {
    int nM, nN, nwg, G, c;
    __device__ void init(int M, int N, int G_, int c_) { nM = M / BM; nN = N / BM; nwg = nM * nN; G = G_; c = c_; }
    __device__ bool next(int i, int& pm, int& pn) const {
        const long L = (long)i * G + c; if (L >= nwg) return false;
        int wgid = (int)L; { const int q = nwg / NXCD, r = nwg % NXCD, xcd = wgid % NXCD, off = wgid / NXCD; wgid = (xcd < r ? xcd * (q + 1) : r * (q + 1) + (xcd - r) * q) + off; }
        const int nig = WGM * nN, gid = wgid / nig, fm = gid * WGM, gsz = (nM - fm) < WGM ? (nM - fm) : WGM;
        pm = fm + ((wgid % nig) % gsz); pn = (wgid % nig) / gsz; return true;
    }
};
__device__ __forceinline__ unsigned cvt_pk_bf16(float lo, float hi) { unsigned r; asm volatile("v_cvt_pk_bf16_f32 %0, %1, %2" : "=v"(r) : "v"(lo), "v"(hi)); return r; }

template <class Epi, class Sched>
__device__ __forceinline__ void gemm_phase(PG8_LAS unsigned char* lds, const Sched& S, const Epi& E, const int tid) {
    constexpr bool STAMP = false; unsigned long long* stamps = nullptr;
    const int wid = __builtin_amdgcn_readfirstlane(tid >> 6), lane = tid & 63, wr = wid >> 2, wc = wid & 3, fr = lane & 15, fq = lane >> 4;
    constexpr int K = 1024, nt = K / BK;
    int ts_lo = 0, ts_hi = 0, nts = 0; const unsigned long long rt_entry = STAMP ? (unsigned long long)wall_clock64() : 0ull;
#define PG8_STAMP() do { if (STAMP && wid == 0 && nts < 64) { const unsigned long long _c = (unsigned long long)clock64(); \
        ts_lo = (lane == nts) ? (int)(unsigned)_c : ts_lo; ts_hi = (lane == nts) ? (int)(unsigned)(_c >> 32) : ts_hi; ++nts; } } while (0)
    PG8_STAMP();
    unsigned voffA[2], voffB[2];
#pragma unroll
    for (int i = 0; i < 2; ++i) { int R, C; stage_rc(tid * 16 + i * 8192, R, C); const int Rb = Epi::PERM ? ((R & ~31) + perm32(R & 31)) : R;
        voffA[i] = (unsigned)(R * K + C) * 2u; voffB[i] = (unsigned)(Rb * K + C) * 2u; }
    const size_t kstep = (size_t)(BK * 2);
    const size_t hstep = (size_t)HALF * K * 2;
    const unsigned ldsw = (unsigned)wid * 1024u;
    const int aoff = lds_byte(wr * 64 + fr, fq * 8), boff = lds_byte(wc * 32 + fr, fq * 8);
#define PG8_SA(b, h) (((b) * 2 + (h)) * HTB)
#define PG8_SB(b, h) ((4 + (b) * 2 + (h)) * HTB)
#define PG8_STAGE(bufoff, gbase, voff) do { _Pragma("unroll") for (int _i = 0; _i < 2; ++_i) \
        __builtin_amdgcn_global_load_lds((const unsigned*)((const char*)(gbase) + (voff)[_i]), (PG8_LAS unsigned*)(lds + (bufoff) + ldsw + _i * 8192), 16, 0, 0); } while (0)
#define PG8_LDA(dst, b, h) do { _Pragma("unroll") for (int m = 0; m < 4; ++m) _Pragma("unroll") for (int k = 0; k < 2; ++k) dst[m][k] = *(const PG8_LAS bf16x8*)(lds + PG8_SA(b, h) + aoff + m * 2048 + k * 1024); } while (0)
#define PG8_LDB(dst, b, h) do { _Pragma("unroll") for (int n = 0; n < 2; ++n) _Pragma("unroll") for (int k = 0; k < 2; ++k) dst[n][k] = *(const PG8_LAS bf16x8*)(lds + PG8_SB(b, h) + boff + n * 2048 + k * 1024); } while (0)
#define PG8_MMA(ai, bj, At, Bt) do { __builtin_amdgcn_s_setprio(1); _Pragma("unroll") for (int m = 0; m < 4; ++m) _Pragma("unroll") for (int n = 0; n < 2; ++n) _Pragma("unroll") for (int k = 0; k < 2; ++k) \
        acc[ai][bj][m][n] = __builtin_amdgcn_mfma_f32_16x16x32_bf16(Bt[n][k], At[m][k], acc[ai][bj][m][n], 0, 0, 0); __builtin_amdgcn_s_setprio(0); } while (0)
#define PG8_WAIT_V(n) asm volatile("s_waitcnt vmcnt(" #n ")" ::: "memory")
#define PG8_WAIT_L(n) asm volatile("s_waitcnt lgkmcnt(" #n ")" ::: "memory")
#define PG8_BAR __builtin_amdgcn_s_barrier()
#define PG8_SCHED __builtin_amdgcn_sched_barrier(0)
    Unit cur, nxt; int ui = 0;
    if (!S.next(0, cur)) return;
    f32x4 acc[2][2][4][2];
#pragma unroll
    for (int a = 0; a < 2; ++a)
#pragma unroll
        for (int b = 0; b < 2; ++b)
#pragma unroll
            for (int m = 0; m < 4; ++m)
#pragma unroll
                for (int n = 0; n < 2; ++n) acc[a][b][m][n] = (f32x4){0.f, 0.f, 0.f, 0.f};
    bf16x8 At[4][2], B0[2][2], B1[2][2];
    const char* cA = cur.A; const char* cB0 = cur.B0; const char* cB1 = cur.B1;
    S.a_ready(cur);
    PG8_STAGE(PG8_SB(0, 0), cB0, voffB); PG8_STAGE(PG8_SA(0, 0), cA, voffA); PG8_STAGE(PG8_SB(0, 1), cB1, voffB); PG8_STAGE(PG8_SA(0, 1), cA + hstep, voffA);
    if (wr == 1) PG8_BAR;
    PG8_WAIT_V(4); PG8_BAR;
    PG8_STAGE(PG8_SB(1, 0), cB0 + kstep, voffB); PG8_STAGE(PG8_SA(1, 0), cA + kstep, voffA); PG8_STAGE(PG8_SB(1, 1), cB1 + kstep, voffB);
    PG8_WAIT_V(6); PG8_BAR;
    PG8_STAMP();
    for (;;) {
        const bool has_next = S.next(ui + 1, nxt);
        const char* nA = has_next ? nxt.A : cA; const char* nB0 = has_next ? nxt.B0 : cB0; const char* nB1 = has_next ? nxt.B1 : cB1;
        for (int t = 0; t < nt; t += 2) {
            const bool last = (t == nt - 2);
            const char* a1 = cA + (size_t)(t + 1) * kstep;
            const char* a2 = last ? nA : cA + (size_t)(t + 2) * kstep; const char* b2 = last ? nB0 : cB0 + (size_t)(t + 2) * kstep; const char* c2 = last ? nB1 : cB1 + (size_t)(t + 2) * kstep;
            const char* a3 = a2 + kstep; const char* b3 = b2 + kstep; const char* c3 = c2 + kstep;
            if (last && has_next) S.a_ready(nxt);
            PG8_LDB(B0, 0, 0); PG8_SCHED; PG8_LDA(At, 0, 0); PG8_STAGE(PG8_SA(1, 1), a1 + hstep, voffA);
            PG8_WAIT_L(8); PG8_BAR; PG8_WAIT_L(0); PG8_MMA(0, 0, At, B0); PG8_BAR; PG8_SCHED;
            PG8_LDB(B1, 0, 1); PG8_STAGE(PG8_SB(0, 0), b2, voffB);
            PG8_BAR; PG8_WAIT_L(0); PG8_MMA(0, 1, At, B1); PG8_BAR;
            PG8_LDA(At, 0, 1); PG8_STAGE(PG8_SA(0, 0), a2, voffA);
            PG8_BAR; PG8_WAIT_L(0); PG8_MMA(1, 0, At, B0); PG8_BAR; PG8_SCHED;
            PG8_STAGE(PG8_SB(0, 1), c2, voffB);
            PG8_WAIT_V(6); PG8_BAR; PG8_MMA(1, 1, At, B1); PG8_BAR;
            PG8_LDB(B0, 1, 0); PG8_SCHED; PG8_LDA(At, 1, 0); PG8_STAGE(PG8_SA(0, 1), a2 + hstep, voffA);
            PG8_WAIT_L(8); PG8_BAR; PG8_WAIT_L(0); PG8_MMA(0, 0, At, B0); PG8_BAR; PG8_SCHED;
            PG8_LDB(B1, 1, 1); PG8_STAGE(PG8_SB(1, 0), b3, voffB);
            PG8_BAR; PG8_WAIT_L(0); PG8_MMA(0, 1, At, B1); PG8_BAR;
            PG8_LDA(At, 1, 1); PG8_STAGE(PG8_SA(1, 0), a3, voffA);
            PG8_BAR; PG8_WAIT_L(0); PG8_MMA(1, 0, At, B0); PG8_BAR; PG8_SCHED;
            PG8_STAGE(PG8_SB(1, 1), c3, voffB);
            PG8_WAIT_V(6); PG8_BAR; PG8_MMA(1, 1, At, B1); PG8_BAR;
        }
        PG8_STAMP();
        if constexpr (!Epi::AFTER_DRAIN) { E(acc, cur, wr, wc, fr, fq); S.done(cur); }
        PG8_STAMP();
        if (!has_next) break;
#pragma unroll
        for (int a = 0; a < 2; ++a)
#pragma unroll
            for (int b = 0; b < 2; ++b)
#pragma unroll
                for (int m = 0; m < 4; ++m)
#pragma unroll
                    for (int n = 0; n < 2; ++n) acc[a][b][m][n] = (f32x4){0.f, 0.f, 0.f, 0.f};
        cur = nxt; cA = nA; cB0 = nB0; cB1 = nB1; ++ui;
    }
    PG8_WAIT_V(0);
    if (wr == 0) PG8_BAR;
    PG8_BAR;
    if constexpr (Epi::AFTER_DRAIN) { E.fused(acc, cur, wr, wc, fr, fq, lds, wid, lane); S.done(cur); }
    PG8_STAMP();
    if (STAMP && wid == 0) { stamps[lane] = lane < nts ? (((unsigned long long)(unsigned)ts_hi << 32) | (unsigned)ts_lo) : 0ull;
        if (lane == 62) stamps[62] = rt_entry; if (lane == 63) stamps[63] = (unsigned long long)wall_clock64(); }
#undef PG8_STAMP
#undef PG8_SA
#undef PG8_SB
#undef PG8_STAGE
#undef PG8_LDA
#undef PG8_LDB
#undef PG8_MMA
#undef PG8_WAIT_V
#undef PG8_WAIT_L
#undef PG8_BAR
#undef PG8_SCHED
}
}

struct SchedStd {
    pg8::StaticOrder so; const char* A; const char* Bt;
    __device__ __forceinline__ bool next(int i, pg8::Unit& u) const {
        int pm, pn; if (!so.next(i, pm, pn)) return false;
        u.A = A + (size_t)pm * 256 * pg8::ROWB; u.B0 = Bt + (size_t)pn * 256 * pg8::ROWB; u.B1 = u.B0 + 128 * pg8::ROWB; u.i0 = pm * 256; u.i1 = pn * 256; u.i2 = 0; u.i3 = 0; return true;
    }
    __device__ __forceinline__ void a_ready(const pg8::Unit&) const {}
    __device__ __forceinline__ void done(const pg8::Unit&) const {}
};
template <int DOWN> struct SchedMoe {
    const volatile LAS int* tab; int G, c; const char* A; const char* W0; const char* W1;
    __device__ __forceinline__ bool next(int i, pg8::Unit& u) const {
        constexpr int NT = DOWN ? 4 : 8;
        const int L = i * G + c, total = __builtin_amdgcn_readfirstlane(tab[16]) * NT; if (L >= total) return false;
        const int nt = L % NT, mg = L / NT; int e = 0;
        for (int k = 1; k < 16; ++k) e += (mg >= __builtin_amdgcn_readfirstlane(tab[k])) ? 1 : 0;
        const int mt = mg - __builtin_amdgcn_readfirstlane(tab[e]);
        u.A = A + (size_t)mg * 256 * pg8::ROWB;
        if (DOWN) { u.B0 = W0 + ((size_t)e * 1024 + 256 * nt) * pg8::ROWB; u.B1 = u.B0 + 128 * pg8::ROWB; u.i0 = e * ECAP + 256 * mt; u.i1 = 256 * nt; u.i2 = __builtin_amdgcn_readfirstlane(tab[32 + e]) - 256 * mt; u.i3 = 0; }
        else      { u.B0 = W0 + ((size_t)e * 1024 + 128 * nt) * pg8::ROWB; u.B1 = W1 + ((size_t)e * 1024 + 128 * nt) * pg8::ROWB; u.i0 = 256 * mg; u.i1 = 128 * nt; u.i2 = 0; u.i3 = 0; }
        return true;
    }
    __device__ __forceinline__ void a_ready(const pg8::Unit&) const {}
    __device__ __forceinline__ void done(const pg8::Unit&) const {}
};
struct EpiP {
    static constexpr bool PERM = true, AFTER_DRAIN = false;
    bf16* O; int ldc;
    __device__ __forceinline__ void operator()(const f32x4 (&acc)[2][2][4][2], const pg8::Unit& u, int wr, int wc, int fr, int fq) const {
        const int row0 = u.i0 + wr * 64 + fr, col0 = u.i1 + wc * 32 + 8 * fq;
#pragma unroll
        for (int ai = 0; ai < 2; ++ai)
#pragma unroll
            for (int m = 0; m < 4; ++m) { bf16* rowp = O + (size_t)(row0 + ai * 128 + m * 16) * ldc + col0;
#pragma unroll
                for (int bj = 0; bj < 2; ++bj) { const f32x4 v0 = acc[ai][bj][m][0], v1 = acc[ai][bj][m][1];
                    u32x4 w; w.x = pg8::cvt_pk_bf16(v0[0], v0[1]); w.y = pg8::cvt_pk_bf16(v0[2], v0[3]); w.z = pg8::cvt_pk_bf16(v1[0], v1[1]); w.w = pg8::cvt_pk_bf16(v1[2], v1[3]);
                    *(u32x4*)(rowp + bj * 128) = w; }
                asm volatile("" ::: "memory"); }
    }
};
struct EpiOut {
    static constexpr bool PERM = false, AFTER_DRAIN = false;
    const float* ctx0; const float* x0; float* xs; const float* mod_l; int layer;
    __device__ __forceinline__ void operator()(const f32x4 (&acc)[2][2][4][2], const pg8::Unit& u, int wr, int wc, int fr, int fq) const {
        const int row0 = u.i0 + wr * 64 + fr, col0 = u.i1 + wc * 32 + 4 * fq;
        const bool isctx = u.i0 < NCTX; const int bidx = isctx ? 8 : (u.i0 - NCTX) / SEQ;
        const float* bs = layer == 0 ? (isctx ? ctx0 : x0 - (size_t)NCTX * D) : xs;
        const float* g1 = mod_l + bidx * 6144 + 2 * 1024;
        f32x4 gv[2][2];
#pragma unroll
        for (int bj = 0; bj < 2; ++bj)
#pragma unroll
            for (int n = 0; n < 2; ++n) gv[bj][n] = *(const f32x4*)(g1 + col0 + bj * 128 + n * 16);
#pragma unroll
        for (int ai = 0; ai < 2; ++ai)
#pragma unroll
            for (int m = 0; m < 4; ++m) { const size_t off = (size_t)(row0 + ai * 128 + m * 16) * D + col0;
#pragma unroll
                for (int bj = 0; bj < 2; ++bj)
#pragma unroll
                    for (int n = 0; n < 2; ++n) { const f32x4 b = *(const f32x4*)(bs + off + bj * 128 + n * 16); *(f32x4*)(xs + off + bj * 128 + n * 16) = b + gv[bj][n] * acc[ai][bj][m][n]; }
                asm volatile("" ::: "memory"); }
    }
};
__device__ __forceinline__ float silu_mul(float g, float u) { return g * u / (1.0f + __expf(-g)); }
struct EpiUp {
    static constexpr bool PERM = true, AFTER_DRAIN = false;
    bf16* ACT;
    __device__ __forceinline__ void operator()(const f32x4 (&acc)[2][2][4][2], const pg8::Unit& u, int wr, int wc, int fr, int fq) const {
        const int row0 = u.i0 + wr * 64 + fr, col0 = u.i1 + wc * 32 + 8 * fq;
#pragma unroll
        for (int ai = 0; ai < 2; ++ai)
#pragma unroll
            for (int m = 0; m < 4; ++m) { bf16* rowp = ACT + (size_t)(row0 + ai * 128 + m * 16) * D + col0;
                const f32x4 g0 = acc[ai][0][m][0], g1 = acc[ai][0][m][1], u0 = acc[ai][1][m][0], u1 = acc[ai][1][m][1];
                u32x4 w; w.x = pg8::cvt_pk_bf16(silu_mul(g0[0], u0[0]), silu_mul(g0[1], u0[1])); w.y = pg8::cvt_pk_bf16(silu_mul(g0[2], u0[2]), silu_mul(g0[3], u0[3]));
                w.z = pg8::cvt_pk_bf16(silu_mul(g1[0], u1[0]), silu_mul(g1[1], u1[1])); w.w = pg8::cvt_pk_bf16(silu_mul(g1[2], u1[2]), silu_mul(g1[3], u1[3]));
                *(u32x4*)rowp = w; asm volatile("" ::: "memory"); }
    }
};
struct EpiDown {
    static constexpr bool PERM = true, AFTER_DRAIN = false;
    bf16* YB; const unsigned* elist; const float* wlist;
    __device__ __forceinline__ void operator()(const f32x4 (&acc)[2][2][4][2], const pg8::Unit& u, int wr, int wc, int fr, int fq) const {
        const int rl0 = wr * 64 + fr, col0 = u.i1 + wc * 32 + 8 * fq;
#pragma unroll
        for (int ai = 0; ai < 2; ++ai)
#pragma unroll
            for (int m = 0; m < 4; ++m) { const int rl = rl0 + ai * 128 + m * 16;
                if (rl < u.i2) { const unsigned entry = elist[u.i0 + rl]; const float w = wlist[u.i0 + rl]; bf16* rowp = YB + (size_t)entry * D + col0;
#pragma unroll
                    for (int bj = 0; bj < 2; ++bj) { const f32x4 v0 = acc[ai][bj][m][0] * w, v1 = acc[ai][bj][m][1] * w;
                        u32x4 o; o.x = pg8::cvt_pk_bf16(v0[0], v0[1]); o.y = pg8::cvt_pk_bf16(v0[2], v0[3]); o.z = pg8::cvt_pk_bf16(v1[0], v1[1]); o.w = pg8::cvt_pk_bf16(v1[2], v1[3]);
                        *(u32x4*)(rowp + bj * 128) = o; } }
                asm volatile("" ::: "memory"); }
    }
};

__device__ __forceinline__ void transpose_item(const float* W, int K, int N, bf16* WT, LAS float* scr, int item, int lane) {
    const int nblk = N / 32, kb = item / nblk, nb = item % nblk, k0 = 64 * kb, n0 = 32 * nb;
#pragma unroll 8
    for (int i = 0; i < 32; ++i) { const int kk = 2 * i + (lane >> 5); scr[kk * 33 + (lane & 31)] = W[(size_t)(k0 + kk) * N + n0 + (lane & 31)]; }
    LDS_WAIT(); asm volatile("" ::: "memory");
    const int c = lane & 7;
#pragma unroll
    for (int j = 0; j < 4; ++j) { const int n = (lane >> 3) + 8 * j; const LAS float* s = scr + (8 * c) * 33 + n;
        u32x4 o; o.x = pk2(s[0 * 33], s[1 * 33]); o.y = pk2(s[2 * 33], s[3 * 33]); o.z = pk2(s[4 * 33], s[5 * 33]); o.w = pk2(s[6 * 33], s[7 * 33]);
        *(u32x4*)(WT + (size_t)(n0 + n) * K + k0 + 8 * c) = o; }
    LDS_WAIT(); asm volatile("" ::: "memory");
}

__device__ __forceinline__ void unit_mod(Frame& F, int u) {
    LAUNDER(F);
    const int l = u / 96, cb = u % 96, n0 = cb * 64;
    LAS float* sc = (LAS float*)F.lds;
    LAS float* red = sc + 9 * 1024;
    const float* c = F.in[I_C + F.z]; const float* cc = F.in[I_CCTX + F.z];
    for (int i = F.tid; i < 9 * 1024; i += 512) { const int r = i >> 10, k = i & 1023; const float v = r < 8 ? c[r * 1024 + k] : cc[k]; sc[i] = v / (1.0f + expf(-v)); }
    __syncthreads();
    const int col = F.tid & 63, ks = F.tid >> 6;
    float acc[9];
#pragma unroll
    for (int r = 0; r < 9; ++r) acc[r] = 0.f;
    const float* w = F.in[I_ADAW + F.z] + ((size_t)l * 1024 + ks * 128) * 6144 + n0 + col;
    for (int k = 0; k < 128; ++k) { const float wv = w[(size_t)k * 6144];
#pragma unroll
        for (int r = 0; r < 9; ++r) acc[r] += sc[r * 1024 + ks * 128 + k] * wv; }
#pragma unroll
    for (int r = 0; r < 9; ++r) red[(ks * 9 + r) * 64 + col] = acc[r];
    __syncthreads();
    float* MOD = (float*)(F.ws + WS_MOD);
    for (int i = F.tid; i < 9 * 64; i += 512) { const int r = i >> 6, cl = i & 63; float s = 0.f;
#pragma unroll
        for (int k = 0; k < 8; ++k) s += red[(k * 9 + r) * 64 + cl];
        MOD[((size_t)l * 9 + r) * 6144 + n0 + cl] = s + F.in[I_ADAB + F.z][l * 6144 + n0 + cl]; }
    __syncthreads();
}

__device__ __forceinline__ void unit_taps1(Frame& F, int u) {
    LAUNDER(F);
    const int l = u / 272, r = u % 272; const int Lsel = r >= 256 ? 1 : 0, blk = Lsel ? r - 256 : r, L = Lsel ? 256 : 4096, pos0 = blk * 16;
    LAS float* feats = (LAS float*)F.lds;
    LAS float* h1 = feats + 16 * 36;
    LAS float* h2 = h1 + 16 * 64;
    const float invLm1 = 1.0f / (float)(L - 1);
    for (int i = F.tid; i < 16 * 33; i += 512) { const int p = i / 33, f = i % 33; const float pos = (float)(pos0 + p); float v;
        if (f == 0) v = pos * invLm1;
        else { const int bi = (f - 1) & 15; const float band = 1e-4f + (float)bi * ((15.0f - 1e-4f) / 15.0f); const float ang = (float)(2.0 * 3.14159265358979323846 / (double)L) * pos * band;
            v = f <= 16 ? cosf(ang) : -sinf(ang); }
        feats[p * 36 + f] = v; }
    __syncthreads();
    for (int i = F.tid; i < 16 * 64; i += 512) { const int p = i >> 6, j = i & 63; float s = F.in[I_HB1 + F.z][l * 64 + j]; const float* w1 = F.in[I_HW1 + F.z] + (size_t)l * 33 * 64 + j;
        for (int f = 0; f < 33; ++f) s += feats[p * 36 + f] * w1[f * 64];
        h1[p * 64 + j] = sinf(F.in[I_HF1 + F.z][l * 64 + j] * s); }
    __syncthreads();
    for (int i = F.tid; i < 16 * 64; i += 512) { const int p = i >> 6, j = i & 63; float s = F.in[I_HB2 + F.z][l * 64 + j]; const float* w2 = F.in[I_HW2 + F.z] + (size_t)l * 64 * 64 + j;
        for (int k = 0; k < 64; ++k) s += h1[p * 64 + k] * w2[k * 64];
        h2[p * 64 + j] = sinf(F.in[I_HF2 + F.z][l * 64 + j] * s); }
    __syncthreads();
    float acc[2][16];
#pragma unroll
    for (int c = 0; c < 2; ++c)
#pragma unroll
        for (int p = 0; p < 16; ++p) acc[c][p] = 0.f;
    const float* w3 = F.in[I_HW3 + F.z] + (size_t)l * 64 * 1024 + F.tid;
    for (int k = 0; k < 64; ++k) { const float wa = w3[k * 1024], wb = w3[k * 1024 + 512];
#pragma unroll
        for (int p = 0; p < 16; ++p) { const float hv = h2[p * 64 + k]; acc[0][p] += hv * wa; acc[1][p] += hv * wb; } }
    float* RAW = (float*)(F.ws + WS_U + (Lsel ? U_RAWC + (size_t)l * 256 * 1024 * 4 : U_RAWL + (size_t)l * 4096 * 1024 * 4));
    float* PART = (float*)(F.ws + WS_U + U_PART) + (size_t)(l * 2 + Lsel) * 256 * 1024;
#pragma unroll
    for (int c = 0; c < 2; ++c) { const int col = F.tid + 512 * c, order = col >> 9, dir = (col >> 8) & 1, ch = col & 255;
        const float decay = fabsf(-3.0701134573253944f + (float)ch * ((-15.350567286626973f + 3.0701134573253944f) / 255.0f)); float asum = 0.f;
#pragma unroll
        for (int p = 0; p < 16; ++p) { const int pos = pos0 + p; const float t = (float)pos * invLm1; const float v = acc[c][p] * expf(-t * decay);
            RAW[(size_t)pos * 1024 + col] = v; if (!(dir == 1 && pos == 0)) asum += fabsf(v); }
        PART[(size_t)blk * 1024 + col] = asum; }
    __syncthreads();
}

__device__ __forceinline__ void unit_taps2(Frame& F, int u) {
    LAUNDER(F);
    int Lsel, l, order, dir, cb, pb;
    if (u < 4096) { Lsel = 0; pb = u & 63; cb = (u >> 6) & 3; dir = (u >> 8) & 1; order = (u >> 9) & 1; l = u >> 10; }
    else { const int v = u - 4096; Lsel = 1; pb = v & 3; cb = (v >> 2) & 3; dir = (v >> 4) & 1; order = (v >> 5) & 1; l = v >> 6; }
    const int L = Lsel ? 256 : 4096, pos0 = pb * 64, ch0 = cb * 64, colb = order * 512 + dir * 256 + ch0;
    LAS float* tile = (LAS float*)F.lds;
    const float* RAW = (const float*)(F.ws + WS_U + (Lsel ? U_RAWC + (size_t)l * 256 * 1024 * 4 : U_RAWL + (size_t)l * 4096 * 1024 * 4));
    const float* PART = (const float*)(F.ws + WS_U + U_PART) + (size_t)(l * 2 + Lsel) * 256 * 1024; LAS float* nrm = tile + 64 * 65;
    { const int cc = F.tid & 63, pr = F.tid >> 6;
#pragma unroll
      for (int i = 0; i < 8; ++i) { const int p = pr + 8 * i; tile[p * 65 + cc] = RAW[(size_t)(pos0 + p) * 1024 + colb + cc]; } }
    { const int ch = F.tid >> 3, pc = F.tid & 7, nblk = Lsel ? 16 : 256; float sacc = 0.f;
      for (int bk = pc; bk < nblk; bk += 8) sacc += PART[(size_t)bk * 1024 + order * 512 + ch0 + ch] + PART[(size_t)bk * 1024 + order * 512 + 256 + ch0 + ch];
      nrm[ch * 8 + pc] = sacc; }
    __syncthreads();
    bf16* TG = Lsel ? (bf16*)(F.ws + WS_TGC) + ((size_t)(l * 2 + order) * 256) * 512 : (bf16*)(F.ws + WS_TG) + ((size_t)(l * 2 + order) * 256) * 8192;
    { const int ch = F.tid >> 3, pc = F.tid & 7; const float inv = 1.0f / (((nrm[ch * 8 + 0] + nrm[ch * 8 + 1]) + (nrm[ch * 8 + 2] + nrm[ch * 8 + 3])) + ((nrm[ch * 8 + 4] + nrm[ch * 8 + 5]) + (nrm[ch * 8 + 6] + nrm[ch * 8 + 7])));
      bf16* row = TG + (size_t)(ch0 + ch) * (2 * L);
#pragma unroll
      for (int j = 0; j < 8; ++j) { const int p = 8 * pc + j, pos = pos0 + p; const unsigned v = f2bf(tile[p * 65 + ch] * inv);
          if (dir == 0) row[L - pos] = (bf16)v;
          else { if (pos == 0) row[0] = 0; else row[L + pos] = (bf16)v; } } }
    __syncthreads();
}

__device__ __forceinline__ void unit_s5tab(Frame& F, int u) {
    LAUNDER(F);
    LAS float* co = (LAS float*)F.lds;
    const int idx = u;
    if (F.tid < 64) { const int p = F.tid;
        const double lr = (double)F.in[I_LRE + F.z][idx * 64 + p], li = (double)F.in[I_LIM + F.z][idx * 64 + p], dt = exp((double)F.in[I_LDT + F.z][idx]);
        const double mag = exp(lr * dt), ar = mag * cos(li * dt), ai = mag * sin(li * dt);
        const double nr = ar - 1.0, ni = ai, den = lr * lr + li * li;
        co[p] = (float)((nr * lr + ni * li) / den); co[64 + p] = (float)((ni * lr - nr * li) / den);
        const double m32 = exp(lr * dt * 32.0);
        f32x2* AB = (f32x2*)(F.ws + WS_S5T + S5_AB); f32x2* A32 = (f32x2*)(F.ws + WS_S5T + S5_A32);
        AB[idx * 64 + p] = (f32x2){(float)ar, (float)ai};
        A32[idx * 64 + p] = (f32x2){(float)(m32 * cos(li * dt * 32.0)), (float)(m32 * sin(li * dt * 32.0))}; }
    __syncthreads();
    bf16* BbT = (bf16*)(F.ws + WS_S5T + S5_BBT) + (size_t)idx * 2048; bf16* CmT = (bf16*)(F.ws + WS_S5T + S5_CMT) + (size_t)idx * 2048;
    for (int i = F.tid; i < 2048; i += 512) { const int n = i >> 4, c = i & 15, p = n & 63;
        const float br = F.in[I_BRE + F.z][((size_t)idx * 64 + p) * 16 + c], bi = F.in[I_BIM + F.z][((size_t)idx * 64 + p) * 16 + c];
        BbT[i] = (bf16)f2bf(n < 64 ? co[p] * br - co[64 + p] * bi : co[p] * bi + co[64 + p] * br); }
    for (int i = F.tid; i < 2048; i += 512) { const int c = i >> 7, n = i & 127, p = n & 63;
        CmT[i] = (bf16)f2bf(n < 64 ? F.in[I_CRE + F.z][((size_t)idx * 16 + c) * 64 + p] : -F.in[I_CIM + F.z][((size_t)idx * 16 + c) * 64 + p]); }
    __syncthreads();
}

__device__ __forceinline__ void ph_prologue0(Frame& F) {
    { LAS float* scr = (LAS float*)(F.lds + F.wave * 8704);
      const int gw = F.bid * 8 + F.wave, NGW = F.G * 8;
      constexpr int I_IN = 16 * 56, I_OUT = 16 * 32, I_GLU = 4 * 8, PER_L = I_IN + I_OUT + I_GLU;
      for (int it = gw; it < DEPTH * PER_L; it += NGW) { const int l = it / PER_L; int r = it % PER_L;
          if (r < I_IN) { transpose_item(F.in[I_WIN + F.z] + (size_t)l * D * INW, D, INW, (bf16*)(F.ws + WS_WIN) + (size_t)l * INW * D, scr, r, F.lane); continue; } r -= I_IN;
          if (r < I_OUT) { transpose_item(F.in[I_WOUT + F.z] + (size_t)l * D * D, D, D, (bf16*)(F.ws + WS_WOUT) + (size_t)l * D * D, scr, r, F.lane); continue; } r -= I_OUT;
          transpose_item(F.in[I_GLUW + F.z] + (size_t)l * 256 * 256, 256, 256, (bf16*)(F.ws + WS_S5T + S5_GLUT) + (size_t)l * 256 * 256, scr, r, F.lane); } }
    __syncthreads();
    for (int u = F.bid; u < 384 + 1088 + 128 + 1; u += F.G) {
        if (u < 384) unit_mod(F, u);
        else if (u < 384 + 1088) unit_taps1(F, u - 384);
        else if (u < 384 + 1088 + 128) unit_s5tab(F, u - 384 - 1088);
        else { f32x2* ROPE = (f32x2*)(F.ws + WS_S5T + S5_ROPE);
            for (int i = F.tid; i < 64 * 16; i += 512) { const int pos = i >> 4, j = i & 15; const double ang = (double)pos * pow(10000.0, -(double)j / 16.0); ROPE[i] = (f32x2){(float)cos(ang), (float)sin(ang)}; } }
    }
}
__device__ __forceinline__ void ph_prologue1(Frame& F) {
    for (int u = F.bid; u < 4096 + 256; u += F.G) unit_taps2(F, u);
}
__device__ __forceinline__ void unit_wconv(Frame& F, int l, int u) {
    LAUNDER(F);
    LAS float* scr = (LAS float*)(F.lds + F.wave * 8704);
#pragma unroll 1
    for (int k = 0; k < 4; ++k) { const int it = u * 32 + k * 8 + F.wave; const int mat = it >> 9, r = it & 511, kind = mat >> 4, e = mat & 15;
        const float* W = F.in[I_WG + kind + F.z] + ((size_t)l * 16 + e) * D * D;
        bf16* WT = (bf16*)(F.ws + WS_WMOE + (size_t)kind * 32 * MiB) + (size_t)e * D * D;
        transpose_item(W, D, D, WT, scr, r, F.lane); }
    __syncthreads();
}

#ifndef PROBE_NO_MOE
#define PROBE_NO_MOE 0
#endif
__device__ __forceinline__ int bidx_of_row(int row) { return row < NCTX ? 8 : (row - NCTX) / SEQ; }

__device__ __forceinline__ void ph_norm1(Frame& F, int l) {
    const int gw = F.bid * 8 + F.wave, NGW = F.G * 8;
    float* XS = (float*)(F.ws + WS_XS); bf16* H = (bf16*)(F.ws + WS_H); const bf16* YB = (const bf16*)(F.ws + WS_U + U_YB); const float* MOD = (const float*)(F.ws + WS_MOD);
    const int row_lo = (l == DEPTH) ? NCTX : 0;
    for (int row = row_lo + gw; row < NTOK; row += NGW) {
        const int bi = bidx_of_row(row);
        const float* src = (l == 0) ? (row < NCTX ? F.in[I_CTX + F.z] + (size_t)row * D : F.in[I_X + F.z] + (size_t)(row - NCTX) * D) : XS + (size_t)row * D;
        f32x4 v[4];
#pragma unroll
        for (int j = 0; j < 4; ++j) v[j] = *(const f32x4*)(src + 4 * F.lane + 256 * j);
        if (l > 0 && !PROBE_NO_MOE) {
            const float* g2 = MOD + ((size_t)(l - 1) * 9 + bi) * 6144 + 5 * 1024;
#pragma unroll
            for (int j = 0; j < 4; ++j) { const int col = 4 * F.lane + 256 * j;
                const u32x2 y0 = *(const u32x2*)(YB + ((size_t)row * 2 + 0) * D + col), y1 = *(const u32x2*)(YB + ((size_t)row * 2 + 1) * D + col);
                const f32x4 g = *(const f32x4*)(g2 + col);
                v[j][0] += g[0] * (bflo(y0.x) + bflo(y1.x)); v[j][1] += g[1] * (bfhi(y0.x) + bfhi(y1.x)); v[j][2] += g[2] * (bflo(y0.y) + bflo(y1.y)); v[j][3] += g[3] * (bfhi(y0.y) + bfhi(y1.y));
                if (l < DEPTH) *(f32x4*)(XS + (size_t)row * D + col) = v[j]; }
        }
        float ss = 0.f;
#pragma unroll
        for (int j = 0; j < 4; ++j) ss += (v[j][0] * v[j][0] + v[j][1] * v[j][1]) + (v[j][2] * v[j][2] + v[j][3] * v[j][3]);
        const float rs = 1.0f / sqrtf(wave_sum(ss, F.lane) * (1.0f / D) + EPS);
        if (l == DEPTH) {
            float* o = F.out + (size_t)(row - NCTX) * D;
#pragma unroll
            for (int j = 0; j < 4; ++j) { const int col = 4 * F.lane + 256 * j; const f32x4 g = *(const f32x4*)(F.in[I_FG + F.z] + col); *(f32x4*)(o + col) = v[j] * rs * g; }
        } else {
            const float* m = MOD + ((size_t)l * 9 + bi) * 6144;
#pragma unroll
            for (int j = 0; j < 4; ++j) { const int col = 4 * F.lane + 256 * j;
                const f32x4 g = *(const f32x4*)(F.in[I_N1G + F.z] + l * D + col), sh = *(const f32x4*)(m + col), sc = *(const f32x4*)(m + 1024 + col);
                const f32x4 h = (v[j] * rs * g) * (sc + 1.0f) + sh;
                u32x2 o; o.x = pk2(h[0], h[1]); o.y = pk2(h[2], h[3]); *(u32x2*)(H + (size_t)row * D + col) = o; }
        }
    }
}

__device__ __forceinline__ void ph_norm2_router(Frame& F, int l) {
    LAS float* rw = (LAS float*)F.lds;
    for (int i = F.tid; i < 1024 * 16 / 4; i += 512) ((LAS f32x4*)rw)[i] = ((const f32x4*)F.in[I_RW + F.z])[i];
    __syncthreads();
    const int gw = F.bid * 8 + F.wave, NGW = F.G * 8;
    const float* XS = (const float*)(F.ws + WS_XS); bf16* H = (bf16*)(F.ws + WS_H); const float* MOD = (const float*)(F.ws + WS_MOD);
    unsigned* ELIST = (unsigned*)(F.ws + WS_ELIST); float* WLIST = (float*)(F.ws + WS_WLIST);
    for (int row = gw; row < NTOK; row += NGW) {
        const int bi = bidx_of_row(row);
        float ss = 0.f;
        { f32x4 v[4];
#pragma unroll
          for (int j = 0; j < 4; ++j) { v[j] = *(const f32x4*)(XS + (size_t)row * D + 4 * F.lane + 256 * j); ss += (v[j][0] * v[j][0] + v[j][1] * v[j][1]) + (v[j][2] * v[j][2] + v[j][3] * v[j][3]); } }
        const float rs = 1.0f / sqrtf(wave_sum(ss, F.lane) * (1.0f / D) + EPS);
        const float* m = MOD + ((size_t)l * 9 + bi) * 6144;
        float lg[16];
#pragma unroll
        for (int e = 0; e < 16; ++e) lg[e] = 0.f;
#pragma unroll 1
        for (int j = 0; j < 4; ++j) { const int col = 4 * F.lane + 256 * j;
            const f32x4 vj = *(const f32x4*)(XS + (size_t)row * D + col);
            const f32x4 g = *(const f32x4*)(F.in[I_N2G + F.z] + l * D + col), sh = *(const f32x4*)(m + 3 * 1024 + col), sc = *(const f32x4*)(m + 4 * 1024 + col);
            const f32x4 h = (vj * rs * g) * (sc + 1.0f) + sh;
            u32x2 o; o.x = pk2(h[0], h[1]); o.y = pk2(h[2], h[3]); *(u32x2*)(H + (size_t)row * D + col) = o;
#pragma unroll
            for (int q = 0; q < 4; ++q) { const LAS f32x4* wr = (const LAS f32x4*)(rw + (col + q) * 16);
#pragma unroll
                for (int e4 = 0; e4 < 4; ++e4) { const f32x4 w = wr[e4]; lg[4 * e4 + 0] += h[q] * w[0]; lg[4 * e4 + 1] += h[q] * w[1]; lg[4 * e4 + 2] += h[q] * w[2]; lg[4 * e4 + 3] += h[q] * w[3]; } }
            asm volatile("" ::: "memory"); }
#pragma unroll
        for (int e = 0; e < 16; ++e) lg[e] = wave_sum(lg[e], F.lane);
        float mx = lg[0];
#pragma unroll
        for (int e = 1; e < 16; ++e) mx = fmaxf(mx, lg[e]);
        float pr[16], sum = 0.f;
#pragma unroll
        for (int e = 0; e < 16; ++e) { pr[e] = expf(lg[e] - mx); sum += pr[e]; }
        const float inv = 1.0f / sum;
        float sel[16];
#pragma unroll
        for (int e = 0; e < 16; ++e) { pr[e] *= inv; sel[e] = pr[e] + F.in[I_RB + F.z][e]; }
        float best = -1e30f; int gi = 0;
#pragma unroll
        for (int g = 0; g < 4; ++g) { const float a = sel[4 * g], b = sel[4 * g + 1], c = sel[4 * g + 2], d = sel[4 * g + 3];
            const float hi1 = fmaxf(a, b), lo1 = fminf(a, b), hi2 = fmaxf(c, d), lo2 = fminf(c, d);
            const float top = fmaxf(hi1, hi2), second = fmaxf(fminf(hi1, hi2), fmaxf(lo1, lo2)); const float gs = top + second;
            if (gs > best) { best = gs; gi = g; } }
        float s0 = 0.f, s1 = 0.f, s2 = 0.f, s3 = 0.f, p0 = 0.f, p1 = 0.f, p2 = 0.f, p3 = 0.f;
#pragma unroll
        for (int g = 0; g < 4; ++g) if (g == gi) { s0 = sel[4 * g]; s1 = sel[4 * g + 1]; s2 = sel[4 * g + 2]; s3 = sel[4 * g + 3]; p0 = pr[4 * g]; p1 = pr[4 * g + 1]; p2 = pr[4 * g + 2]; p3 = pr[4 * g + 3]; }
        int i1 = 0; float b1 = s0; if (s1 > b1) { b1 = s1; i1 = 1; } if (s2 > b1) { b1 = s2; i1 = 2; } if (s3 > b1) { b1 = s3; i1 = 3; }
        int i2 = -1; float b2 = -1e30f;
        if (i1 != 0 && s0 > b2) { b2 = s0; i2 = 0; } if (i1 != 1 && s1 > b2) { b2 = s1; i2 = 1; } if (i1 != 2 && s2 > b2) { b2 = s2; i2 = 2; } if (i1 != 3 && s3 > b2) { b2 = s3; i2 = 3; }
        const float q1 = i1 == 0 ? p0 : i1 == 1 ? p1 : i1 == 2 ? p2 : p3, q2 = i2 == 0 ? p0 : i2 == 1 ? p1 : i2 == 2 ? p2 : p3;
        const float gsum = q1 + q2;
        if (F.lane < 2) { const int e = gi * 4 + (F.lane == 0 ? i1 : i2); const float gate = (F.lane == 0 ? q1 : q2) / gsum;
            const unsigned pos = __hip_atomic_fetch_add(F.ctl + CW_CNT + (l * 16 + e) * 64, 1u, __ATOMIC_RELAXED, __HIP_MEMORY_SCOPE_AGENT);
            ELIST[(size_t)e * ECAP + pos] = (unsigned)row * 2u + (unsigned)F.lane; WLIST[(size_t)e * ECAP + pos] = gate; }
    }
    __syncthreads();
}

__device__ __forceinline__ void moe_tables(Frame& F, int l, volatile LAS int* tab) {
    __syncthreads();
    if (F.tid == 0) { int pref = 0;
        for (int e = 0; e < 16; ++e) { const int c = (int)__hip_atomic_load(F.ctl + CW_CNT + (l * 16 + e) * 64, __ATOMIC_RELAXED, __HIP_MEMORY_SCOPE_AGENT); tab[e] = pref; tab[32 + e] = c; pref += (c + 255) >> 8; }
        tab[16] = pref; }
    __syncthreads();
}
__device__ __forceinline__ void ph_gather(Frame& F, int l) {
    volatile LAS int* tab = (volatile LAS int*)(F.lds + LDS_BYTES - 512);
    moe_tables(F, l, tab);
    const int gw = F.bid * 8 + F.wave, NGW = F.G * 8;
    const unsigned* ELIST = (const unsigned*)(F.ws + WS_ELIST); const bf16* H = (const bf16*)(F.ws + WS_H); bf16* XG = (bf16*)(F.ws + WS_U + U_XG);
    for (int e = 0; e < 16; ++e) { const int cnt = __builtin_amdgcn_readfirstlane(tab[32 + e]), base = 256 * __builtin_amdgcn_readfirstlane(tab[e]);
        for (int pos = gw; pos < cnt; pos += NGW) { const unsigned tok = ELIST[(size_t)e * ECAP + pos] >> 1;
            const u32x4* s = (const u32x4*)(H + (size_t)tok * D); u32x4* d = (u32x4*)(XG + (size_t)(base + pos) * D);
            const u32x4 a = s[F.lane], b = s[64 + F.lane]; d[F.lane] = a; d[64 + F.lane] = b; }
        for (int pos = cnt + gw; pos < ((cnt + 255) & ~255); pos += NGW) { u32x4* d = (u32x4*)(XG + (size_t)(base + pos) * D); d[F.lane] = (u32x4){0u, 0u, 0u, 0u}; d[64 + F.lane] = (u32x4){0u, 0u, 0u, 0u}; } }
}

__device__ __forceinline__ void unit_prep_qk(Frame& F, int u) {
    LAUNDER(F);
    const bf16* P = (const bf16*)(F.ws + WS_U + U_P); bf16* QR = (bf16*)(F.ws + WS_U + U_QR); bf16* KR = (bf16*)(F.ws + WS_U + U_KR); const f32x2* ROPE = (const f32x2*)(F.ws + WS_S5T + S5_ROPE);
    for (int it = F.tid; it < 64 * 40; it += 512) { const int r = it / 40, s = it % 40, hs = s >> 2, half = (s >> 1) & 1, ck = s & 1; const int row = u * 64 + r;
        const bool isq = hs < 8; const int scol = (isq ? HY_END + hs * 64 : Q_END + (hs - 8) * 64) + half * 32 + ck * 8;
        const u32x4 a = *(const u32x4*)(P + (size_t)row * INW + scol), b = *(const u32x4*)(P + (size_t)row * INW + scol + 16);
        const unsigned aw[4] = {a.x, a.y, a.z, a.w}, bw[4] = {b.x, b.y, b.z, b.w}; float x1[8], x2[8], o1[8], o2[8];
#pragma unroll
        for (int k = 0; k < 4; ++k) { x1[2 * k] = bflo(aw[k]); x1[2 * k + 1] = bfhi(aw[k]); x2[2 * k] = bflo(bw[k]); x2[2 * k + 1] = bfhi(bw[k]); }
        const float scl = isq ? 0.125f : 1.0f;
        if (row >= NCTX) { const int t = (row - NCTX) & (SEQ - 1), pos = half ? (t & 63) : (t >> 6);
#pragma unroll
            for (int k = 0; k < 8; ++k) { const f32x2 cs = ROPE[pos * 16 + ck * 8 + k]; o1[k] = (x1[k] * cs.x - x2[k] * cs.y) * scl; o2[k] = (x1[k] * cs.y + x2[k] * cs.x) * scl; } }
        else {
#pragma unroll
            for (int k = 0; k < 8; ++k) { o1[k] = x1[k] * scl; o2[k] = x2[k] * scl; } }
        u32x4 oa, ob; oa.x = pk2(o1[0], o1[1]); oa.y = pk2(o1[2], o1[3]); oa.z = pk2(o1[4], o1[5]); oa.w = pk2(o1[6], o1[7]); ob.x = pk2(o2[0], o2[1]); ob.y = pk2(o2[2], o2[3]); ob.z = pk2(o2[4], o2[5]); ob.w = pk2(o2[6], o2[7]);
        bf16* dst = isq ? QR + (size_t)row * 512 + hs * 64 + half * 32 + ck * 8 : KR + (size_t)row * 128 + (hs - 8) * 64 + half * 32 + ck * 8;
        *(u32x4*)dst = oa; *(u32x4*)(dst + 16) = ob; }
}

__device__ __forceinline__ void unit_hy_prep(Frame& F, int l, int u) {
    LAUNDER(F);
    const int seg = u / 512, b = (u >> 6) & 7, tb = u & 63, t0 = tb * 64;
    LAS bf16* tile = (LAS bf16*)F.lds;
    const bf16* P = (const bf16*)(F.ws + WS_U + U_P);
    __syncthreads();
    for (int i = F.tid; i < 66 * 32; i += 512) { const int rr = i >> 5, ck = i & 31, t = t0 - 1 + rr; u32x4 v = (u32x4){0u, 0u, 0u, 0u};
        if (t >= 0 && t < SEQ) v = *(const u32x4*)(P + (size_t)(NCTX + b * SEQ + t) * INW + seg * 256 + ck * 8);
        *(LAS u32x4*)(tile + rr * 264 + ck * 8) = v; }
    __syncthreads();
    bf16* OUT = (bf16*)(F.ws + WS_U + (seg == 0 ? U_HV : seg == 1 ? U_HX1 : U_HX2));
    const int ch = F.tid & 255, col = seg * 256 + ch;
    const float w0 = F.in[I_HCW + F.z][(l * 3 + 0) * 768 + col], w1 = F.in[I_HCW + F.z][(l * 3 + 1) * 768 + col], w2 = F.in[I_HCW + F.z][(l * 3 + 2) * 768 + col], bb = F.in[I_HCB + F.z][l * 768 + col];
#pragma unroll
    for (int k = 0; k < 4; ++k) { const int tc = (F.tid >> 8) + 2 * k; float z[10];
#pragma unroll
        for (int j = 0; j < 10; ++j) z[j] = bf2f(tile[(8 * tc + j) * 264 + ch]);
        float o[8];
#pragma unroll
        for (int j = 0; j < 8; ++j) o[j] = bb + w0 * z[j] + w1 * z[j + 1] + w2 * z[j + 2];
        u32x4 w; w.x = pk2(o[0], o[1]); w.y = pk2(o[2], o[3]); w.z = pk2(o[4], o[5]); w.w = pk2(o[6], o[7]);
        *(u32x4*)(OUT + ((size_t)ch * NB + b) * SEQ + t0 + 8 * tc) = w; }
}

constexpr int HY_NA = 642, HY_GT_BYTES = 8 * HY_NA * 16  , HY_UP = 4488, HY_UB_OFF = HY_GT_BYTES, HY_UB_BYTES = 8 * HY_UP * 2  ;
static_assert(HY_UB_OFF + HY_UB_BYTES <= LDS_BYTES - 512, "hyena LDS");
__device__ __forceinline__ void unit_hy_conv(Frame& F, int l, int order, int ch) {
    LAUNDER(F);
    LAS unsigned char* GT = F.lds; LAS unsigned char* UB = F.lds + HY_UB_OFF; LAS float* RED = (LAS float*)F.lds;
    const bf16* TG = (const bf16*)(F.ws + WS_TG) + ((size_t)(l * 2 + order) * 256 + ch) * 8192;
    const bf16* U = (const bf16*)(F.ws + WS_U + (order == 0 ? U_HV : U_Z1T)) + (size_t)ch * NB * SEQ;
    const bf16* XM = (const bf16*)(F.ws + WS_U + (order == 0 ? U_HX1 : U_HX2)) + (size_t)ch * NB * SEQ;
    bf16* OUT = (bf16*)(F.ws + WS_U + (order == 0 ? U_Z1T : U_HYT)) + (size_t)ch * NB * SEQ;
    const float bias = F.in[I_HBIAS + F.z][(l * 2 + order) * 256 + ch];
    const int lane = F.lane, w = F.wave, nt = w & 3, kh = w >> 2, half = lane >> 5, i = lane & 31, col = lane & 31, bb = col >> 2, np = col & 3;
    __syncthreads();
    for (int k = F.tid; k < 8 * 512; k += 512) { const int b = k >> 9, c = k & 511; *(LAS u32x4*)(UB + b * (HY_UP * 2) + (192 + 8 * c) * 2) = *(const u32x4*)(U + (size_t)b * SEQ + 8 * c); }
    for (int k = F.tid; k < 8 * 49; k += 512) { const int b = k / 49, c = k % 49; const int el = c < 24 ? 8 * c : 4288 + 8 * (c - 24); *(LAS u32x4*)(UB + b * (HY_UP * 2) + el * 2) = (u32x4){0u, 0u, 0u, 0u}; }
#pragma unroll 1
    for (int q = 0; q < 4; ++q) {
        const int T0 = 1024 * q, Y0 = -(T0 + 1024);
        __syncthreads();
        for (int a = F.tid; a < HY_NA; a += 512) { const int yp = Y0 + 8 * a + 4096;
            u32x4 lo = (u32x4){0u, 0u, 0u, 0u}, hi = lo;
            if (yp >= 0 && yp < 8192) lo = *(const u32x4*)(TG + yp);
            if (yp + 8 >= 0 && yp + 8 < 8192) hi = *(const u32x4*)(TG + yp + 8);
            const unsigned wv[8] = {lo.x, lo.y, lo.z, lo.w, hi.x, hi.y, hi.z, hi.w};
#pragma unroll
            for (int r = 0; r < 8; ++r) { u32x4 o;
                if ((r & 1) == 0) { o.x = wv[r / 2]; o.y = wv[r / 2 + 1]; o.z = wv[r / 2 + 2]; o.w = wv[r / 2 + 3]; }
                else { const int d = r / 2; o.x = (wv[d] >> 16) | (wv[d + 1] << 16); o.y = (wv[d + 1] >> 16) | (wv[d + 2] << 16); o.z = (wv[d + 2] >> 16) | (wv[d + 3] << 16); o.w = (wv[d + 3] >> 16) | (wv[d + 4] << 16); }
                *(LAS u32x4*)(GT + (r * HY_NA + a) * 16) = o; } }
        __syncthreads();
        const int K_lo = -(T0 + 256 * nt + 192), ks0 = K_lo + 16 * 134 * kh;
        const int rcp = (8 - (i & 7)) & 7;
        int aidx = (ks0 - 32 - Y0) / 8 + half - ((i + 7) >> 3);
        const LAS unsigned char* ap = GT + (rcp * HY_NA) * 16;
        int boff = bb * (HY_UP * 2) + (192 + ks0 + T0 + 256 * nt + 64 * np + 8 * half) * 2;
        bf16x8 am2 = *(const LAS bf16x8*)(ap + aidx * 16), am1 = *(const LAS bf16x8*)(ap + (aidx + 2) * 16);
        aidx += 4;
        f32x16 acc0 = zero16(), acc1 = zero16();
#pragma unroll 2
        for (int st = 0; st < 134; ++st) {
            const bf16x8 an = *(const LAS bf16x8*)(ap + aidx * 16); const bf16x8 bf = *(const LAS bf16x8*)(UB + boff);
            acc0 = __builtin_amdgcn_mfma_f32_32x32x16_bf16(an, bf, acc0, 0, 0, 0);
            acc1 = __builtin_amdgcn_mfma_f32_32x32x16_bf16(am2, bf, acc1, 0, 0, 0);
            am2 = am1; am1 = an; aidx += 2; boff += 32;
        }
        __syncthreads();
        { LAS float* mine = RED + ((nt * 2 + (1 - kh)) * 16) * 64;
#pragma unroll
          for (int r = 0; r < 16; ++r) mine[r * 64 + lane] = (kh == 0) ? acc1[r] : acc0[r]; }
        __syncthreads();
        { const LAS float* oth = RED + ((nt * 2 + kh) * 16) * 64;
          const int mb = kh;
#pragma unroll
          for (int rg = 0; rg < 4; ++rg) {
              const int t = T0 + 256 * nt + 64 * np + 32 * mb + 8 * rg + 4 * half;
              const u32x2 xm = *(const u32x2*)(XM + (size_t)bb * SEQ + t);
              const u32x2 uu = *(const LAS u32x2*)(UB + bb * (HY_UP * 2) + (192 + t) * 2);
              const float xv[4] = {bflo(xm.x), bfhi(xm.x), bflo(xm.y), bfhi(xm.y)}, uv[4] = {bflo(uu.x), bfhi(uu.x), bflo(uu.y), bfhi(uu.y)};
              float o[4];
#pragma unroll
              for (int j = 0; j < 4; ++j) { const int r = 4 * rg + j; const float y = (kh == 0 ? acc0[r] : acc1[r]) + oth[r * 64 + lane]; o[j] = xv[j] * (y + uv[j] * bias); }
              u32x2 ov; ov.x = pk2(o[0], o[1]); ov.y = pk2(o[2], o[3]);
              *(u32x2*)(OUT + (size_t)bb * SEQ + t) = ov; } }
    }
    __syncthreads();
}

__device__ __forceinline__ void unit_hy_ctx(Frame& F, int l, int ch) {
    LAUNDER(F);
    LAS float* z = (LAS float*)F.lds;
    LAS float* vv = z + 3 * 8 * 258;
    LAS float* g = vv + 3 * 8 * 256;
    LAS float* z1 = g + 2 * 512;
    const bf16* P = (const bf16*)(F.ws + WS_U + U_P);
    __syncthreads();
    for (int k = F.tid; k < 3 * 8 * 258; k += 512) { const int seg = k / (8 * 258), r = k % (8 * 258), b = r / 258, tt = r % 258 - 1;
        z[k] = (tt >= 0 && tt < 256) ? bf2f(P[(size_t)(b * 256 + tt) * INW + seg * 256 + ch]) : 0.f; }
    for (int k = F.tid; k < 2 * 512; k += 512) { const int o = k >> 9, y = k & 511; g[k] = bf2f(((const bf16*)(F.ws + WS_TGC))[((size_t)(l * 2 + o) * 256 + ch) * 512 + y]); }
    __syncthreads();
    for (int k = F.tid; k < 3 * 8 * 256; k += 512) { const int seg = k / 2048, r = k % 2048, b = r >> 8, t = r & 255; const int col = seg * 256 + ch; const LAS float* zz = z + (seg * 8 + b) * 258 + t;
        vv[k] = F.in[I_HCB + F.z][l * 768 + col] + F.in[I_HCW + F.z][(l * 3 + 0) * 768 + col] * zz[0] + F.in[I_HCW + F.z][(l * 3 + 1) * 768 + col] * zz[1] + F.in[I_HCW + F.z][(l * 3 + 2) * 768 + col] * zz[2]; }
    __syncthreads();
    const int b = F.tid >> 6, tq = F.tid & 63;
    const float bias0 = F.in[I_HBIAS + F.z][(l * 2 + 0) * 256 + ch], bias1 = F.in[I_HBIAS + F.z][(l * 2 + 1) * 256 + ch];
    { float a[4] = {0.f, 0.f, 0.f, 0.f}; const LAS float* u = vv + b * 256;
      for (int s = 0; s < 256; ++s) { const float us = u[s];
#pragma unroll
          for (int k = 0; k < 4; ++k) a[k] += g[s - (tq + 64 * k) + 256] * us; }
#pragma unroll
      for (int k = 0; k < 4; ++k) { const int t = tq + 64 * k; z1[b * 256 + t] = vv[(8 + b) * 256 + t] * (a[k] + u[t] * bias0); } }
    __syncthreads();
    { float a[4] = {0.f, 0.f, 0.f, 0.f}; const LAS float* u = z1 + b * 256;
      for (int s = 0; s < 256; ++s) { const float us = u[s];
#pragma unroll
          for (int k = 0; k < 4; ++k) a[k] += g[512 + s - (tq + 64 * k) + 256] * us; }
      bf16* HYC = (bf16*)(F.ws + WS_HYC);
#pragma unroll
      for (int k = 0; k < 4; ++k) { const int t = tq + 64 * k; HYC[(size_t)(b * 256 + t) * 256 + ch] = (bf16)f2bf(vv[(16 + b) * 256 + t] * (a[k] + u[t] * bias1)); } }
    __syncthreads();
}

constexpr int AT_KP = 72  , AT_VP = 332  , AT_K_BYTES = 320 * AT_KP * 2  , AT_V_OFF = AT_K_BYTES, AT_V_BYTES = 64 * AT_VP * 2  ;
__device__ __forceinline__ void unit_attn(Frame& F, int l, int u) {
    LAUNDER(F);
    const bool lat = u < 1024; const int v_ = u - 1024;
    const int b = lat ? (u >> 7) : (v_ >> 3), kvh = lat ? ((u >> 6) & 1) : ((v_ >> 2) & 1), qt = lat ? (u & 63) : (v_ & 3);
    const bf16* P = (const bf16*)(F.ws + WS_U + U_P); const bf16* QR = (const bf16*)(F.ws + WS_U + U_QR); const bf16* KR = (const bf16*)(F.ws + WS_U + U_KR); bf16* ATT = (bf16*)(F.ws + WS_U + U_ATT);
    LAS unsigned char* KL = F.lds; LAS bf16* VT = (LAS bf16*)(F.lds + AT_V_OFF);
    const int lane = F.lane, w = F.wave, g = w >> 1, hh = w & 1, half = lane >> 5, ql = lane & 31;
    const int rowbase = lat ? NCTX + b * SEQ : b * CTXL;
    const int tq = 64 * qt + 32 * hh + ql;
    const int qrow = rowbase + tq, head = kvh * 4 + g;
    bf16x8 qf[4];
#pragma unroll
    for (int ks = 0; ks < 4; ++ks) qf[ks] = *(const bf16x8*)(QR + (size_t)qrow * 512 + head * 64 + 16 * ks + 8 * half);
    float m_run = F.in[I_SINK + F.z][l * 8 + head], l_run = 1.0f;
    f32x16 o0 = zero16(), o1 = zero16();
#pragma unroll 1
    for (int stage = lat ? 0 : 1; stage < 2; ++stage) {
        const int nkeys = stage == 0 ? 320 : 256;
        const int kbase = stage == 0 ? 64 * qt - 128 : 0;
        const int krow0 = stage == 0 ? NCTX + b * SEQ : b * CTXL;
        const int klimit = stage == 0 ? SEQ : CTXL;
        __syncthreads();
        for (int i = F.tid; i < nkeys * 8; i += 512) { const int kk = i >> 3, c = i & 7, kp = kbase + kk; u32x4 kv = (u32x4){0u, 0u, 0u, 0u}, vv = kv;
            if (kp >= 0 && kp < klimit) { kv = *(const u32x4*)(KR + (size_t)(krow0 + kp) * 128 + kvh * 64 + 8 * c); vv = *(const u32x4*)(P + (size_t)(krow0 + kp) * INW + K_END + kvh * 64 + 8 * c); }
            *(LAS u32x4*)(KL + (kk * AT_KP + 8 * c) * 2) = kv;
            const unsigned vw[4] = {vv.x, vv.y, vv.z, vv.w};
#pragma unroll
            for (int j = 0; j < 4; ++j) { VT[(8 * c + 2 * j) * AT_VP + kk] = (bf16)(vw[j] & 0xffffu); VT[(8 * c + 2 * j + 1) * AT_VP + kk] = (bf16)(vw[j] >> 16); } }
        __syncthreads();
        const int ntile = stage == 0 ? 9 : 8, kk00 = stage == 0 ? 32 * hh : 0;
#pragma unroll 1
        for (int tt = 0; tt < ntile; ++tt) {
            const int kk0 = kk00 + 32 * tt;
            f32x16 st = zero16();
#pragma unroll
            for (int ks = 0; ks < 4; ++ks) { const bf16x8 kf = *(const LAS bf16x8*)(KL + ((kk0 + ql) * AT_KP + 16 * ks + 8 * half) * 2); st = __builtin_amdgcn_mfma_f32_32x32x16_bf16(kf, qf[ks], st, 0, 0, 0); }
            float mx = -1e30f;
#pragma unroll
            for (int r = 0; r < 16; ++r) { if (stage == 0) { const int kp = kbase + kk0 + 8 * (r >> 2) + 4 * half + (r & 3); const int dd = kp - tq; const bool ok = (dd <= 128) && (dd >= -128) && (kp >= 0) && (kp < SEQ); st[r] = ok ? st[r] : -1e30f; }
                mx = fmaxf(mx, st[r]); }
            mx = fmaxf(mx, lane_xor(mx, lane, 32));
            const float m_new = fmaxf(m_run, mx), alpha = __expf(m_run - m_new);
            float rsum = 0.f;
#pragma unroll
            for (int r = 0; r < 16; ++r) { st[r] = __expf(st[r] - m_new); rsum += st[r]; }
            rsum += lane_xor(rsum, lane, 32);
            l_run = l_run * alpha + rsum; m_run = m_new;
#pragma unroll
            for (int r = 0; r < 16; ++r) { o0[r] *= alpha; o1[r] *= alpha; }
#pragma unroll
            for (int ks = 0; ks < 2; ++ks) {
                union { bf16x8 v; unsigned w[4]; } pf;
                pf.w[0] = pk2(st[8 * ks + 0], st[8 * ks + 1]); pf.w[1] = pk2(st[8 * ks + 2], st[8 * ks + 3]); pf.w[2] = pk2(st[8 * ks + 4], st[8 * ks + 5]); pf.w[3] = pk2(st[8 * ks + 6], st[8 * ks + 7]);
                union { bf16x8 v; u32x2 h[2]; } v0, v1;
                const LAS bf16* vp0 = VT + ql * AT_VP + kk0 + 16 * ks + 4 * half; const LAS bf16* vp1 = vp0 + 32 * AT_VP;
                v0.h[0] = *(const LAS u32x2*)vp0; v0.h[1] = *(const LAS u32x2*)(vp0 + 8); v1.h[0] = *(const LAS u32x2*)vp1; v1.h[1] = *(const LAS u32x2*)(vp1 + 8);
                o0 = __builtin_amdgcn_mfma_f32_32x32x16_bf16(v0.v, pf.v, o0, 0, 0, 0);
                o1 = __builtin_amdgcn_mfma_f32_32x32x16_bf16(v1.v, pf.v, o1, 0, 0, 0);
            }
        }
    }
    const float inv = 1.0f / l_run;
    bf16* orow = ATT + (size_t)qrow * 512 + head * 64;
#pragma unroll
    for (int rg = 0; rg < 4; ++rg) { const int d = 8 * rg + 4 * half;
        u32x2 a; a.x = pk2(o0[4 * rg] * inv, o0[4 * rg + 1] * inv); a.y = pk2(o0[4 * rg + 2] * inv, o0[4 * rg + 3] * inv); *(u32x2*)(orow + d) = a;
        u32x2 c; c.x = pk2(o1[4 * rg] * inv, o1[4 * rg + 1] * inv); c.y = pk2(o1[4 * rg + 2] * inv, o1[4 * rg + 3] * inv); *(u32x2*)(orow + 32 + d) = c; }
    __syncthreads();
}

__device__ __forceinline__ size_t s5_state_off(int cid, int b, int dir, int g) { return ((((size_t)cid * NB + b) * 2 + dir) * 16 + g) * 128; }
__device__ __forceinline__ int s5_row0(int cid, int b) { return cid < 8 ? b * CTXL + 32 * cid : NCTX + b * SEQ + 32 * (cid - 8); }
__device__ __forceinline__ void cmac(float& sr, float& si, float ar, float ai, float br, float bi) {
    float nr, ni;
    asm volatile("v_fma_f32 %0, %2, %3, %6\n\tv_fma_f32 %1, %2, %4, %7\n\tv_fma_f32 %0, -%5, %4, %0\n\tv_fma_f32 %1, %5, %3, %1" : "=&v"(nr), "=&v"(ni) : "v"(ar), "v"(sr), "v"(si), "v"(ai), "v"(br), "v"(bi));
    sr = nr; si = ni;
}
constexpr int S5_SP = 132;
template <int MODE> __device__ __forceinline__ void unit_s5(Frame& F, int l, int u) {
    LAUNDER(F);
    const int g = u >> 4, b = (u >> 1) & 7, hf = u & 1;
    const int lane = F.lane, w = F.wave, half = lane >> 5, ql = lane & 31;
    const bf16* P = (const bf16*)(F.ws + WS_U + U_P);
    LAS float* Sb = (LAS float*)(F.lds + w * (32 * S5_SP * 4));
    float* LOC = (float*)(F.ws + WS_LOC); const float* SPREV = (const float*)(F.ws + WS_SPREV); bf16* S5Y = (bf16*)(F.ws + WS_S5Y);
    __syncthreads();
#pragma unroll 1
    for (int cid = 68 * hf + w; cid < 68 * hf + 68; cid += 8) {
        const int row0 = s5_row0(cid, b);
        const bf16x8 uf = *(const bf16x8*)(P + (size_t)(row0 + ql) * INW + V_END + 16 * g + 8 * half);
        f32x4 yacc[2] = {zero4(), zero4()};
#pragma unroll 1
        for (int dir = 0; dir < 2; ++dir) {
            const int idx = (l * 2 + dir) * 16 + g;
            const bf16* BbT = (const bf16*)(F.ws + WS_S5T + S5_BBT) + (size_t)idx * 2048;
#pragma unroll
            for (int nt = 0; nt < 4; ++nt) { const bf16x8 bfr = *(const bf16x8*)(BbT + (32 * nt + ql) * 16 + 8 * half);
                f32x16 acc = zero16();
                acc = __builtin_amdgcn_mfma_f32_32x32x16_bf16(uf, bfr, acc, 0, 0, 0);
#pragma unroll
                for (int r = 0; r < 16; ++r) Sb[(8 * (r >> 2) + 4 * half + (r & 3)) * S5_SP + 32 * nt + ql] = acc[r]; }
            LDS_WAIT(); __builtin_amdgcn_wave_barrier();
            { const f32x2 ab = ((const f32x2*)(F.ws + WS_S5T + S5_AB))[idx * 64 + lane]; float sr = 0.f, si = 0.f;
              if (MODE == 1) { const float* sp = SPREV + s5_state_off(cid, b, dir, g); sr = sp[lane]; si = sp[64 + lane]; }
#pragma unroll 4
              for (int k = 0; k < 32; ++k) { const int j = dir == 0 ? k : 31 - k; const float br = Sb[j * S5_SP + lane], bi = Sb[j * S5_SP + 64 + lane];
                  cmac(sr, si, ab.x, ab.y, br, bi);
                  if (MODE == 1) { Sb[j * S5_SP + lane] = sr; Sb[j * S5_SP + 64 + lane] = si; } }
              if (MODE == 0) { float* lp = LOC + s5_state_off(cid, b, dir, g); lp[lane] = sr; lp[64 + lane] = si; } }
            if (MODE == 1) {
                LDS_WAIT(); __builtin_amdgcn_wave_barrier();
                const bf16* CmT = (const bf16*)(F.ws + WS_S5T + S5_CMT) + (size_t)idx * 2048;
                const int c16 = lane & 15, kq = lane >> 4;
#pragma unroll
                for (int ks = 0; ks < 4; ++ks) { const bf16x8 cf = *(const bf16x8*)(CmT + c16 * 128 + 32 * ks + 8 * kq);
#pragma unroll
                    for (int ntk = 0; ntk < 2; ++ntk) { const LAS float* sp = Sb + (16 * ntk + c16) * S5_SP + 32 * ks + 8 * kq;
                        const f32x4 a = *(const LAS f32x4*)sp, c = *(const LAS f32x4*)(sp + 4);
                        union { bf16x8 v; unsigned w[4]; } sf; sf.w[0] = pk2(a[0], a[1]); sf.w[1] = pk2(a[2], a[3]); sf.w[2] = pk2(c[0], c[1]); sf.w[3] = pk2(c[2], c[3]);
                        yacc[ntk] = __builtin_amdgcn_mfma_f32_16x16x32_bf16(cf, sf.v, yacc[ntk], 0, 0, 0); } }
                LDS_WAIT(); __builtin_amdgcn_wave_barrier();
            }
        }
        if (MODE == 1) {
            const int c0 = 4 * (lane >> 4);
            const f32x4 dsk = *(const f32x4*)(F.in[I_S5D + F.z] + l * 256 + 16 * g + c0);
#pragma unroll
            for (int ntk = 0; ntk < 2; ++ntk) { const int row = row0 + 16 * ntk + (lane & 15);
                const u32x2 uu = *(const u32x2*)(P + (size_t)row * INW + V_END + 16 * g + c0);
                const float y0 = yacc[ntk][0] + bflo(uu.x) * dsk[0], y1 = yacc[ntk][1] + bfhi(uu.x) * dsk[1], y2 = yacc[ntk][2] + bflo(uu.y) * dsk[2], y3 = yacc[ntk][3] + bfhi(uu.y) * dsk[3];
                u32x2 o; o.x = pk2(y0, y1); o.y = pk2(y2, y3); *(u32x2*)(S5Y + (size_t)row * 256 + 16 * g + c0) = o; }
        }
    }
    __syncthreads();
}
__device__ __forceinline__ void unit_s5_carry(Frame& F, int l, int u) {
    LAUNDER(F);
    const int gt = u * 512 + F.tid, p = gt & 63, g = (gt >> 6) & 15, dir = (gt >> 10) & 1, b = gt >> 11;
    const float* LOC = (const float*)(F.ws + WS_LOC); float* SPREV = (float*)(F.ws + WS_SPREV);
    const f32x2 a32 = ((const f32x2*)(F.ws + WS_S5T + S5_A32))[((l * 2 + dir) * 16 + g) * 64 + p];
    float sr = 0.f, si = 0.f;
#pragma unroll 1
    for (int k0 = 0; k0 < NCH; k0 += 8) {
        float lr[8], li[8];
#pragma unroll
        for (int j = 0; j < 8; ++j) { const int k = k0 + j, cid = dir == 0 ? k : (k < 8 ? 7 - k : 143 - k); const float* lp = LOC + s5_state_off(cid, b, dir, g); lr[j] = lp[p]; li[j] = lp[64 + p]; }
#pragma unroll
        for (int j = 0; j < 8; ++j) { const int k = k0 + j, cid = dir == 0 ? k : (k < 8 ? 7 - k : 143 - k); float* sp = SPREV + s5_state_off(cid, b, dir, g); sp[p] = sr; sp[64 + p] = si;
            cmac(sr, si, a32.x, a32.y, lr[j], li[j]); }
    }
}

constexpr int MX_P = 1032, GA_P = 264, MX_BYTES = 32 * MX_P * 2  , GA_OFF = MX_BYTES;
__device__ __forceinline__ float gelu_tanh(float x) { const float t = 0.7978845608028654f * (x + 0.044715f * x * x * x); const float e = __expf(2.0f * t); return 0.5f * x * (1.0f + (1.0f - 2.0f / (e + 1.0f))); }
__device__ __forceinline__ void unit_mixfinal(Frame& F, int l, int u) {
    LAUNDER(F);
    const int row0 = u * 32, lane = F.lane, w = F.wave;
    LAS bf16* MX = (LAS bf16*)F.lds; LAS bf16* GA = (LAS bf16*)(F.lds + GA_OFF);
    const bf16* ATT = (const bf16*)(F.ws + WS_U + U_ATT); const bf16* S5Y = (const bf16*)(F.ws + WS_S5Y);
    __syncthreads();
    if (row0 < NCTX) { const bf16* HYC = (const bf16*)(F.ws + WS_HYC);
        for (int i = F.tid; i < 32 * 32; i += 512) { const int r = i >> 5, c = i & 31; *(LAS u32x4*)(MX + r * MX_P + 8 * c) = *(const u32x4*)(HYC + (size_t)(row0 + r) * 256 + 8 * c); } }
    else { const bf16* HYT = (const bf16*)(F.ws + WS_U + U_HYT); const int b = (row0 - NCTX) / SEQ, t0 = (row0 - NCTX) % SEQ;
        for (int i = F.tid; i < 256 * 4; i += 512) { const int ch = i >> 2, part = i & 3; const u32x4 v = *(const u32x4*)(HYT + ((size_t)ch * NB + b) * SEQ + t0 + 8 * part);
            const unsigned vw[4] = {v.x, v.y, v.z, v.w};
#pragma unroll
            for (int j = 0; j < 4; ++j) { MX[(8 * part + 2 * j) * MX_P + ch] = (bf16)(vw[j] & 0xffffu); MX[(8 * part + 2 * j + 1) * MX_P + ch] = (bf16)(vw[j] >> 16); } } }
    for (int i = F.tid; i < 32 * 64; i += 512) { const int r = i >> 6, c = i & 63; *(LAS u32x4*)(MX + r * MX_P + 256 + 8 * c) = *(const u32x4*)(ATT + (size_t)(row0 + r) * 512 + 8 * c); }
    for (int i = F.tid; i < 32 * 32; i += 512) { const int r = i >> 5, c = i & 31; const u32x4 v = *(const u32x4*)(S5Y + (size_t)(row0 + r) * 256 + 8 * c);
        u32x4 o; o.x = pk2(gelu_tanh(bflo(v.x)), gelu_tanh(bfhi(v.x))); o.y = pk2(gelu_tanh(bflo(v.y)), gelu_tanh(bfhi(v.y))); o.z = pk2(gelu_tanh(bflo(v.z)), gelu_tanh(bfhi(v.z))); o.w = pk2(gelu_tanh(bflo(v.w)), gelu_tanh(bfhi(v.w)));
        *(LAS u32x4*)(GA + r * GA_P + 8 * c) = o; }
    __syncthreads();
    { const bf16* GLUT = (const bf16*)(F.ws + WS_S5T + S5_GLUT) + (size_t)l * 256 * 256; const int c16 = lane & 15, kq = lane >> 4;
      f32x4 acc[2][2];
#pragma unroll
      for (int mt = 0; mt < 2; ++mt)
#pragma unroll
          for (int nt = 0; nt < 2; ++nt) acc[mt][nt] = zero4();
#pragma unroll
      for (int ks = 0; ks < 8; ++ks) {
          bf16x8 wf[2], gf[2];
#pragma unroll
          for (int nt = 0; nt < 2; ++nt) wf[nt] = *(const bf16x8*)(GLUT + (size_t)(32 * w + 16 * nt + c16) * 256 + 32 * ks + 8 * kq);
#pragma unroll
          for (int mt = 0; mt < 2; ++mt) gf[mt] = *(const LAS bf16x8*)(GA + (16 * mt + c16) * GA_P + 32 * ks + 8 * kq);
#pragma unroll
          for (int mt = 0; mt < 2; ++mt)
#pragma unroll
              for (int nt = 0; nt < 2; ++nt) acc[mt][nt] = __builtin_amdgcn_mfma_f32_16x16x32_bf16(wf[nt], gf[mt], acc[mt][nt], 0, 0, 0); }
#pragma unroll
      for (int mt = 0; mt < 2; ++mt)
#pragma unroll
          for (int nt = 0; nt < 2; ++nt) { const int n0 = 32 * w + 16 * nt + 4 * kq, tok = 16 * mt + c16;
              const f32x4 gb = *(const f32x4*)(F.in[I_GLUB + F.z] + l * 256 + n0); const u32x2 gg = *(const LAS u32x2*)(GA + tok * GA_P + n0);
              const float g0 = bflo(gg.x), g1 = bfhi(gg.x), g2 = bflo(gg.y), g3 = bfhi(gg.y);
              u32x2 o; o.x = pk2(g0 / (1.0f + __expf(-(acc[mt][nt][0] + gb[0]))), g1 / (1.0f + __expf(-(acc[mt][nt][1] + gb[1]))));
              o.y = pk2(g2 / (1.0f + __expf(-(acc[mt][nt][2] + gb[2]))), g3 / (1.0f + __expf(-(acc[mt][nt][3] + gb[3]))));
              *(LAS u32x2*)(MX + tok * MX_P + 768 + n0) = o; } }
    __syncthreads();
    { bf16* MIXN = (bf16*)(F.ws + WS_U + U_MIXN); const float* gn = F.in[I_MIXG + F.z] + l * 1024 + 16 * lane;
      f32x4 gv[4];
#pragma unroll
      for (int j = 0; j < 4; ++j) gv[j] = *(const f32x4*)(gn + 4 * j);
#pragma unroll 1
      for (int k = 0; k < 4; ++k) { const int tok = 4 * w + k; const u32x4 a = *(const LAS u32x4*)(MX + tok * MX_P + 16 * lane), c = *(const LAS u32x4*)(MX + tok * MX_P + 16 * lane + 8);
          float x[16]; const unsigned ww[8] = {a.x, a.y, a.z, a.w, c.x, c.y, c.z, c.w};
#pragma unroll
          for (int j = 0; j < 8; ++j) { x[2 * j] = bflo(ww[j]); x[2 * j + 1] = bfhi(ww[j]); }
          float ss = 0.f;
#pragma unroll
          for (int j = 0; j < 16; ++j) ss += x[j] * x[j];
          const float s_hy = wave_sum(lane < 16 ? ss : 0.f, lane), s_at = wave_sum((lane >= 16 && lane < 48) ? ss : 0.f, lane), s_s5 = wave_sum(lane >= 48 ? ss : 0.f, lane);
          const float rs = lane < 16 ? 1.0f / sqrtf(s_hy * (1.0f / 256.0f) + EPS) : lane < 48 ? 1.0f / sqrtf(s_at * (1.0f / 512.0f) + EPS) : 1.0f / sqrtf(s_s5 * (1.0f / 256.0f) + EPS);
          u32x4 o0, o1;
          o0.x = pk2(x[0] * rs * gv[0][0], x[1] * rs * gv[0][1]); o0.y = pk2(x[2] * rs * gv[0][2], x[3] * rs * gv[0][3]); o0.z = pk2(x[4] * rs * gv[1][0], x[5] * rs * gv[1][1]); o0.w = pk2(x[6] * rs * gv[1][2], x[7] * rs * gv[1][3]);
          o1.x = pk2(x[8] * rs * gv[2][0], x[9] * rs * gv[2][1]); o1.y = pk2(x[10] * rs * gv[2][2], x[11] * rs * gv[2][3]); o1.z = pk2(x[12] * rs * gv[3][0], x[13] * rs * gv[3][1]); o1.w = pk2(x[14] * rs * gv[3][2], x[15] * rs * gv[3][3]);
          bf16* orow = MIXN + (size_t)(row0 + tok) * 1024 + 16 * lane; *(u32x4*)orow = o0; *(u32x4*)(orow + 8) = o1; } }
    __syncthreads();
}

constexpr int PH_PER_LAYER = 11, PH_L0 = 2, PH_FINAL = PH_L0 + PH_PER_LAYER * DEPTH, NPH = PH_FINAL + 1;

__global__ void __launch_bounds__(512, 2) fwd_kernel(Params p) {
    extern __shared__ __attribute__((aligned(16))) unsigned char lds_raw[];
    Frame F;
    F.lds = (LAS unsigned char*)lds_raw; F.ws = p.ws; F.ctl = (unsigned*)(p.ws + WS_CTL); F.in = p.in; F.out = p.out;
    F.tid = threadIdx.x; F.lane = F.tid & 63; F.wave = __builtin_amdgcn_readfirstlane(F.tid >> 6); F.G = gridDim.x; F.bid = blockIdx.x; F.z = 0;
    if (F.tid < 16) ((volatile LAS unsigned*)(F.lds + LDS_MISC))[F.tid] = 0u;
    __syncthreads();
#if MK_ONE_LAUNCH
    XcdBarrier bar = xcd_barrier_post(F.ctl + CW_BAR, (volatile LAS unsigned*)(F.lds + LDS_MISC));
#define SEAM(k) do { if (p.ph_lo <= (k) && (k) + 1 < p.ph_hi) xcd_barrier(bar); } while (0)
#else
#define SEAM(k) do { } while (0)
#endif
#ifndef PHMASK
#define PHMASK 0xFFFFFFFFu
#endif
#define IN(k) (p.ph_lo <= (k) && (k) < p.ph_hi)
#ifndef STATIC_Q
#define STATIC_Q 1
#endif
#define ON(b) (((PHMASK) >> (b)) & 1u)
#define FRESH() do { asm volatile("s_mov_b32 %0, 0" : "=s"(F.z)); asm volatile("" : "+s"(F.ws), "+s"(F.lds), "+v"(F.tid), "+v"(F.lane)); F.ctl = (unsigned*)(F.ws + WS_CTL); } while (0)
    const int lo = p.ph_lo, hi = p.ph_hi; (void)lo; (void)hi;

    if (ON(11) && IN(0)) { FRESH(); ph_prologue0(F); }
    SEAM(0);
    if (ON(12) && IN(1)) { FRESH(); ph_prologue1(F); }
    SEAM(1);
    { constexpr int l = 0;
        const int pb = PH_L0 + PH_PER_LAYER * l;
        if (ON(0) && IN(pb + 0)) { FRESH(); ph_norm1(F, l); }
        SEAM(pb + 0);
        if (ON(1) && IN(pb + 1)) { FRESH();
            SchedStd S; S.so.init(NTOK, INW, F.G, F.bid); S.A = (const char*)(F.ws + WS_H); S.Bt = (const char*)(F.ws + WS_WIN) + (size_t)l * INW * D * 2;
            EpiP E{(bf16*)(F.ws + WS_U + U_P), INW};
            pg8::gemm_phase<EpiP, SchedStd>(F.lds, S, E, F.tid);
        }
        SEAM(pb + 1);
        if (ON(2) && IN(pb + 2)) { FRESH();
            constexpr int N0 = 544, N1 = N0 + 1536, N2 = N1 + 256, N3 = N2 + 768;
            for (int u_ = F.bid;; u_ += F.G) { __syncthreads(); const int u = STATIC_Q ? u_ : wq_next(F, l * 4 + 0); if (u >= N3) break;
                if (u < N0) unit_prep_qk(F, u);
                else if (u < N1) unit_hy_prep(F, l, u - N0);
                else if (u < N2) unit_s5<0>(F, l, u - N1);
                else unit_wconv(F, l, u - N2); }
        }
        SEAM(pb + 2);
        if (ON(3) && IN(pb + 3)) { FRESH();
            constexpr int N0 = 256, N1 = N0 + 1088, N2 = N1 + 256, N3 = N2 + 32;
            for (int u_ = F.bid;; u_ += F.G) { __syncthreads(); const int u = STATIC_Q ? u_ : wq_next(F, l * 4 + 1); if (u >= N3) break;
                if (u < N0) unit_hy_conv(F, l, 0, u);
                else if (u < N1) unit_attn(F, l, u - N0);
                else if (u < N2) unit_hy_ctx(F, l, u - N1);
                else unit_s5_carry(F, l, u - N2); }
        }
        SEAM(pb + 3);
        if (ON(4) && IN(pb + 4)) { FRESH();
            constexpr int N0 = 256, N1 = N0 + 256;
            for (int u_ = F.bid;; u_ += F.G) { __syncthreads(); const int u = STATIC_Q ? u_ : wq_next(F, l * 4 + 2); if (u >= N1) break;
                if (u < N0) unit_hy_conv(F, l, 1, u);
                else unit_s5<1>(F, l, u - N0); }
        }
        SEAM(pb + 4);
        if (ON(5) && IN(pb + 5)) { FRESH(); for (int u = F.bid; u < NTOK / 32; u += F.G) unit_mixfinal(F, l, u); }
        SEAM(pb + 5);
        if (ON(6) && IN(pb + 6)) { FRESH();
            SchedStd S; S.so.init(NTOK, D, F.G, F.bid); S.A = (const char*)(F.ws + WS_U + U_MIXN); S.Bt = (const char*)(F.ws + WS_WOUT) + (size_t)l * D * D * 2;
            EpiOut E{F.in[I_CTX + F.z], F.in[I_X + F.z], (float*)(F.ws + WS_XS), (const float*)(F.ws + WS_MOD) + (size_t)l * 9 * 6144, l};
            pg8::gemm_phase<EpiOut, SchedStd>(F.lds, S, E, F.tid);
        }
        SEAM(pb + 6);
        if (ON(7) && IN(pb + 7)) { FRESH(); ph_norm2_router(F, l); }
        SEAM(pb + 7);
        if (ON(8) && IN(pb + 8)) { FRESH(); ph_gather(F, l); }
        SEAM(pb + 8);
        if (ON(9) && IN(pb + 9)) { FRESH();
            volatile LAS int* tab = (volatile LAS int*)(F.lds + LDS_BYTES - 512);
            moe_tables(F, l, tab);
            SchedMoe<0> S; S.tab = tab; S.G = F.G; S.c = F.bid; S.A = (const char*)(F.ws + WS_U + U_XG); S.W0 = (const char*)(F.ws + WS_WMOE); S.W1 = (const char*)(F.ws + WS_WMOE + 32 * MiB);
            EpiUp E{(bf16*)(F.ws + WS_U + U_ACT)};
            pg8::gemm_phase<EpiUp, SchedMoe<0>>(F.lds, S, E, F.tid);
        }
        SEAM(pb + 9);
        if (ON(10) && IN(pb + 10)) { FRESH();
            volatile LAS int* tab = (volatile LAS int*)(F.lds + LDS_BYTES - 512);
            moe_tables(F, l, tab);
            SchedMoe<1> S; S.tab = tab; S.G = F.G; S.c = F.bid; S.A = (const char*)(F.ws + WS_U + U_ACT); S.W0 = (const char*)(F.ws + WS_WMOE + 64 * MiB); S.W1 = nullptr;
            EpiDown E{(bf16*)(F.ws + WS_U + U_YB), (const unsigned*)(F.ws + WS_ELIST), (const float*)(F.ws + WS_WLIST)};
            pg8::gemm_phase<EpiDown, SchedMoe<1>>(F.lds, S, E, F.tid);
        }
        SEAM(pb + 10);
        }
    { constexpr int l = 1;
        const int pb = PH_L0 + PH_PER_LAYER * l;
        if (ON(0) && IN(pb + 0)) { FRESH(); ph_norm1(F, l); }
        SEAM(pb + 0);
        if (ON(1) && IN(pb + 1)) { FRESH();
            SchedStd S; S.so.init(NTOK, INW, F.G, F.bid); S.A = (const char*)(F.ws + WS_H); S.Bt = (const char*)(F.ws + WS_WIN) + (size_t)l * INW * D * 2;
            EpiP E{(bf16*)(F.ws + WS_U + U_P), INW};
            pg8::gemm_phase<EpiP, SchedStd>(F.lds, S, E, F.tid);
        }
        SEAM(pb + 1);
        if (ON(2) && IN(pb + 2)) { FRESH();
            constexpr int N0 = 544, N1 = N0 + 1536, N2 = N1 + 256, N3 = N2 + 768;
            for (int u_ = F.bid;; u_ += F.G) { __syncthreads(); const int u = STATIC_Q ? u_ : wq_next(F, l * 4 + 0); if (u >= N3) break;
                if (u < N0) unit_prep_qk(F, u);
                else if (u < N1) unit_hy_prep(F, l, u - N0);
                else if (u < N2) unit_s5<0>(F, l, u - N1);
                else unit_wconv(F, l, u - N2); }
        }
        SEAM(pb + 2);
        if (ON(3) && IN(pb + 3)) { FRESH();
            constexpr int N0 = 256, N1 = N0 + 1088, N2 = N1 + 256, N3 = N2 + 32;
            for (int u_ = F.bid;; u_ += F.G) { __syncthreads(); const int u = STATIC_Q ? u_ : wq_next(F, l * 4 + 1); if (u >= N3) break;
                if (u < N0) unit_hy_conv(F, l, 0, u);
                else if (u < N1) unit_attn(F, l, u - N0);
                else if (u < N2) unit_hy_ctx(F, l, u - N1);
                else unit_s5_carry(F, l, u - N2); }
        }
        SEAM(pb + 3);
        if (ON(4) && IN(pb + 4)) { FRESH();
            constexpr int N0 = 256, N1 = N0 + 256;
            for (int u_ = F.bid;; u_ += F.G) { __syncthreads(); const int u = STATIC_Q ? u_ : wq_next(F, l * 4 + 2); if (u >= N1) break;
                if (u < N0) unit_hy_conv(F, l, 1, u);
                else unit_s5<1>(F, l, u - N0); }
        }
        SEAM(pb + 4);
        if (ON(5) && IN(pb + 5)) { FRESH(); for (int u = F.bid; u < NTOK / 32; u += F.G) unit_mixfinal(F, l, u); }
        SEAM(pb + 5);
        if (ON(6) && IN(pb + 6)) { FRESH();
            SchedStd S; S.so.init(NTOK, D, F.G, F.bid); S.A = (const char*)(F.ws + WS_U + U_MIXN); S.Bt = (const char*)(F.ws + WS_WOUT) + (size_t)l * D * D * 2;
            EpiOut E{F.in[I_CTX + F.z], F.in[I_X + F.z], (float*)(F.ws + WS_XS), (const float*)(F.ws + WS_MOD) + (size_t)l * 9 * 6144, l};
            pg8::gemm_phase<EpiOut, SchedStd>(F.lds, S, E, F.tid);
        }
        SEAM(pb + 6);
        if (ON(7) && IN(pb + 7)) { FRESH(); ph_norm2_router(F, l); }
        SEAM(pb + 7);
        if (ON(8) && IN(pb + 8)) { FRESH(); ph_gather(F, l); }
        SEAM(pb + 8);
        if (ON(9) && IN(pb + 9)) { FRESH();
            volatile LAS int* tab = (volatile LAS int*)(F.lds + LDS_BYTES - 512);
            moe_tables(F, l, tab);
            SchedMoe<0> S; S.tab = tab; S.G = F.G; S.c = F.bid; S.A = (const char*)(F.ws + WS_U + U_XG); S.W0 = (const char*)(F.ws + WS_WMOE); S.W1 = (const char*)(F.ws + WS_WMOE + 32 * MiB);
            EpiUp E{(bf16*)(F.ws + WS_U + U_ACT)};
            pg8::gemm_phase<EpiUp, SchedMoe<0>>(F.lds, S, E, F.tid);
        }
        SEAM(pb + 9);
        if (ON(10) && IN(pb + 10)) { FRESH();
            volatile LAS int* tab = (volatile LAS int*)(F.lds + LDS_BYTES - 512);
            moe_tables(F, l, tab);
            SchedMoe<1> S; S.tab = tab; S.G = F.G; S.c = F.bid; S.A = (const char*)(F.ws + WS_U + U_ACT); S.W0 = (const char*)(F.ws + WS_WMOE + 64 * MiB); S.W1 = nullptr;
            EpiDown E{(bf16*)(F.ws + WS_U + U_YB), (const unsigned*)(F.ws + WS_ELIST), (const float*)(F.ws + WS_WLIST)};
            pg8::gemm_phase<EpiDown, SchedMoe<1>>(F.lds, S, E, F.tid);
        }
        SEAM(pb + 10);
        }
    { constexpr int l = 2;
        const int pb = PH_L0 + PH_PER_LAYER * l;
        if (ON(0) && IN(pb + 0)) { FRESH(); ph_norm1(F, l); }
        SEAM(pb + 0);
        if (ON(1) && IN(pb + 1)) { FRESH();
            SchedStd S; S.so.init(NTOK, INW, F.G, F.bid); S.A = (const char*)(F.ws + WS_H); S.Bt = (const char*)(F.ws + WS_WIN) + (size_t)l * INW * D * 2;
            EpiP E{(bf16*)(F.ws + WS_U + U_P), INW};
            pg8::gemm_phase<EpiP, SchedStd>(F.lds, S, E, F.tid);
        }
        SEAM(pb + 1);
        if (ON(2) && IN(pb + 2)) { FRESH();
            constexpr int N0 = 544, N1 = N0 + 1536, N2 = N1 + 256, N3 = N2 + 768;
            for (int u_ = F.bid;; u_ += F.G) { __syncthreads(); const int u = STATIC_Q ? u_ : wq_next(F, l * 4 + 0); if (u >= N3) break;
                if (u < N0) unit_prep_qk(F, u);
                else if (u < N1) unit_hy_prep(F, l, u - N0);
                else if (u < N2) unit_s5<0>(F, l, u - N1);
                else unit_wconv(F, l, u - N2); }
        }
        SEAM(pb + 2);
        if (ON(3) && IN(pb + 3)) { FRESH();
            constexpr int N0 = 256, N1 = N0 + 1088, N2 = N1 + 256, N3 = N2 + 32;
            for (int u_ = F.bid;; u_ += F.G) { __syncthreads(); const int u = STATIC_Q ? u_ : wq_next(F, l * 4 + 1); if (u >= N3) break;
                if (u < N0) unit_hy_conv(F, l, 0, u);
                else if (u < N1) unit_attn(F, l, u - N0);
                else if (u < N2) unit_hy_ctx(F, l, u - N1);
                else unit_s5_carry(F, l, u - N2); }
        }
        SEAM(pb + 3);
        if (ON(4) && IN(pb + 4)) { FRESH();
            constexpr int N0 = 256, N1 = N0 + 256;
            for (int u_ = F.bid;; u_ += F.G) { __syncthreads(); const int u = STATIC_Q ? u_ : wq_next(F, l * 4 + 2); if (u >= N1) break;
                if (u < N0) unit_hy_conv(F, l, 1, u);
                else unit_s5<1>(F, l, u - N0); }
        }
        SEAM(pb + 4);
        if (ON(5) && IN(pb + 5)) { FRESH(); for (int u = F.bid; u < NTOK / 32; u += F.G) unit_mixfinal(F, l, u); }
        SEAM(pb + 5);
        if (ON(6) && IN(pb + 6)) { FRESH();
            SchedStd S; S.so.init(NTOK, D, F.G, F.bid); S.A = (const char*)(F.ws + WS_U + U_MIXN); S.Bt = (const char*)(F.ws + WS_WOUT) + (size_t)l * D * D * 2;
            EpiOut E{F.in[I_CTX + F.z], F.in[I_X + F.z], (float*)(F.ws + WS_XS), (const float*)(F.ws + WS_MOD) + (size_t)l * 9 * 6144, l};
            pg8::gemm_phase<EpiOut, SchedStd>(F.lds, S, E, F.tid);
        }
        SEAM(pb + 6);
        if (ON(7) && IN(pb + 7)) { FRESH(); ph_norm2_router(F, l); }
        SEAM(pb + 7);
        if (ON(8) && IN(pb + 8)) { FRESH(); ph_gather(F, l); }
        SEAM(pb + 8);
        if (ON(9) && IN(pb + 9)) { FRESH();
            volatile LAS int* tab = (volatile LAS int*)(F.lds + LDS_BYTES - 512);
            moe_tables(F, l, tab);
            SchedMoe<0> S; S.tab = tab; S.G = F.G; S.c = F.bid; S.A = (const char*)(F.ws + WS_U + U_XG); S.W0 = (const char*)(F.ws + WS_WMOE); S.W1 = (const char*)(F.ws + WS_WMOE + 32 * MiB);
            EpiUp E{(bf16*)(F.ws + WS_U + U_ACT)};
            pg8::gemm_phase<EpiUp, SchedMoe<0>>(F.lds, S, E, F.tid);
        }
        SEAM(pb + 9);
        if (ON(10) && IN(pb + 10)) { FRESH();
            volatile LAS int* tab = (volatile LAS int*)(F.lds + LDS_BYTES - 512);
            moe_tables(F, l, tab);
            SchedMoe<1> S; S.tab = tab; S.G = F.G; S.c = F.bid; S.A = (const char*)(F.ws + WS_U + U_ACT); S.W0 = (const char*)(F.ws + WS_WMOE + 64 * MiB); S.W1 = nullptr;
            EpiDown E{(bf16*)(F.ws + WS_U + U_YB), (const unsigned*)(F.ws + WS_ELIST), (const float*)(F.ws + WS_WLIST)};
            pg8::gemm_phase<EpiDown, SchedMoe<1>>(F.lds, S, E, F.tid);
        }
        SEAM(pb + 10);
        }
    { constexpr int l = 3;
        const int pb = PH_L0 + PH_PER_LAYER * l;
        if (ON(0) && IN(pb + 0)) { FRESH(); ph_norm1(F, l); }
        SEAM(pb + 0);
        if (ON(1) && IN(pb + 1)) { FRESH();
            SchedStd S; S.so.init(NTOK, INW, F.G, F.bid); S.A = (const char*)(F.ws + WS_H); S.Bt = (const char*)(F.ws + WS_WIN) + (size_t)l * INW * D * 2;
            EpiP E{(bf16*)(F.ws + WS_U + U_P), INW};
            pg8::gemm_phase<EpiP, SchedStd>(F.lds, S, E, F.tid);
        }
        SEAM(pb + 1);
        if (ON(2) && IN(pb + 2)) { FRESH();
            constexpr int N0 = 544, N1 = N0 + 1536, N2 = N1 + 256, N3 = N2 + 768;
            for (int u_ = F.bid;; u_ += F.G) { __syncthreads(); const int u = STATIC_Q ? u_ : wq_next(F, l * 4 + 0); if (u >= N3) break;
                if (u < N0) unit_prep_qk(F, u);
                else if (u < N1) unit_hy_prep(F, l, u - N0);
                else if (u < N2) unit_s5<0>(F, l, u - N1);
                else unit_wconv(F, l, u - N2); }
        }
        SEAM(pb + 2);
        if (ON(3) && IN(pb + 3)) { FRESH();
            constexpr int N0 = 256, N1 = N0 + 1088, N2 = N1 + 256, N3 = N2 + 32;
            for (int u_ = F.bid;; u_ += F.G) { __syncthreads(); const int u = STATIC_Q ? u_ : wq_next(F, l * 4 + 1); if (u >= N3) break;
                if (u < N0) unit_hy_conv(F, l, 0, u);
                else if (u < N1) unit_attn(F, l, u - N0);
                else if (u < N2) unit_hy_ctx(F, l, u - N1);
                else unit_s5_carry(F, l, u - N2); }
        }
        SEAM(pb + 3);
        if (ON(4) && IN(pb + 4)) { FRESH();
            constexpr int N0 = 256, N1 = N0 + 256;
            for (int u_ = F.bid;; u_ += F.G) { __syncthreads(); const int u = STATIC_Q ? u_ : wq_next(F, l * 4 + 2); if (u >= N1) break;
                if (u < N0) unit_hy_conv(F, l, 1, u);
                else unit_s5<1>(F, l, u - N0); }
        }
        SEAM(pb + 4);
        if (ON(5) && IN(pb + 5)) { FRESH(); for (int u = F.bid; u < NTOK / 32; u += F.G) unit_mixfinal(F, l, u); }
        SEAM(pb + 5);
        if (ON(6) && IN(pb + 6)) { FRESH();
            SchedStd S; S.so.init(NTOK, D, F.G, F.bid); S.A = (const char*)(F.ws + WS_U + U_MIXN); S.Bt = (const char*)(F.ws + WS_WOUT) + (size_t)l * D * D * 2;
            EpiOut E{F.in[I_CTX + F.z], F.in[I_X + F.z], (float*)(F.ws + WS_XS), (const float*)(F.ws + WS_MOD) + (size_t)l * 9 * 6144, l};
            pg8::gemm_phase<EpiOut, SchedStd>(F.lds, S, E, F.tid);
        }
        SEAM(pb + 6);
        if (ON(7) && IN(pb + 7)) { FRESH(); ph_norm2_router(F, l); }
        SEAM(pb + 7);
        if (ON(8) && IN(pb + 8)) { FRESH(); ph_gather(F, l); }
        SEAM(pb + 8);
        if (ON(9) && IN(pb + 9)) { FRESH();
            volatile LAS int* tab = (volatile LAS int*)(F.lds + LDS_BYTES - 512);
            moe_tables(F, l, tab);
            SchedMoe<0> S; S.tab = tab; S.G = F.G; S.c = F.bid; S.A = (const char*)(F.ws + WS_U + U_XG); S.W0 = (const char*)(F.ws + WS_WMOE); S.W1 = (const char*)(F.ws + WS_WMOE + 32 * MiB);
            EpiUp E{(bf16*)(F.ws + WS_U + U_ACT)};
            pg8::gemm_phase<EpiUp, SchedMoe<0>>(F.lds, S, E, F.tid);
        }
        SEAM(pb + 9);
        if (ON(10) && IN(pb + 10)) { FRESH();
            volatile LAS int* tab = (volatile LAS int*)(F.lds + LDS_BYTES - 512);
            moe_tables(F, l, tab);
            SchedMoe<1> S; S.tab = tab; S.G = F.G; S.c = F.bid; S.A = (const char*)(F.ws + WS_U + U_ACT); S.W0 = (const char*)(F.ws + WS_WMOE + 64 * MiB); S.W1 = nullptr;
            EpiDown E{(bf16*)(F.ws + WS_U + U_YB), (const unsigned*)(F.ws + WS_ELIST), (const float*)(F.ws + WS_WLIST)};
            pg8::gemm_phase<EpiDown, SchedMoe<1>>(F.lds, S, E, F.tid);
        }
        SEAM(pb + 10);
        }
    if (ON(13) && IN(PH_FINAL)) { FRESH(); ph_norm1(F, DEPTH); }
}

extern "C" void kernel_launch(void* const* d_in, const int* in_sizes, int n_in, void* d_out, int out_size, void* d_ws, size_t ws_size, hipStream_t stream) {
    static int grid = 0;
    if (grid == 0) {
        if (n_in != 38 || out_size != NLAT * D || ws_size < WS_END) { fprintf(stderr, "kernel_launch: unexpected shapes: n_in %d out %d ws %zu (need %zu)\n", n_in, out_size, ws_size, (size_t)WS_END); grid = -1; return; }
        int dev = 0, cus = 0, per_cu = 0;
        if (hipGetDevice(&dev) != hipSuccess || hipDeviceGetAttribute(&cus, hipDeviceAttributeMultiprocessorCount, dev) != hipSuccess) { grid = -1; return; }
        if (hipFuncSetAttribute((const void*)fwd_kernel, hipFuncAttributeMaxDynamicSharedMemorySize, LDS_BYTES) != hipSuccess) { fprintf(stderr, "kernel_launch: hipFuncSetAttribute failed\n"); grid = -1; return; }
        if (hipOccupancyMaxActiveBlocksPerMultiprocessor(&per_cu, (const void*)fwd_kernel, 512, LDS_BYTES) != hipSuccess || per_cu < 1) fprintf(stderr, "kernel_launch: occupancy query reports %d per CU\n", per_cu);
        grid = cus > 0 ? cus : 256;
    }
    if (grid < 0) return;
    (void)in_sizes;
    hipMemsetAsync((char*)d_ws + WS_CTL, 0, CTL_BYTES, stream);
    Params p{};
    for (int i = 0; i < 38; ++i) p.in[i] = (const float*)d_in[i];
    p.out = (float*)d_out; p.ws = (unsigned char*)d_ws;
#if MK_ONE_LAUNCH
    p.ph_lo = 0; p.ph_hi = NPH;
    hipLaunchKernelGGL(fwd_kernel, dim3(grid), dim3(512), LDS_BYTES, stream, p);
#else
    for (int k = 0; k < NPH; ++k) { p.ph_lo = k; p.ph_hi = k + 1; hipLaunchKernelGGL(fwd_kernel, dim3(grid), dim3(512), LDS_BYTES, stream, p); }
#endif
}
```

```cpp
#include <hip/hip_runtime.h>
#include <stdio.h>
#include <stdint.h>

#ifndef PROBE_STAMPS
#define PROBE_STAMPS 0
#endif
#ifndef MK_ONE_LAUNCH
#define MK_ONE_LAUNCH 1
#endif

#define GAS __attribute__((address_space(1)))
#define LAS __attribute__((address_space(3)))
typedef unsigned short bf16;
typedef short bf16x8 __attribute__((ext_vector_type(8)));
typedef float f32x2 __attribute__((ext_vector_type(2)));
typedef float f32x4 __attribute__((ext_vector_type(4)));
typedef float f32x16 __attribute__((ext_vector_type(16)));
typedef unsigned u32x2 __attribute__((ext_vector_type(2)));
typedef unsigned u32x4 __attribute__((ext_vector_type(4)));

constexpr int D = 1024, NB = 8, SEQ = 4096, CTXL = 256, DEPTH = 4;
constexpr int NCTX = NB * CTXL, NLAT = NB * SEQ, NTOK = NCTX + NLAT;
constexpr int INW = 1792, HY_END = 768, Q_END = 1280, K_END = 1408, V_END = 1536;
constexpr int NEXP = 16, ECAP = NTOK;
constexpr int XG_ROWS = 2 * NTOK + NEXP * 256;
constexpr float EPS = 1e-6f;
constexpr int NCH = 136;

constexpr size_t MiB = 1u << 20;
constexpr size_t WS_CTL = 0, CTL_BYTES = 1 * MiB;
constexpr size_t WS_WIN = 1 * MiB, WS_WOUT = 15 * MiB, WS_WMOE = 23 * MiB, WS_MOD = 119 * MiB, WS_TG = 120 * MiB, WS_TGC = 152 * MiB, WS_S5T = 154 * MiB;
constexpr size_t WS_XS = 156 * MiB, WS_H = 292 * MiB, WS_LOC = 360 * MiB, WS_SPREV = 377 * MiB, WS_S5Y = 394 * MiB, WS_ELIST = 411 * MiB, WS_WLIST = 414 * MiB, WS_HYC = 417 * MiB;
constexpr size_t WS_U = 418 * MiB;
constexpr size_t U_XG = 0, U_ACT = 144 * MiB, U_YB = 288 * MiB;
constexpr size_t U_DELTA = 0;
constexpr size_t U_P = 0, U_QR = 119 * MiB, U_KR = 153 * MiB, U_HV = 162 * MiB, U_HX1 = 178 * MiB, U_HX2 = 194 * MiB, U_Z1T = 210 * MiB, U_HYT = 226 * MiB, U_ATT = 242 * MiB, U_MIXN = 276 * MiB;
constexpr size_t U_RAWL = 0, U_RAWC = 64 * MiB, U_PART = 68 * MiB;
constexpr size_t WS_WMOE2 = WS_U + 424 * MiB;
constexpr size_t WS_END = WS_WMOE2 + 96 * MiB;
__host__ __device__ constexpr size_t wmoe_off(int l) { return (l & 1) ? WS_WMOE2 : WS_WMOE; }
constexpr size_t S5_BBT = 0, S5_CMT = 512 * 1024, S5_AB = 1024 * 1024, S5_A32 = 1088 * 1024, S5_GLUT = 1152 * 1024, S5_ROPE = 1664 * 1024;
constexpr int CW_BAR = 4096, CW_WQ = 8192, CW_CNT = 16384, CW_NORM = 32768;

constexpr int LDS_BYTES = 163840;
constexpr int LDS_MISC = LDS_BYTES - 64;

__device__ __forceinline__ unsigned f2bf(float f) { unsigned u = __builtin_bit_cast(unsigned, f); return (u + 0x7fffu + ((u >> 16) & 1u)) >> 16; }
__device__ __forceinline__ unsigned pk2(float lo, float hi) { unsigned r; asm("v_cvt_pk_bf16_f32 %0, %1, %2" : "=v"(r) : "v"(lo), "v"(hi)); return r; }
__device__ __forceinline__ float bf2f(unsigned b) { return __builtin_bit_cast(float, b << 16); }
__device__ __forceinline__ float bflo(unsigned w) { return __builtin_bit_cast(float, w << 16); }
__device__ __forceinline__ float bfhi(unsigned w) { return __builtin_bit_cast(float, w & 0xffff0000u); }
struct U2 { unsigned x, y; };
__device__ __forceinline__ U2 swap32(float v) { const unsigned a = __builtin_bit_cast(unsigned, v); const auto r = __builtin_amdgcn_permlane32_swap(a, a, false, false); U2 o; o.x = r[0]; o.y = r[1]; return o; }
__device__ __forceinline__ U2 swap16(float v) { const unsigned a = __builtin_bit_cast(unsigned, v); const auto r = __builtin_amdgcn_permlane16_swap(a, a, false, false); U2 o; o.x = r[0]; o.y = r[1]; return o; }
__device__ __forceinline__ float lane_xor(float v, int lane, int o) {
    const int x = __builtin_bit_cast(int, v);
    if (o == 1) return __builtin_bit_cast(float, __builtin_amdgcn_update_dpp(0, x, 0xB1, 0xF, 0xF, true));
    if (o == 2) return __builtin_bit_cast(float, __builtin_amdgcn_update_dpp(0, x, 0x4E, 0xF, 0xF, true));
    if (o == 4) { const int t = __builtin_amdgcn_update_dpp(0, x, 0x141, 0xF, 0xF, true); return __builtin_bit_cast(float, __builtin_amdgcn_update_dpp(0, t, 0x1B, 0xF, 0xF, true)); }
    if (o == 8) return __builtin_bit_cast(float, __builtin_amdgcn_update_dpp(0, x, 0x128, 0xF, 0xF, true));
    if (o == 16) { const U2 r = swap16(v); return __builtin_bit_cast(float, (lane & 16) ? r.x : r.y); }
    { const U2 r = swap32(v); return __builtin_bit_cast(float, (lane & 32) ? r.x : r.y); }
}
__device__ __forceinline__ float pair32_max(float v) { const U2 r = swap32(v); return fmaxf(__builtin_bit_cast(float, r.x), __builtin_bit_cast(float, r.y)); }
__device__ __forceinline__ float pair32_sum(float v) { const U2 r = swap32(v); return __builtin_bit_cast(float, r.x) + __builtin_bit_cast(float, r.y); }
__device__ __forceinline__ float wave_sum(float v, int lane) {
    (void)lane;
    v += __builtin_bit_cast(float, __builtin_amdgcn_update_dpp(0, __builtin_bit_cast(int, v), 0xB1, 0xF, 0xF, true));
    v += __builtin_bit_cast(float, __builtin_amdgcn_update_dpp(0, __builtin_bit_cast(int, v), 0x4E, 0xF, 0xF, true));
    v += __builtin_bit_cast(float, __builtin_amdgcn_update_dpp(0, __builtin_bit_cast(int, v), 0x141, 0xF, 0xF, true));
    v += __builtin_bit_cast(float, __builtin_amdgcn_update_dpp(0, __builtin_bit_cast(int, v), 0x140, 0xF, 0xF, true));
    { const U2 r = swap16(v); v = __builtin_bit_cast(float, r.x) + __builtin_bit_cast(float, r.y); }
    return pair32_sum(v);
}
__device__ __forceinline__ f32x16 zero16() { f32x16 z;
#pragma unroll
    for (int r = 0; r < 16; ++r) z[r] = 0.f;
    asm volatile("" : "+v"(z)); return z; }
__device__ __forceinline__ f32x4 zero4() { f32x4 z = (f32x4){0.f, 0.f, 0.f, 0.f}; asm volatile("" : "+v"(z)); return z; }
#define LDS_BARRIER() do { asm volatile("s_waitcnt lgkmcnt(0)" ::: "memory"); __builtin_amdgcn_s_barrier(); asm volatile("" ::: "memory"); } while (0)
#define LDS_WAIT() asm volatile("s_waitcnt lgkmcnt(0)" ::: "memory")
#define VM_WAIT() asm volatile("s_waitcnt vmcnt(0)" ::: "memory")

#define XB_TMO      128
#define XB_XCNT(j)  (256  + 64 * (j))
#define XB_XSUB(j)  (1280 + 64 * (j))
#define XB_XGEN(j)  (2304 + 64 * (j))
#define XB_TOP      3328
#define XB_TOPGEN   3392
#define XCD_BAR_WORDS 3456
#define XB_SPIN_CAP (1u << 18)

__device__ __forceinline__ unsigned xb_ld(unsigned* p)              { return __hip_atomic_load(p, __ATOMIC_RELAXED, __HIP_MEMORY_SCOPE_AGENT); }
__device__ __forceinline__ unsigned xb_add(unsigned* p, unsigned v) { return __hip_atomic_fetch_add(p, v, __ATOMIC_RELAXED, __HIP_MEMORY_SCOPE_AGENT); }
__device__ __forceinline__ unsigned xb_xcc_id() { return (unsigned)__builtin_amdgcn_s_getreg((3 << 11) | 20) & 0xFu; }
#define XB_SPIN(cond, bar) do { unsigned _sp = 0; while (cond) { __builtin_amdgcn_s_sleep(1); \
    if ((++_sp & 255u) == 0u) { if (xb_ld(&(bar)[XB_TMO])) break; if (_sp > XB_SPIN_CAP) { atomicAdd(&(bar)[XB_TMO], 1u); break; } } } } while (0)

struct XcdBarrier {
    unsigned* bar; unsigned x;
    volatile LAS unsigned* st;
};

__device__ __forceinline__ XcdBarrier xcd_barrier_post(unsigned* bar, volatile LAS unsigned* st) {
    XcdBarrier b; b.bar = bar; b.x = xb_xcc_id(); b.st = st;
    if (threadIdx.x == 0) (void)xb_add(&bar[XB_XCNT(b.x)], 1u);
    return b;
}
__device__ __forceinline__ void xcd_barrier_complete(unsigned* bar, unsigned x, unsigned& nloc, unsigned& nx) {
    const unsigned G = gridDim.x * gridDim.y * gridDim.z;
    unsigned sum, cnt, mine, sp = 0u;
    for (;;) {
        sum = 0u; cnt = 0u; mine = 0u;
#pragma unroll
        for (unsigned j = 0; j < 16; ++j) { const unsigned c = xb_ld(&bar[XB_XCNT(j)]); sum += c; cnt += (c > 0u) ? 1u : 0u; mine = (j == x) ? c : mine; }
        if (sum == G) break;
        __builtin_amdgcn_s_sleep(1);
        if ((++sp & 255u) == 0u) { if (xb_ld(&bar[XB_TMO])) break; if (sp > XB_SPIN_CAP) { atomicAdd(&bar[XB_TMO], 1u); break; } }
    }
    nloc = mine > 0u ? mine : 1u; nx = cnt > 0u ? cnt : 1u;
}

__device__ __forceinline__ void xcd_barrier(const XcdBarrier& b) {
    asm volatile("s_waitcnt vmcnt(0)" ::: "memory");
    __syncthreads();
    if (threadIdx.x == 0) {
        unsigned* bar = b.bar;
        __builtin_amdgcn_s_waitcnt(0);
        unsigned nloc = b.st[0], nx = b.st[1];
        if (nloc == 0u) { xcd_barrier_complete(bar, b.x, nloc, nx); b.st[0] = nloc; b.st[1] = nx; }
        const unsigned old = xb_add(&bar[XB_XSUB(b.x)], 1u);
        const unsigned gen = old / nloc;
        if (old + 1u == (gen + 1u) * nloc) {
            __builtin_amdgcn_fence(__ATOMIC_RELEASE, "agent");
            asm volatile("s_waitcnt vmcnt(0)" ::: "memory");
            const unsigned og = xb_add(&bar[XB_TOP], 1u);
            const unsigned tg = og / nx;
            if (og + 1u == (tg + 1u) * nx) xb_add(&bar[XB_TOPGEN], 1u);
            else XB_SPIN(xb_ld(&bar[XB_TOPGEN]) == tg, bar);
            __builtin_amdgcn_fence(__ATOMIC_ACQUIRE, "agent");
            xb_add(&bar[XB_XGEN(b.x)], 1u);
            asm volatile("s_waitcnt vmcnt(0)" ::: "memory");
        } else {
            XB_SPIN(xb_ld(&bar[XB_XGEN(b.x)]) == gen, bar);
            __builtin_amdgcn_fence(__ATOMIC_ACQUIRE, "agent");
            asm volatile("s_waitcnt vmcnt(0)" ::: "memory");
        }
    }
    __syncthreads();
}

struct Params { const GAS float* in[38]; GAS float* out; GAS unsigned char* ws; int ph_lo, ph_hi; };
enum { I_X = 0, I_C, I_CTX, I_CCTX, I_N1G, I_N2G, I_ADAW, I_ADAB, I_WIN, I_WOUT, I_MIXG, I_HCW, I_HCB, I_HW1, I_HB1, I_HF1, I_HW2, I_HB2, I_HF2, I_HW3, I_HBIAS, I_SINK,
       I_LRE, I_LIM, I_LDT, I_BRE, I_BIM, I_CRE, I_CIM, I_S5D, I_GLUW, I_GLUB, I_RW, I_RB, I_WG, I_WU, I_WD, I_FG };

struct Frame {
    LAS unsigned char* lds;
    GAS unsigned* ctl;
    GAS unsigned char* ws;
    const GAS float* const* in;
    GAS float* out;
    int tid, lane, wave, G, bid, z;
};

#define LAUNDER(F) do { asm volatile("s_mov_b32 %0, 0" : "=s"((F).z)); asm volatile("" : "+s"((F).ws), "+s"((F).lds), "+v"((F).tid), "+v"((F).lane)); (F).ctl = (GAS unsigned*)((F).ws + WS_CTL); } while (0)
__device__ __forceinline__ int wq_next(Frame& F, int qid) {
    volatile LAS unsigned* m = (volatile LAS unsigned*)(F.lds + LDS_MISC);
    __syncthreads();
    if (F.tid == 0) m[4] = __hip_atomic_fetch_add(F.ctl + CW_WQ + 64 * qid, 1u, __ATOMIC_RELAXED, __HIP_MEMORY_SCOPE_AGENT);
    __syncthreads();
    return __builtin_amdgcn_readfirstlane((int)m[4]);
}
namespace pg8 {
#define PG8_LAS __attribute__((address_space(3)))
typedef unsigned short bf16_t;
constexpr int BM = 256, BK = 64, HALF = 128, HTB = HALF * BK * 2  , STAGE_BYTES = 8 * HTB, NXCD = 8, WGM = 8;
constexpr size_t ROWB = 2048;
constexpr int GATHER_TAB = 131072;

__host__ __device__ __forceinline__ int lds_byte(int r, int c) { const int st = (r >> 4) * 2 + (c >> 5), rr = r & 15, cc = c & 31, ob = rr * 64 + cc * 2; return st * 1024 + (ob ^ (((ob >> 9) & 1) << 5)); }
__host__ __device__ __forceinline__ void stage_rc(int b, int& R, int& C) { const int st = b / 1024, sb = b % 1024, swz = sb ^ (((sb >> 9) & 1) << 5); R = (st >> 1) * 16 + swz / 64; C = (st & 1) * 32 + (swz % 64) / 2; }
__host__ __device__ __forceinline__ int perm32(int rho) { const int n = rho >> 4, i = rho & 15; return 8 * (i >> 2) + 4 * n + (i & 3); }

struct Unit { const GAS char* A; const GAS char* B0; const GAS char* B1; int i0, i1, i2, i3; };

struct StaticOrder {
    int nM, nN, nwg, G, c;
    __device__ void init(int M, int N, int G_, int c_) { nM = M / BM; nN = N / BM; nwg = nM * nN; G = G_; c = c_; }
    __device__ bool next(int i, int& pm, int& pn) const {
        const long L = (long)i * G + c; if (L >= nwg) return false;
        int wgid = (int)L; { const int q = nwg / NXCD, r = nwg % NXCD, xcd = wgid % NXCD, off = wgid / NXCD; wgid = (xcd < r ? xcd * (q + 1) : r * (q + 1) + (xcd - r) * q) + off; }
        const int nig = WGM * nN, gid = wgid / nig, fm = gid * WGM, gsz = (nM - fm) < WGM ? (nM - fm) : WGM;
        pm = fm + ((wgid % nig) % gsz); pn = (wgid % nig) / gsz; return true;
    }
};
__device__ __forceinline__ unsigned cvt_pk_bf16(float lo, float hi) { unsigned r; asm volatile("v_cvt_pk_bf16_f32 %0, %1, %2" : "=v"(r) : "v"(lo), "v"(hi)); return r; }

typedef int i32x8 __attribute__((ext_vector_type(8)));
typedef int i32x4v __attribute__((ext_vector_type(4)));
__device__ __forceinline__ i32x8 cat8(bf16x8 lo, bf16x8 hi) { const i32x4v a = __builtin_bit_cast(i32x4v, lo), b = __builtin_bit_cast(i32x4v, hi); return __builtin_shufflevector(a, b, 0, 1, 2, 3, 4, 5, 6, 7); }
template <class Epi, class Sched>
__device__ __forceinline__ void gemm_phase(PG8_LAS unsigned char* lds, const Sched& S, const Epi& E, const int tid) {
    constexpr bool STAMP = false; unsigned long long* stamps = nullptr;
    const int wid = __builtin_amdgcn_readfirstlane(tid >> 6), lane = tid & 63, wr = wid >> 2, wc = wid & 3, fr = lane & 15, fq = lane >> 4;
    constexpr bool F8 = Sched::FP8;
    constexpr int KB = F8 ? 1024 : 2048  , nt = KB / 128;
    int ts_lo = 0, ts_hi = 0, nts = 0; const unsigned long long rt_entry = STAMP ? (unsigned long long)wall_clock64() : 0ull;
#define PG8_STAMP() do { if (STAMP && wid == 0 && nts < 64) { const unsigned long long _c = (unsigned long long)clock64(); \
        ts_lo = (lane == nts) ? (int)(unsigned)_c : ts_lo; ts_hi = (lane == nts) ? (int)(unsigned)(_c >> 32) : ts_hi; ++nts; } } while (0)
    PG8_STAMP();
    unsigned voffA[2], voffB[2];
#pragma unroll
    for (int i = 0; i < 2; ++i) { int R, C; stage_rc(tid * 16 + i * 8192, R, C); const int Rb = Epi::PERM ? ((R & ~31) + perm32(R & 31)) : R;
        voffA[i] = (unsigned)(R * KB + C * 2); voffB[i] = (unsigned)(Rb * KB + C * 2); }
    int gR[2], gC[2];
#pragma unroll
    for (int i = 0; i < 2; ++i) { int R, C; stage_rc(tid * 16 + i * 8192, R, C); gR[i] = R; gC[i] = C * 2; }
    unsigned vA[2][2], vN[2][2];
#define PG8_GLOAD(dst, k) do { const PG8_LAS unsigned* t_ = (const PG8_LAS unsigned*)(lds + GATHER_TAB + 1024 * (k)); _Pragma("unroll") for (int h_ = 0; h_ < 2; ++h_) _Pragma("unroll") for (int i_ = 0; i_ < 2; ++i_) dst[h_][i_] = t_[h_ * 128 + gR[i_]] + (unsigned)gC[i_]; } while (0)
#define PG8_APTR(base, half) ((base) + (Sched::GATHER ? (size_t)0 : (size_t)(half) * hstep))
#pragma unroll
    for (int h = 0; h < 2; ++h)
#pragma unroll
        for (int i = 0; i < 2; ++i) { vA[h][i] = voffA[i]; vN[h][i] = voffA[i]; }
    const size_t kstep = (size_t)(BK * 2);
    const size_t hstep = (size_t)HALF * KB;
    const unsigned ldsw = (unsigned)wid * 1024u;
    const int aoff = F8 ? lds_byte(wr * 64 + fr, fq * 16) : lds_byte(wr * 64 + fr, fq * 8), boff = F8 ? lds_byte(wc * 32 + fr, fq * 16) : lds_byte(wc * 32 + fr, fq * 8);

#define PG8_SA(b, h) (((b) * 2 + (h)) * HTB)
#define PG8_SB(b, h) ((4 + (b) * 2 + (h)) * HTB)
#define PG8_STAGE(bufoff, gbase, voff) do { _Pragma("unroll") for (int _i = 0; _i < 2; ++_i) \
        __builtin_amdgcn_global_load_lds((const GAS unsigned*)((gbase) + (voff)[_i]), (PG8_LAS unsigned*)(lds + (bufoff) + ldsw + _i * 8192), 16, 0, 0); } while (0)
#define PG8_LDA(dst, b, h) do { _Pragma("unroll") for (int m = 0; m < 4; ++m) { if constexpr (F8) dst##8[m] = cat8(*(const PG8_LAS bf16x8*)(lds + PG8_SA(b, h) + aoff + m * 2048), *(const PG8_LAS bf16x8*)(lds + PG8_SA(b, h) + aoff + m * 2048 + 16)); \
        else { _Pragma("unroll") for (int k = 0; k < 2; ++k) dst[m][k] = *(const PG8_LAS bf16x8*)(lds + PG8_SA(b, h) + aoff + m * 2048 + k * 1024); } } } while (0)
#define PG8_LDB(dst, b, h) do { _Pragma("unroll") for (int n = 0; n < 2; ++n) { if constexpr (F8) dst##8[n] = cat8(*(const PG8_LAS bf16x8*)(lds + PG8_SB(b, h) + boff + n * 2048), *(const PG8_LAS bf16x8*)(lds + PG8_SB(b, h) + boff + n * 2048 + 16)); \
        else { _Pragma("unroll") for (int k = 0; k < 2; ++k) dst[n][k] = *(const PG8_LAS bf16x8*)(lds + PG8_SB(b, h) + boff + n * 2048 + k * 1024); } } } while (0)
#define PG8_MMA(ai, bj, At, Bt) do { __builtin_amdgcn_s_setprio(1); _Pragma("unroll") for (int m = 0; m < 4; ++m) _Pragma("unroll") for (int n = 0; n < 2; ++n) { \
        if constexpr (F8) asm volatile("v_mfma_scale_f32_16x16x128_f8f6f4 %0, %1, %2, %0, %3, %3 op_sel_hi:[0,0,0]" : "+v"(acc[ai][bj][m][n]) : "v"(Bt##8[n]), "v"(At##8[m]), "v"(sc1));   \
        else { _Pragma("unroll") for (int k = 0; k < 2; ++k) acc[ai][bj][m][n] = __builtin_amdgcn_mfma_f32_16x16x32_bf16(Bt[n][k], At[m][k], acc[ai][bj][m][n], 0, 0, 0); } } __builtin_amdgcn_s_setprio(0); } while (0)
#define PG8_WAIT_V(n) asm volatile("s_waitcnt vmcnt(" #n ")" ::: "memory")
#define PG8_WAIT_L(n) asm volatile("s_waitcnt lgkmcnt(" #n ")" ::: "memory")
#define PG8_BAR __builtin_amdgcn_s_barrier()
#define PG8_SCHED __builtin_amdgcn_sched_barrier(0)
    Unit cur, nxt; int ui = 0;
    if (!S.next(0, cur)) return;
    f32x4 acc[2][2][4][2];
#pragma unroll
    for (int a = 0; a < 2; ++a)
#pragma unroll
        for (int b = 0; b < 2; ++b)
#pragma unroll
            for (int m = 0; m < 4; ++m)
#pragma unroll
                for (int n = 0; n < 2; ++n) acc[a][b][m][n] = (f32x4){0.f, 0.f, 0.f, 0.f};
    const int sc1 = 0x7F7F7F7F;
    bf16x8 At[4][2], B0[2][2], B1[2][2]; i32x8 At8[4], B08[2], B18[2];
    const GAS char* cA = cur.A; const GAS char* cB0 = cur.B0; const GAS char* cB1 = cur.B1;
    S.a_ready(cur);
    if (Sched::GATHER) { PG8_GLOAD(vA, 0); }
    PG8_STAGE(PG8_SB(0, 0), cB0, voffB); PG8_STAGE(PG8_SA(0, 0), PG8_APTR(cA, 0), vA[0]); PG8_STAGE(PG8_SB(0, 1), cB1, voffB); PG8_STAGE(PG8_SA(0, 1), PG8_APTR(cA, 1), vA[1]);
    if (wr == 1) PG8_BAR;
    PG8_WAIT_V(4); PG8_BAR;
    PG8_STAGE(PG8_SB(1, 0), cB0 + kstep, voffB); PG8_STAGE(PG8_SA(1, 0), PG8_APTR(cA + kstep, 0), vA[0]); PG8_STAGE(PG8_SB(1, 1), cB1 + kstep, voffB);
    PG8_WAIT_V(6); PG8_BAR;
    PG8_STAMP();
    for (;;) {
        const bool has_next = S.next(ui + 1, nxt);
        if (Sched::GATHER && has_next) { PG8_GLOAD(vN, ui + 1); }
        const GAS char* nA = has_next ? nxt.A : cA; const GAS char* nB0 = has_next ? nxt.B0 : cB0; const GAS char* nB1 = has_next ? nxt.B1 : cB1;
#pragma unroll 1
        for (int t = 0; t < nt; t += 2) {
            const bool last = (t == nt - 2);
            const GAS char* a1 = cA + (size_t)(t + 1) * kstep;
            const GAS char* a2 = last ? nA : cA + (size_t)(t + 2) * kstep; const GAS char* b2 = last ? nB0 : cB0 + (size_t)(t + 2) * kstep; const GAS char* c2 = last ? nB1 : cB1 + (size_t)(t + 2) * kstep;
            const GAS char* a3 = a2 + kstep; const GAS char* b3 = b2 + kstep; const GAS char* c3 = c2 + kstep;
            if (last && has_next) S.a_ready(nxt);
            unsigned vS[2][2];
#pragma unroll
            for (int h = 0; h < 2; ++h)
#pragma unroll
                for (int i = 0; i < 2; ++i) vS[h][i] = (Sched::GATHER && last && has_next) ? vN[h][i] : vA[h][i];
            PG8_LDB(B0, 0, 0); PG8_SCHED; PG8_LDA(At, 0, 0); PG8_STAGE(PG8_SA(1, 1), PG8_APTR(a1, 1), vA[1]);
            PG8_WAIT_L(8); PG8_BAR; PG8_WAIT_L(0); PG8_MMA(0, 0, At, B0); PG8_BAR; PG8_SCHED;
            PG8_LDB(B1, 0, 1); PG8_STAGE(PG8_SB(0, 0), b2, voffB);
            PG8_BAR; PG8_WAIT_L(0); PG8_MMA(0, 1, At, B1); PG8_BAR;
            PG8_LDA(At, 0, 1); PG8_STAGE(PG8_SA(0, 0), PG8_APTR(a2, 0), vS[0]);
            PG8_BAR; PG8_WAIT_L(0); PG8_MMA(1, 0, At, B0); PG8_BAR; PG8_SCHED;
            PG8_STAGE(PG8_SB(0, 1), c2, voffB);
            PG8_WAIT_V(6); PG8_BAR; PG8_MMA(1, 1, At, B1); PG8_BAR;
            PG8_LDB(B0, 1, 0); PG8_SCHED; PG8_LDA(At, 1, 0); PG8_STAGE(PG8_SA(0, 1), PG8_APTR(a2, 1), vS[1]);
            PG8_WAIT_L(8); PG8_BAR; PG8_WAIT_L(0); PG8_MMA(0, 0, At, B0); PG8_BAR; PG8_SCHED;
            PG8_LDB(B1, 1, 1); PG8_STAGE(PG8_SB(1, 0), b3, voffB);
            PG8_BAR; PG8_WAIT_L(0); PG8_MMA(0, 1, At, B1); PG8_BAR;
            PG8_LDA(At, 1, 1); PG8_STAGE(PG8_SA(1, 0), PG8_APTR(a3, 0), vS[0]);
            PG8_BAR; PG8_WAIT_L(0); PG8_MMA(1, 0, At, B0); PG8_BAR; PG8_SCHED;
            PG8_STAGE(PG8_SB(1, 1), c3, voffB);
            PG8_WAIT_V(6); PG8_BAR; PG8_MMA(1, 1, At, B1); PG8_BAR;
        }
        PG8_STAMP();
        if constexpr (F8) asm volatile("s_nop 15\n\ts_nop 7" ::: "memory");
        if constexpr (!Epi::AFTER_DRAIN) { E(acc, cur, wr, wc, fr, fq); S.done(cur); }
        PG8_STAMP();
        if (!has_next) break;
#pragma unroll
        for (int a = 0; a < 2; ++a)
#pragma unroll
            for (int b = 0; b < 2; ++b)
#pragma unroll
                for (int m = 0; m < 4; ++m)
#pragma unroll
                    for (int n = 0; n < 2; ++n) acc[a][b][m][n] = (f32x4){0.f, 0.f, 0.f, 0.f};
        cur = nxt; cA = nA; cB0 = nB0; cB1 = nB1; ++ui;
#pragma unroll
        for (int h = 0; h < 2; ++h)
#pragma unroll
            for (int i = 0; i < 2; ++i) vA[h][i] = vN[h][i];
    }
    PG8_WAIT_V(0);
    if (wr == 0) PG8_BAR;
    PG8_BAR;
    if constexpr (Epi::AFTER_DRAIN) { E.fused(acc, cur, wr, wc, fr, fq, lds, wid, lane); S.done(cur); }
    PG8_STAMP();
    if (STAMP && wid == 0) { stamps[lane] = lane < nts ? (((unsigned long long)(unsigned)ts_hi << 32) | (unsigned)ts_lo) : 0ull;
        if (lane == 62) stamps[62] = rt_entry; if (lane == 63) stamps[63] = (unsigned long long)wall_clock64(); }
#undef PG8_STAMP
#undef PG8_SA
#undef PG8_SB
#undef PG8_STAGE
#undef PG8_GLOAD
#undef PG8_APTR
#undef PG8_LDA
#undef PG8_LDB
#undef PG8_MMA
#undef PG8_WAIT_V
#undef PG8_WAIT_L
#undef PG8_BAR
#undef PG8_SCHED
}
}

struct SchedStd {
    static constexpr bool GATHER = false, FP8 = false;
    pg8::StaticOrder so; const GAS char* A; const GAS char* Bt; int row_off;
    __device__ __forceinline__ bool next(int i, pg8::Unit& u) const {
        int pm, pn; if (!so.next(i, pm, pn)) return false;
        u.A = A + (size_t)(pm * 256 + row_off) * pg8::ROWB; u.B0 = Bt + (size_t)pn * 256 * pg8::ROWB; u.B1 = u.B0 + 128 * pg8::ROWB; u.i0 = pm * 256 + row_off; u.i1 = pn * 256; u.i2 = 0; u.i3 = 0; return true;
    }
    __device__ __forceinline__ void a_ready(const pg8::Unit&) const {}
    __device__ __forceinline__ void done(const pg8::Unit&) const {}
};
struct SchedStd8 {
    static constexpr bool GATHER = false, FP8 = true;
    pg8::StaticOrder so; const GAS char* A; const GAS char* Bt; int row_off;
    __device__ __forceinline__ bool next(int i, pg8::Unit& u) const {
        int pm, pn; if (!so.next(i, pm, pn)) return false;
        u.A = A + (size_t)(pm * 256 + row_off) * 1024; u.B0 = Bt + (size_t)pn * 256 * 1024; u.B1 = u.B0 + 128 * 1024; u.i0 = pm * 256 + row_off; u.i1 = pn * 256; u.i2 = 0; u.i3 = 0; return true;
    }
    __device__ __forceinline__ void a_ready(const pg8::Unit&) const {}
    __device__ __forceinline__ void done(const pg8::Unit&) const {}
};
template <int DOWN> struct SchedMoe {
    static constexpr bool GATHER = (DOWN == 0);
    static constexpr bool FP8 = true;
    static constexpr size_t RB = 1024;
    const volatile LAS int* tab; int G, c; const GAS char* A; const GAS char* W0; const GAS char* W1;
    __device__ __forceinline__ bool next(int i, pg8::Unit& u) const {
        constexpr int NT = DOWN ? 4 : 8;
        const int L = i * G + c, total = __builtin_amdgcn_readfirstlane(tab[16]) * NT; if (L >= total) return false;
        const int nt = L % NT, mg = L / NT; int e = 0;
        for (int k = 1; k < 16; ++k) e += (mg >= __builtin_amdgcn_readfirstlane(tab[k])) ? 1 : 0;
        const int mt = mg - __builtin_amdgcn_readfirstlane(tab[e]);
        u.A = GATHER ? A : A + (size_t)mg * 256 * RB;
        if (DOWN) { u.B0 = W0 + ((size_t)e * 1024 + 256 * nt) * RB; u.B1 = u.B0 + 128 * RB; u.i0 = e * ECAP + 256 * mt; u.i1 = 256 * nt; u.i2 = __builtin_amdgcn_readfirstlane(tab[32 + e]) - 256 * mt; u.i3 = 0; }
        else      { u.B0 = W0 + ((size_t)e * 1024 + 128 * nt) * RB; u.B1 = W1 + ((size_t)e * 1024 + 128 * nt) * RB; u.i0 = 256 * mg; u.i1 = 128 * nt; u.i2 = 0; u.i3 = 0; }
        return true;
    }
    __device__ __forceinline__ void a_ready(const pg8::Unit&) const {}
    __device__ __forceinline__ void done(const pg8::Unit&) const {}
};
struct EpiP {
    static constexpr bool PERM = true, AFTER_DRAIN = false;
    GAS bf16* O; int ldc;
    __device__ __forceinline__ void operator()(const f32x4 (&acc)[2][2][4][2], const pg8::Unit& u, int wr, int wc, int fr, int fq) const {
        const int row0 = u.i0 + wr * 64 + fr, col0 = u.i1 + wc * 32 + 8 * fq;
#pragma unroll
        for (int ai = 0; ai < 2; ++ai)
#pragma unroll
            for (int m = 0; m < 4; ++m) { GAS bf16* rowp = O + (size_t)(row0 + ai * 128 + m * 16) * ldc + col0;
#pragma unroll
                for (int bj = 0; bj < 2; ++bj) { const f32x4 v0 = acc[ai][bj][m][0], v1 = acc[ai][bj][m][1];
                    u32x4 w; w.x = pg8::cvt_pk_bf16(v0[0], v0[1]); w.y = pg8::cvt_pk_bf16(v0[2], v0[3]); w.z = pg8::cvt_pk_bf16(v1[0], v1[1]); w.w = pg8::cvt_pk_bf16(v1[2], v1[3]);
                    *(GAS u32x4*)(rowp + bj * 128) = w; }
                asm volatile("" ::: "memory"); }
    }
};
constexpr float W8_SCALE = 64.0f, W8_INV = 1.0f / 64.0f;
struct EpiOut {
    static constexpr bool PERM = true, AFTER_DRAIN = false;
    GAS bf16* O; const GAS float* mod_l;
    __device__ __forceinline__ void operator()(const f32x4 (&acc)[2][2][4][2], const pg8::Unit& u, int wr, int wc, int fr, int fq) const {
        const int row0 = u.i0 + wr * 64 + fr, col0 = u.i1 + wc * 32 + 8 * fq;
        const int bidx = u.i0 < NCTX ? 8 : (u.i0 - NCTX) / SEQ;
        const GAS float* g1 = mod_l + bidx * 6144 + 2 * 1024 + col0;
        f32x4 gv[2][2];
#pragma unroll
        for (int bj = 0; bj < 2; ++bj)
#pragma unroll
            for (int n = 0; n < 2; ++n) gv[bj][n] = *(const GAS f32x4*)(g1 + bj * 128 + 4 * n) * W8_INV;
#pragma unroll
        for (int ai = 0; ai < 2; ++ai)
#pragma unroll
            for (int m = 0; m < 4; ++m) { GAS bf16* rowp = O + (size_t)(row0 + ai * 128 + m * 16) * D + col0;
#pragma unroll
                for (int bj = 0; bj < 2; ++bj) { const f32x4 v0 = acc[ai][bj][m][0] * gv[bj][0], v1 = acc[ai][bj][m][1] * gv[bj][1];
                    u32x4 w; w.x = pg8::cvt_pk_bf16(v0[0], v0[1]); w.y = pg8::cvt_pk_bf16(v0[2], v0[3]); w.z = pg8::cvt_pk_bf16(v1[0], v1[1]); w.w = pg8::cvt_pk_bf16(v1[2], v1[3]);
                    *(GAS u32x4*)(rowp + bj * 128) = w; }
                asm volatile("" ::: "memory"); }
    }
};
__device__ __forceinline__ float silu_mul(float g, float u) { return g * u * __builtin_amdgcn_rcpf(1.0f + __expf(-g)); }
__device__ __forceinline__ unsigned pk4_fp8(float a, float b, float c, float d) { int r = 0; r = __builtin_amdgcn_cvt_pk_fp8_f32(a, b, r, false); r = __builtin_amdgcn_cvt_pk_fp8_f32(c, d, r, true); return (unsigned)r; }
__device__ __forceinline__ f32x4 silu_mul4(f32x4 g, f32x4 u) {
    const f32x4 ea = g * (-1.4426950408889634f * W8_INV);
    f32x4 e;
#pragma unroll
    for (int i = 0; i < 4; ++i) e[i] = __builtin_amdgcn_exp2f(ea[i]);
    const f32x4 d = e + 1.0f;
    f32x4 r;
#pragma unroll
    for (int i = 0; i < 4; ++i) r[i] = __builtin_amdgcn_rcpf(d[i]);
    return (g * u) * (r * (W8_INV * W8_INV));
}
struct EpiUp {
    static constexpr bool PERM = true, AFTER_DRAIN = false;
    GAS unsigned char* ACT;
    __device__ __forceinline__ void operator()(const f32x4 (&acc)[2][2][4][2], const pg8::Unit& u, int wr, int wc, int fr, int fq) const {
        const int row0 = u.i0 + wr * 64 + fr, col0 = u.i1 + wc * 32 + 8 * fq;
#pragma unroll
        for (int ai = 0; ai < 2; ++ai)
#pragma unroll
            for (int m = 0; m < 4; ++m) { GAS unsigned char* rowp = ACT + (size_t)(row0 + ai * 128 + m * 16) * 1024 + col0;
                const f32x4 s0 = silu_mul4(acc[ai][0][m][0], acc[ai][1][m][0]), s1 = silu_mul4(acc[ai][0][m][1], acc[ai][1][m][1]);
                u32x2 w; w.x = pk4_fp8(s0[0], s0[1], s0[2], s0[3]); w.y = pk4_fp8(s1[0], s1[1], s1[2], s1[3]);
                *(GAS u32x2*)rowp = w; asm volatile("" ::: "memory"); }
    }
};
struct EpiDown {
    static constexpr bool PERM = true, AFTER_DRAIN = false;
    GAS bf16* YB; const GAS unsigned* elist; const GAS float* wlist;
    __device__ __forceinline__ void operator()(const f32x4 (&acc)[2][2][4][2], const pg8::Unit& u, int wr, int wc, int fr, int fq) const {
        const int rl0 = wr * 64 + fr, col0 = u.i1 + wc * 32 + 8 * fq;
        unsigned ent[2][4]; float wv[2][4];
#pragma unroll
        for (int ai = 0; ai < 2; ++ai)
#pragma unroll
            for (int m = 0; m < 4; ++m) { const int rl = rl0 + ai * 128 + m * 16, idx = u.i0 + (rl < u.i2 ? rl : 0); ent[ai][m] = elist[idx]; wv[ai][m] = wlist[idx]; }
        asm volatile("" ::: "memory");
#pragma unroll
        for (int ai = 0; ai < 2; ++ai)
#pragma unroll
            for (int m = 0; m < 4; ++m) { const int rl = rl0 + ai * 128 + m * 16;
                if (rl < u.i2) { const float w = wv[ai][m] * W8_INV; GAS bf16* rowp = YB + (size_t)ent[ai][m] * D + col0;
#pragma unroll
                    for (int bj = 0; bj < 2; ++bj) { const f32x4 v0 = acc[ai][bj][m][0] * w, v1 = acc[ai][bj][m][1] * w;
                        u32x4 o; o.x = pg8::cvt_pk_bf16(v0[0], v0[1]); o.y = pg8::cvt_pk_bf16(v0[2], v0[3]); o.z = pg8::cvt_pk_bf16(v1[0], v1[1]); o.w = pg8::cvt_pk_bf16(v1[2], v1[3]);
                        *(GAS u32x4*)(rowp + bj * 128) = o; } }
                asm volatile("" ::: "memory"); }
    }
};

__device__ __forceinline__ void transpose_item(const GAS float* W, int K, int N, GAS bf16* WT, LAS float* scr, int item, int lane) {
    const int nblk = N / 32, kb = item / nblk, nb = item % nblk, k0 = 64 * kb, n0 = 32 * nb;
    float wv[32];
#pragma unroll
    for (int i = 0; i < 32; ++i) wv[i] = W[(size_t)(k0 + 2 * i + (lane >> 5)) * N + n0 + (lane & 31)];
#pragma unroll
    for (int i = 0; i < 32; ++i) scr[(2 * i + (lane >> 5)) * 33 + (lane & 31)] = wv[i];
    LDS_WAIT(); asm volatile("" ::: "memory");
    const int c = lane & 7;
#pragma unroll
    for (int j = 0; j < 4; ++j) { const int n = (lane >> 3) + 8 * j; const LAS float* s = scr + (8 * c) * 33 + n;
        u32x4 o; o.x = pk2(s[0 * 33], s[1 * 33]); o.y = pk2(s[2 * 33], s[3 * 33]); o.z = pk2(s[4 * 33], s[5 * 33]); o.w = pk2(s[6 * 33], s[7 * 33]);
        *(GAS u32x4*)(WT + (size_t)(n0 + n) * K + k0 + 8 * c) = o; }
    LDS_WAIT(); asm volatile("" ::: "memory");
}

__device__ __forceinline__ void unit_mod(Frame& F, int u) {
    LAUNDER(F);
    const int l = u / 96, cb = u % 96, n0 = cb * 64;
    LAS float* sc = (LAS float*)F.lds;
    LAS float* red = sc + 9 * 1024;
    const GAS float* c = F.in[I_C + F.z]; const GAS float* cc = F.in[I_CCTX + F.z];
    for (int i = F.tid; i < 9 * 1024; i += 512) { const int r = i >> 10, k = i & 1023; const float v = r < 8 ? c[r * 1024 + k] : cc[k]; sc[i] = v / (1.0f + expf(-v)); }
    __syncthreads();
    const int col = F.tid & 63, ks = F.tid >> 6;
    float acc[9];
#pragma unroll
    for (int r = 0; r < 9; ++r) acc[r] = 0.f;
    const GAS float* w = F.in[I_ADAW + F.z] + ((size_t)l * 1024 + ks * 128) * 6144 + n0 + col;
#pragma unroll 1
    for (int k0 = 0; k0 < 128; k0 += 16) { float wv[16];
#pragma unroll
        for (int k = 0; k < 16; ++k) wv[k] = w[(size_t)(k0 + k) * 6144];
#pragma unroll
        for (int k = 0; k < 16; ++k)
#pragma unroll
            for (int r = 0; r < 9; ++r) acc[r] += sc[r * 1024 + ks * 128 + k0 + k] * wv[k]; }
#pragma unroll
    for (int r = 0; r < 9; ++r) red[(ks * 9 + r) * 64 + col] = acc[r];
    __syncthreads();
    GAS float* MOD = (GAS float*)(F.ws + WS_MOD);
    for (int i = F.tid; i < 9 * 64; i += 512) { const int r = i >> 6, cl = i & 63; float s = 0.f;
#pragma unroll
        for (int k = 0; k < 8; ++k) s += red[(k * 9 + r) * 64 + cl];
        MOD[((size_t)l * 9 + r) * 6144 + n0 + cl] = s + F.in[I_ADAB + F.z][l * 6144 + n0 + cl]; }
    __syncthreads();
}

__device__ __forceinline__ void unit_taps1(Frame& F, int u) {
    LAUNDER(F);
    const int l = u / 272, r = u % 272; const int Lsel = r >= 256 ? 1 : 0, blk = Lsel ? r - 256 : r, L = Lsel ? 256 : 4096, pos0 = blk * 16;
    LAS float* feats = (LAS float*)F.lds;
    LAS float* h1 = feats + 16 * 36;
    LAS float* h2 = h1 + 16 * 64;
    const float invLm1 = 1.0f / (float)(L - 1);
    for (int i = F.tid; i < 16 * 33; i += 512) { const int p = i / 33, f = i % 33; const float pos = (float)(pos0 + p); float v;
        if (f == 0) v = pos * invLm1;
        else { const int bi = (f - 1) & 15; const float band = 1e-4f + (float)bi * ((15.0f - 1e-4f) / 15.0f); const float ang = (float)(2.0 * 3.14159265358979323846 / (double)L) * pos * band;
            v = f <= 16 ? cosf(ang) : -sinf(ang); }
        feats[p * 36 + f] = v; }
    __syncthreads();
    for (int i = F.tid; i < 16 * 64; i += 512) { const int p = i >> 6, j = i & 63; float s = F.in[I_HB1 + F.z][l * 64 + j]; const GAS float* w1 = F.in[I_HW1 + F.z] + (size_t)l * 33 * 64 + j;
        for (int f = 0; f < 33; ++f) s += feats[p * 36 + f] * w1[f * 64];
        h1[p * 64 + j] = sinf(F.in[I_HF1 + F.z][l * 64 + j] * s); }
    __syncthreads();
    for (int i = F.tid; i < 16 * 64; i += 512) { const int p = i >> 6, j = i & 63; float s = F.in[I_HB2 + F.z][l * 64 + j]; const GAS float* w2 = F.in[I_HW2 + F.z] + (size_t)l * 64 * 64 + j;
        for (int k = 0; k < 64; ++k) s += h1[p * 64 + k] * w2[k * 64];
        h2[p * 64 + j] = sinf(F.in[I_HF2 + F.z][l * 64 + j] * s); }
    __syncthreads();
    float acc[2][16];
#pragma unroll
    for (int c = 0; c < 2; ++c)
#pragma unroll
        for (int p = 0; p < 16; ++p) acc[c][p] = 0.f;
    const GAS float* w3 = F.in[I_HW3 + F.z] + (size_t)l * 64 * 1024 + F.tid;
#pragma unroll 1
    for (int k0 = 0; k0 < 64; k0 += 8) { float wa[8], wb[8];
#pragma unroll
        for (int k = 0; k < 8; ++k) { wa[k] = w3[(k0 + k) * 1024]; wb[k] = w3[(k0 + k) * 1024 + 512]; }
#pragma unroll
        for (int k = 0; k < 8; ++k)
#pragma unroll
            for (int p = 0; p < 16; ++p) { const float hv = h2[p * 64 + k0 + k]; acc[0][p] += hv * wa[k]; acc[1][p] += hv * wb[k]; } }
    GAS float* RAW = (GAS float*)(F.ws + WS_U + (Lsel ? U_RAWC + (size_t)l * 256 * 1024 * 4 : U_RAWL + (size_t)l * 4096 * 1024 * 4));
    GAS float* PART = (GAS float*)(F.ws + WS_U + U_PART) + (size_t)(l * 2 + Lsel) * 256 * 1024;
#pragma unroll
    for (int c = 0; c < 2; ++c) { const int col = F.tid + 512 * c, order = col >> 9, dir = (col >> 8) & 1, ch = col & 255;
        const float decay = fabsf(-3.0701134573253944f + (float)ch * ((-15.350567286626973f + 3.0701134573253944f) / 255.0f)); float asum = 0.f;
#pragma unroll
        for (int p = 0; p < 16; ++p) { const int pos = pos0 + p; const float t = (float)pos * invLm1; const float v = acc[c][p] * expf(-t * decay);
            RAW[(size_t)pos * 1024 + col] = v; if (!(dir == 1 && pos == 0)) asum += fabsf(v); }
        PART[(size_t)blk * 1024 + col] = asum; }
    __syncthreads();
}

__device__ __forceinline__ void unit_taps2(Frame& F, int u) {
    LAUNDER(F);
    int Lsel, l, order, dir, cb, pb;
    if (u < 4096) { Lsel = 0; pb = u & 63; cb = (u >> 6) & 3; dir = (u >> 8) & 1; order = (u >> 9) & 1; l = u >> 10; }
    else { const int v = u - 4096; Lsel = 1; pb = v & 3; cb = (v >> 2) & 3; dir = (v >> 4) & 1; order = (v >> 5) & 1; l = v >> 6; }
    const int L = Lsel ? 256 : 4096, pos0 = pb * 64, ch0 = cb * 64, colb = order * 512 + dir * 256 + ch0;
    LAS float* tile = (LAS float*)F.lds;
    const GAS float* RAW = (const GAS float*)(F.ws + WS_U + (Lsel ? U_RAWC + (size_t)l * 256 * 1024 * 4 : U_RAWL + (size_t)l * 4096 * 1024 * 4));
    const GAS float* PART = (const GAS float*)(F.ws + WS_U + U_PART) + (size_t)(l * 2 + Lsel) * 256 * 1024; LAS float* nrm = tile + 64 * 65;
    { const int cc = F.tid & 63, pr = F.tid >> 6;
#pragma unroll
      for (int i = 0; i < 8; ++i) { const int p = pr + 8 * i; tile[p * 65 + cc] = RAW[(size_t)(pos0 + p) * 1024 + colb + cc]; } }
    { const int ch = F.tid >> 3, pc = F.tid & 7, nblk = Lsel ? 16 : 256; float sacc = 0.f;
#pragma unroll 8
      for (int bk = pc; bk < nblk; bk += 8) sacc += PART[(size_t)bk * 1024 + order * 512 + ch0 + ch] + PART[(size_t)bk * 1024 + order * 512 + 256 + ch0 + ch];
      nrm[ch * 8 + pc] = sacc; }
    __syncthreads();
    GAS bf16* TG = Lsel ? (GAS bf16*)(F.ws + WS_TGC) + ((size_t)(l * 2 + order) * 256) * 512 : (GAS bf16*)(F.ws + WS_TG) + ((size_t)(l * 2 + order) * 256) * 8192;
    { const int ch = F.tid >> 3, pc = F.tid & 7; const float inv = 1.0f / (((nrm[ch * 8 + 0] + nrm[ch * 8 + 1]) + (nrm[ch * 8 + 2] + nrm[ch * 8 + 3])) + ((nrm[ch * 8 + 4] + nrm[ch * 8 + 5]) + (nrm[ch * 8 + 6] + nrm[ch * 8 + 7])));
      GAS bf16* row = TG + (size_t)(ch0 + ch) * (2 * L);
#pragma unroll
      for (int j = 0; j < 8; ++j) { const int p = 8 * pc + j, pos = pos0 + p; const unsigned v = f2bf(tile[p * 65 + ch] * inv);
          if (dir == 0) row[L - pos] = (bf16)v;
          else { if (pos == 0) row[0] = 0; else row[L + pos] = (bf16)v; } } }
    __syncthreads();
}

__device__ __forceinline__ void unit_s5tab(Frame& F, int u) {
    LAUNDER(F);
    LAS float* co = (LAS float*)F.lds;
    const int idx = u;
    if (F.tid < 64) { const int p = F.tid;
        const double lr = (double)F.in[I_LRE + F.z][idx * 64 + p], li = (double)F.in[I_LIM + F.z][idx * 64 + p], dt = exp((double)F.in[I_LDT + F.z][idx]);
        const double mag = exp(lr * dt), ar = mag * cos(li * dt), ai = mag * sin(li * dt);
        const double nr = ar - 1.0, ni = ai, den = lr * lr + li * li;
        co[p] = (float)((nr * lr + ni * li) / den); co[64 + p] = (float)((ni * lr - nr * li) / den);
        const double m32 = exp(lr * dt * 32.0);
        GAS f32x2* AB = (GAS f32x2*)(F.ws + WS_S5T + S5_AB); GAS f32x2* A32 = (GAS f32x2*)(F.ws + WS_S5T + S5_A32);
        AB[idx * 64 + p] = (f32x2){(float)ar, (float)ai};
        A32[idx * 64 + p] = (f32x2){(float)(m32 * cos(li * dt * 32.0)), (float)(m32 * sin(li * dt * 32.0))}; }
    __syncthreads();
    GAS bf16* BbT = (GAS bf16*)(F.ws + WS_S5T + S5_BBT) + (size_t)idx * 2048; GAS bf16* CmT = (GAS bf16*)(F.ws + WS_S5T + S5_CMT) + (size_t)idx * 2048;
    for (int i = F.tid; i < 2048; i += 512) { const int n = i >> 4, c = i & 15, p = n & 63;
        const float br = F.in[I_BRE + F.z][((size_t)idx * 64 + p) * 16 + c], bi = F.in[I_BIM + F.z][((size_t)idx * 64 + p) * 16 + c];
        BbT[i] = (bf16)f2bf(n < 64 ? co[p] * br - co[64 + p] * bi : co[p] * bi + co[64 + p] * br); }
    for (int i = F.tid; i < 2048; i += 512) { const int c = i >> 7, n = i & 127, p = n & 63;
        CmT[i] = (bf16)f2bf(n < 64 ? F.in[I_CRE + F.z][((size_t)idx * 16 + c) * 64 + p] : -F.in[I_CIM + F.z][((size_t)idx * 16 + c) * 64 + p]); }
    __syncthreads();
}

__device__ __forceinline__ void transpose_item_fp8(const GAS float* W, int K, int N, GAS unsigned char* WT, LAS float* scr, int item, int lane) {
    const int nblk = N / 32, kb = item / nblk, nb = item % nblk, k0 = 64 * kb, n0 = 32 * nb;
    float wv[32];
#pragma unroll
    for (int i = 0; i < 32; ++i) wv[i] = W[(size_t)(k0 + 2 * i + (lane >> 5)) * N + n0 + (lane & 31)];
#pragma unroll
    for (int i = 0; i < 32; ++i) scr[(2 * i + (lane >> 5)) * 33 + (lane & 31)] = wv[i];
    LDS_WAIT(); asm volatile("" ::: "memory");
    const int c = lane & 7;
#pragma unroll
    for (int j = 0; j < 4; ++j) { const int n = (lane >> 3) + 8 * j; const LAS float* s = scr + (8 * c) * 33 + n;
        u32x2 o; o.x = pk4_fp8(s[0 * 33] * W8_SCALE, s[1 * 33] * W8_SCALE, s[2 * 33] * W8_SCALE, s[3 * 33] * W8_SCALE); o.y = pk4_fp8(s[4 * 33] * W8_SCALE, s[5 * 33] * W8_SCALE, s[6 * 33] * W8_SCALE, s[7 * 33] * W8_SCALE);
        *(GAS u32x2*)(WT + (size_t)(n0 + n) * K + k0 + 8 * c) = o; }
    LDS_WAIT(); asm volatile("" ::: "memory");
}
__device__ __forceinline__ void ph_prologue0(Frame& F) {
    { LAS float* scr = (LAS float*)(F.lds + F.wave * 8704);
      const int gw = F.bid * 8 + F.wave, NGW = F.G * 8;
      constexpr int I_IN = 16 * 56, I_OUT = 16 * 32, I_GLU = 4 * 8, PER_L = I_IN + I_OUT + I_GLU;
      for (int it = gw; it < DEPTH * PER_L; it += NGW) { const int l = it / PER_L; int r = it % PER_L;
          if (r < I_IN) { transpose_item(F.in[I_WIN + F.z] + (size_t)l * D * INW, D, INW, (GAS bf16*)(F.ws + WS_WIN) + (size_t)l * INW * D, scr, r, F.lane); continue; } r -= I_IN;
          if (r < I_OUT) { transpose_item_fp8(F.in[I_WOUT + F.z] + (size_t)l * D * D, D, D, (GAS unsigned char*)(F.ws + WS_WOUT) + (size_t)l * D * D, scr, r, F.lane); continue; } r -= I_OUT;
          transpose_item(F.in[I_GLUW + F.z] + (size_t)l * 256 * 256, 256, 256, (GAS bf16*)(F.ws + WS_S5T + S5_GLUT) + (size_t)l * 256 * 256, scr, r, F.lane); } }
    __syncthreads();
    for (int u = F.bid; u < 384 + 1088 + 128 + 1; u += F.G) {
        if (u < 384) unit_mod(F, u);
        else if (u < 384 + 1088) unit_taps1(F, u - 384);
        else if (u < 384 + 1088 + 128) unit_s5tab(F, u - 384 - 1088);
        else { GAS f32x2* ROPE = (GAS f32x2*)(F.ws + WS_S5T + S5_ROPE);
            for (int i = F.tid; i < 64 * 16; i += 512) { const int pos = i >> 4, j = i & 15; const double ang = (double)pos * pow(10000.0, -(double)j / 16.0); ROPE[i] = (f32x2){(float)cos(ang), (float)sin(ang)}; } }
    }
}
__device__ __forceinline__ void unit_wconv(Frame& F, int l, int u) {
    LAUNDER(F);
    LAS float* scr = (LAS float*)(F.lds + F.wave * 8704);
#pragma unroll 1
    for (int k = 0; k < 4; ++k) { const int it = u * 32 + k * 8 + F.wave; const int mat = it >> 9, r = it & 511, kind = mat >> 4, e = mat & 15;
        const GAS float* W = F.in[I_WG + kind + F.z] + ((size_t)l * 16 + e) * D * D;
        GAS unsigned char* WT = (GAS unsigned char*)(F.ws + wmoe_off(l) + (size_t)kind * 32 * MiB) + (size_t)e * D * D;
        transpose_item_fp8(W, D, D, WT, scr, r, F.lane); }
    __syncthreads();
}
__device__ __forceinline__ void ph_prologue1(Frame& F) {
    for (int u = F.bid; u < 4096 + 256; u += F.G) unit_taps2(F, u);
    for (;;) { const int u = wq_next(F, 16); if (u >= 768) break; unit_wconv(F, 0, u); }
}

#ifndef PROBE_NO_MOE
#define PROBE_NO_MOE 0
#endif
__device__ __forceinline__ int bidx_of_row(int row) { return row < NCTX ? 8 : (row - NCTX) / SEQ; }

__device__ __forceinline__ void ph_norm1(Frame& F, int l) {
    GAS bf16* XS = (GAS bf16*)(F.ws + WS_XS); GAS bf16* H = (GAS bf16*)(F.ws + WS_H); const GAS bf16* YB = (const GAS bf16*)(F.ws + WS_U + U_YB); const GAS float* MOD = (const GAS float*)(F.ws + WS_MOD);
    const int lane = F.lane, row_lo = (l == DEPTH) ? NCTX : 0, nrows = NTOK - row_lo, RPB = (nrows + F.G - 1) / F.G;
    const int rbeg = row_lo + F.bid * RPB, rend = (rbeg + RPB < NTOK) ? rbeg + RPB : NTOK;
    f32x4 vn[4]; u32x2 y0n[4], y1n[4];
    f32x4 ga[4], gb[4], g2v[4]; int cur_bi = -1;
#define N1_LOAD(r) do { const GAS float* src_ = ((r) < NCTX ? F.in[I_CTX + F.z] + (size_t)(r) * D : F.in[I_X + F.z] + (size_t)((r) - NCTX) * D); \
        _Pragma("unroll") for (int j = 0; j < 4; ++j) { const int col_ = 4 * lane + 256 * j; \
            if (l == 0) vn[j] = *(const GAS f32x4*)(src_ + col_); else { const u32x2 xb_ = *(const GAS u32x2*)(XS + (size_t)(r) * D + col_); vn[j] = (f32x4){bflo(xb_.x), bfhi(xb_.x), bflo(xb_.y), bfhi(xb_.y)}; } \
            if (l > 0) { y0n[j] = *(const GAS u32x2*)(YB + ((size_t)(r) * 2 + 0) * D + col_); y1n[j] = *(const GAS u32x2*)(YB + ((size_t)(r) * 2 + 1) * D + col_); } } } while (0)
    int row = rbeg + F.wave;
    if (row < rend) N1_LOAD(row);
    for (; row < rend; row += 8) {
        const int bi = bidx_of_row(row);
        if (bi != cur_bi) { cur_bi = bi;
#pragma unroll
            for (int j = 0; j < 4; ++j) { const int col = 4 * lane + 256 * j;
                if (l > 0) g2v[j] = *(const GAS f32x4*)(MOD + ((size_t)(l - 1) * 9 + bi) * 6144 + 5 * 1024 + col);
                if (l == DEPTH) { ga[j] = *(const GAS f32x4*)(F.in[I_FG + F.z] + col); gb[j] = (f32x4){0.f, 0.f, 0.f, 0.f}; }
                else { const GAS float* m = MOD + ((size_t)l * 9 + bi) * 6144; const f32x4 g = *(const GAS f32x4*)(F.in[I_N1G + F.z] + l * D + col), sh = *(const GAS f32x4*)(m + col), sc = *(const GAS f32x4*)(m + 1024 + col);
                    ga[j] = g * (sc + 1.0f); gb[j] = sh; } } }
        f32x4 v[4]; float ss = 0.f;
#pragma unroll
        for (int j = 0; j < 4; ++j) { v[j] = vn[j];
            if (l > 0) { v[j][0] += g2v[j][0] * (bflo(y0n[j].x) + bflo(y1n[j].x)); v[j][1] += g2v[j][1] * (bfhi(y0n[j].x) + bfhi(y1n[j].x)); v[j][2] += g2v[j][2] * (bflo(y0n[j].y) + bflo(y1n[j].y)); v[j][3] += g2v[j][3] * (bfhi(y0n[j].y) + bfhi(y1n[j].y)); }
            ss += (v[j][0] * v[j][0] + v[j][1] * v[j][1]) + (v[j][2] * v[j][2] + v[j][3] * v[j][3]); }
        if (row + 8 < rend) N1_LOAD(row + 8);
        if (l > 0 && l < DEPTH) {
#pragma unroll
            for (int j = 0; j < 4; ++j) { u32x2 xo; xo.x = pk2(v[j][0], v[j][1]); xo.y = pk2(v[j][2], v[j][3]); *(GAS u32x2*)(XS + (size_t)row * D + 4 * lane + 256 * j) = xo; } }
        const float rs = __builtin_amdgcn_rsqf(wave_sum(ss, lane) * (1.0f / D) + EPS);
        if (l == DEPTH) { GAS float* o = F.out + (size_t)(row - NCTX) * D;
#pragma unroll
            for (int j = 0; j < 4; ++j) *(GAS f32x4*)(o + 4 * lane + 256 * j) = (v[j] * rs) * ga[j]; }
        else {
#pragma unroll
            for (int j = 0; j < 4; ++j) { const f32x4 h = (v[j] * rs) * ga[j] + gb[j]; u32x2 o; o.x = pk2(h[0], h[1]); o.y = pk2(h[2], h[3]); *(GAS u32x2*)(H + (size_t)row * D + 4 * lane + 256 * j) = o; } }
    }
#undef N1_LOAD
}

__device__ __forceinline__ void ph_norm2_router(Frame& F, int l) {
    LAS float* rwT = (LAS float*)F.lds; LAS unsigned* rinfo = (LAS unsigned*)(F.lds + 65536); LAS unsigned* lcnt = rinfo + 160 * 4; LAS unsigned* lbase = lcnt + 16;
    __syncthreads();
    if (F.tid < 16) lcnt[F.tid] = 0u;
    for (int i = F.tid; i < 1024 * 4; i += 512) { const int k = i >> 2, e4 = i & 3; const f32x4 w = ((const GAS f32x4*)F.in[I_RW + F.z])[i];
        rwT[(4 * e4 + 0) * 1024 + k] = w[0]; rwT[(4 * e4 + 1) * 1024 + k] = w[1]; rwT[(4 * e4 + 2) * 1024 + k] = w[2]; rwT[(4 * e4 + 3) * 1024 + k] = w[3]; }
    __syncthreads();
    const int lane = F.lane, row_lo = (l == DEPTH - 1) ? NCTX : 0, RPB = (NTOK - row_lo + F.G - 1) / F.G, rbeg = row_lo + F.bid * RPB, rend = (rbeg + RPB < NTOK) ? rbeg + RPB : NTOK;
    GAS bf16* XS = (GAS bf16*)(F.ws + WS_XS); GAS bf16* H = (GAS bf16*)(F.ws + WS_H); const GAS float* MOD = (const GAS float*)(F.ws + WS_MOD); const GAS bf16* DL = (const GAS bf16*)(F.ws + WS_U + U_DELTA);
    GAS unsigned* ELIST = (GAS unsigned*)(F.ws + WS_ELIST); GAS float* WLIST = (GAS float*)(F.ws + WS_WLIST);
    float rb[16];
#pragma unroll
    for (int e = 0; e < 16; ++e) rb[e] = F.in[I_RB + F.z][e];
    f32x4 ga[4], gb[4]; int cur_bi = -1;
    f32x4 vn[4]; u32x2 dn[4];
    int row = rbeg + F.wave;
#define N2_LOAD(r) do { const GAS float* src_ = ((r) < NCTX ? F.in[I_CTX + F.z] + (size_t)(r) * D : F.in[I_X + F.z] + (size_t)((r) - NCTX) * D); \
        _Pragma("unroll") for (int j = 0; j < 4; ++j) { const int col_ = 4 * lane + 256 * j; \
            if (l == 0) vn[j] = *(const GAS f32x4*)(src_ + col_); else { const u32x2 xb_ = *(const GAS u32x2*)(XS + (size_t)(r) * D + col_); vn[j] = (f32x4){bflo(xb_.x), bfhi(xb_.x), bflo(xb_.y), bfhi(xb_.y)}; } \
            dn[j] = *(const GAS u32x2*)(DL + (size_t)(r) * D + col_); } } while (0)
    if (row < rend) N2_LOAD(row);
    int rl = -1;
    for (; row < rend; row += 8) {
        ++rl;
        const int bi = bidx_of_row(row);
        if (bi != cur_bi) { cur_bi = bi; const GAS float* m = MOD + ((size_t)l * 9 + bi) * 6144;
#pragma unroll
            for (int j = 0; j < 4; ++j) { const int col = 4 * lane + 256 * j; const f32x4 g = *(const GAS f32x4*)(F.in[I_N2G + F.z] + l * D + col), sh = *(const GAS f32x4*)(m + 3 * 1024 + col), sc = *(const GAS f32x4*)(m + 4 * 1024 + col);
                ga[j] = g * (sc + 1.0f); gb[j] = sh; } }
        f32x4 v[4]; float ss = 0.f;
#pragma unroll
        for (int j = 0; j < 4; ++j) { v[j][0] = vn[j][0] + bflo(dn[j].x); v[j][1] = vn[j][1] + bfhi(dn[j].x); v[j][2] = vn[j][2] + bflo(dn[j].y); v[j][3] = vn[j][3] + bfhi(dn[j].y);
            ss += (v[j][0] * v[j][0] + v[j][1] * v[j][1]) + (v[j][2] * v[j][2] + v[j][3] * v[j][3]); }
        if (row + 8 < rend) N2_LOAD(row + 8);
#pragma unroll
        for (int j = 0; j < 4; ++j) { u32x2 xo; xo.x = pk2(v[j][0], v[j][1]); xo.y = pk2(v[j][2], v[j][3]); *(GAS u32x2*)(XS + (size_t)row * D + 4 * lane + 256 * j) = xo; }
        const float rs = __builtin_amdgcn_rsqf(wave_sum(ss, lane) * (1.0f / D) + EPS);
        float lg[16];
#pragma unroll
        for (int e = 0; e < 16; ++e) lg[e] = 0.f;
#pragma unroll
        for (int j = 0; j < 4; ++j) { const int col = 4 * lane + 256 * j;
            const f32x4 h = (v[j] * rs) * ga[j] + gb[j];
            *(GAS unsigned*)((GAS unsigned char*)H + (size_t)row * D + col) = pk4_fp8(h[0], h[1], h[2], h[3]);
#pragma unroll
            for (int e = 0; e < 16; ++e) { const f32x4 w = *(const LAS f32x4*)(rwT + e * 1024 + col); lg[e] = __builtin_fmaf(h[3], w[3], __builtin_fmaf(h[2], w[2], __builtin_fmaf(h[1], w[1], __builtin_fmaf(h[0], w[0], lg[e])))); }
            asm volatile("" ::: "memory"); }
        float a8[8], a4[4], a2[2], a1;
        { const bool up = (lane & 32) != 0;
#pragma unroll
          for (int i = 0; i < 8; ++i) { const float send = up ? lg[i] : lg[i + 8], keep = up ? lg[i + 8] : lg[i]; a8[i] = keep + lane_xor(send, lane, 32); } }
        { const bool up = (lane & 16) != 0;
#pragma unroll
          for (int i = 0; i < 4; ++i) { const float send = up ? a8[i] : a8[i + 4], keep = up ? a8[i + 4] : a8[i]; a4[i] = keep + lane_xor(send, lane, 16); } }
        { const bool up = (lane & 8) != 0;
#pragma unroll
          for (int i = 0; i < 2; ++i) { const float send = up ? a4[i] : a4[i + 2], keep = up ? a4[i + 2] : a4[i]; a2[i] = keep + lane_xor(send, lane, 8); } }
        { const bool up = (lane & 4) != 0; const float send = up ? a2[0] : a2[1], keep = up ? a2[1] : a2[0]; a1 = keep + lane_xor(send, lane, 4); }
        a1 += lane_xor(a1, lane, 1); a1 += lane_xor(a1, lane, 2);
#pragma unroll
        for (int e = 0; e < 16; ++e) lg[e] = __builtin_bit_cast(float, __builtin_amdgcn_readlane(__builtin_bit_cast(int, a1), 4 * e));
        float mx = lg[0];
#pragma unroll
        for (int e = 1; e < 16; ++e) mx = fmaxf(mx, lg[e]);
        float pr[16], sum = 0.f;
#pragma unroll
        for (int e = 0; e < 16; ++e) { pr[e] = __expf(lg[e] - mx); sum += pr[e]; }
        const float inv = __builtin_amdgcn_rcpf(sum);
        float sel[16];
#pragma unroll
        for (int e = 0; e < 16; ++e) { pr[e] *= inv; sel[e] = pr[e] + rb[e]; }
        float best = -1e30f; int gi = 0;
#pragma unroll
        for (int g = 0; g < 4; ++g) { const float a = sel[4 * g], b = sel[4 * g + 1], c = sel[4 * g + 2], d = sel[4 * g + 3];
            const float hi1 = fmaxf(a, b), lo1 = fminf(a, b), hi2 = fmaxf(c, d), lo2 = fminf(c, d);
            const float top = fmaxf(hi1, hi2), second = fmaxf(fminf(hi1, hi2), fmaxf(lo1, lo2)); const float gs = top + second;
            if (gs > best) { best = gs; gi = g; } }
        float s0 = 0.f, s1 = 0.f, s2 = 0.f, s3 = 0.f, p0 = 0.f, p1 = 0.f, p2 = 0.f, p3 = 0.f;
#pragma unroll
        for (int g = 0; g < 4; ++g) if (g == gi) { s0 = sel[4 * g]; s1 = sel[4 * g + 1]; s2 = sel[4 * g + 2]; s3 = sel[4 * g + 3]; p0 = pr[4 * g]; p1 = pr[4 * g + 1]; p2 = pr[4 * g + 2]; p3 = pr[4 * g + 3]; }
        int i1 = 0; float b1 = s0; if (s1 > b1) { b1 = s1; i1 = 1; } if (s2 > b1) { b1 = s2; i1 = 2; } if (s3 > b1) { b1 = s3; i1 = 3; }
        int i2 = -1; float b2 = -1e30f;
        if (i1 != 0 && s0 > b2) { b2 = s0; i2 = 0; } if (i1 != 1 && s1 > b2) { b2 = s1; i2 = 1; } if (i1 != 2 && s2 > b2) { b2 = s2; i2 = 2; } if (i1 != 3 && s3 > b2) { b2 = s3; i2 = 3; }
        const float q1 = i1 == 0 ? p0 : i1 == 1 ? p1 : i1 == 2 ? p2 : p3, q2 = i2 == 0 ? p0 : i2 == 1 ? p1 : i2 == 2 ? p2 : p3;
        const float gsum = q1 + q2;
        if (lane < 2) { const int e = gi * 4 + (lane == 0 ? i1 : i2); const float gate = (lane == 0 ? q1 : q2) * __builtin_amdgcn_rcpf(gsum);
            const unsigned lp = __hip_atomic_fetch_add(lcnt + e, 1u, __ATOMIC_RELAXED, __HIP_MEMORY_SCOPE_WORKGROUP);
            const int ent = (rl * 8 + F.wave) * 2 + lane;
            rinfo[ent * 2 + 0] = ((unsigned)e << 24) | lp; rinfo[ent * 2 + 1] = __builtin_bit_cast(unsigned, gate); }
    }
#undef N2_LOAD
    __syncthreads();
    if (F.tid < 16) lbase[F.tid] = __hip_atomic_fetch_add(F.ctl + CW_CNT + (l * 16 + F.tid) * 64, lcnt[F.tid], __ATOMIC_RELAXED, __HIP_MEMORY_SCOPE_AGENT);
    __syncthreads();
    for (int ent = F.tid; ent < 160 * 2; ent += 512) { const int rslot = ent >> 1, k = rslot >> 3, w = rslot & 7; const int r = rbeg + w + 8 * k;
        if (r < rend) { const unsigned a0 = rinfo[ent * 2], e = a0 >> 24, pos = lbase[e] + (a0 & 0xffffffu);
            ELIST[(size_t)e * ECAP + pos] = (unsigned)r * 2u + (unsigned)(ent & 1); WLIST[(size_t)e * ECAP + pos] = __builtin_bit_cast(float, rinfo[ent * 2 + 1]); } }
    __syncthreads();
}

__device__ __forceinline__ void moe_tables(Frame& F, int l, volatile LAS int* tab) {
    __syncthreads();
    if (F.tid == 0) { int pref = 0;
        for (int e = 0; e < 16; ++e) { const int c = (int)__hip_atomic_load(F.ctl + CW_CNT + (l * 16 + e) * 64, __ATOMIC_RELAXED, __HIP_MEMORY_SCOPE_AGENT); tab[e] = pref; tab[32 + e] = c; pref += (c + 255) >> 8; }
        tab[16] = pref; }
    __syncthreads();
}
__device__ __forceinline__ void ph_gather(Frame& F, int l) {
    volatile LAS int* tab = (volatile LAS int*)(F.lds + LDS_BYTES - 512);
    moe_tables(F, l, tab);
    const int gw = F.bid * 8 + F.wave, NGW = F.G * 8;
    const GAS unsigned* ELIST = (const GAS unsigned*)(F.ws + WS_ELIST); const GAS bf16* H = (const GAS bf16*)(F.ws + WS_H); GAS bf16* XG = (GAS bf16*)(F.ws + WS_U + U_XG);
    for (int e = 0; e < 16; ++e) { const int cnt = __builtin_amdgcn_readfirstlane(tab[32 + e]), base = 256 * __builtin_amdgcn_readfirstlane(tab[e]);
        for (int pos = gw; pos < cnt; pos += NGW) { const unsigned tok = ELIST[(size_t)e * ECAP + pos] >> 1;
            const GAS u32x4* s = (const GAS u32x4*)(H + (size_t)tok * D); GAS u32x4* d = (GAS u32x4*)(XG + (size_t)(base + pos) * D);
            const u32x4 a = s[F.lane], b = s[64 + F.lane]; d[F.lane] = a; d[64 + F.lane] = b; }
        for (int pos = cnt + gw; pos < ((cnt + 255) & ~255); pos += NGW) { GAS u32x4* d = (GAS u32x4*)(XG + (size_t)(base + pos) * D); d[F.lane] = (u32x4){0u, 0u, 0u, 0u}; d[64 + F.lane] = (u32x4){0u, 0u, 0u, 0u}; } }
}

__device__ __forceinline__ void unit_prep_qk(Frame& F, int u) {
    LAUNDER(F);
    const GAS bf16* P = (const GAS bf16*)(F.ws + WS_U + U_P); GAS bf16* QR = (GAS bf16*)(F.ws + WS_U + U_QR); GAS bf16* KR = (GAS bf16*)(F.ws + WS_U + U_KR); const GAS f32x2* ROPE = (const GAS f32x2*)(F.ws + WS_S5T + S5_ROPE);
    u32x4 pa[5], pb[5];
#pragma unroll
    for (int q = 0; q < 5; ++q) { const int it = F.tid + 512 * q, r = it / 40, s = it % 40, hs = s >> 2, half = (s >> 1) & 1, ck = s & 1; const int row = u * 64 + r;
        const int scol = (hs < 8 ? HY_END + hs * 64 : Q_END + (hs - 8) * 64) + half * 32 + ck * 8;
        pa[q] = *(const GAS u32x4*)(P + (size_t)row * INW + scol); pb[q] = *(const GAS u32x4*)(P + (size_t)row * INW + scol + 16); }
#pragma unroll
    for (int q = 0; q < 5; ++q) { const int it = F.tid + 512 * q; const int r = it / 40, s = it % 40, hs = s >> 2, half = (s >> 1) & 1, ck = s & 1; const int row = u * 64 + r;
        const bool isq = hs < 8;
        const u32x4 a = pa[q], b = pb[q];
        const unsigned aw[4] = {a.x, a.y, a.z, a.w}, bw[4] = {b.x, b.y, b.z, b.w}; float x1[8], x2[8], o1[8], o2[8];
#pragma unroll
        for (int k = 0; k < 4; ++k) { x1[2 * k] = bflo(aw[k]); x1[2 * k + 1] = bfhi(aw[k]); x2[2 * k] = bflo(bw[k]); x2[2 * k + 1] = bfhi(bw[k]); }
        const float scl = isq ? 0.125f * 1.4426950408889634f : 1.0f;
        if (row >= NCTX) { const int t = (row - NCTX) & (SEQ - 1), pos = half ? (t & 63) : (t >> 6);
#pragma unroll
            for (int k = 0; k < 8; ++k) { const f32x2 cs = ROPE[pos * 16 + ck * 8 + k]; o1[k] = (x1[k] * cs.x - x2[k] * cs.y) * scl; o2[k] = (x1[k] * cs.y + x2[k] * cs.x) * scl; } }
        else {
#pragma unroll
            for (int k = 0; k < 8; ++k) { o1[k] = x1[k] * scl; o2[k] = x2[k] * scl; } }
        u32x4 oa, ob; oa.x = pk2(o1[0], o1[1]); oa.y = pk2(o1[2], o1[3]); oa.z = pk2(o1[4], o1[5]); oa.w = pk2(o1[6], o1[7]); ob.x = pk2(o2[0], o2[1]); ob.y = pk2(o2[2], o2[3]); ob.z = pk2(o2[4], o2[5]); ob.w = pk2(o2[6], o2[7]);
        GAS bf16* dst = isq ? QR + (size_t)row * 512 + hs * 64 + half * 32 + ck * 8 : KR + (size_t)row * 128 + (hs - 8) * 64 + half * 32 + ck * 8;
        *(GAS u32x4*)dst = oa; *(GAS u32x4*)(dst + 16) = ob; }
}

__device__ __forceinline__ void unit_hy_prep(Frame& F, int l, int u) {
    LAUNDER(F);
    const int seg = u / 256, b = (u >> 5) & 7, tb = u & 31, t0 = tb * 128;
    LAS bf16* tile = (LAS bf16*)F.lds;
    const GAS bf16* P = (const GAS bf16*)(F.ws + WS_U + U_P);
    __syncthreads();
    { u32x4 tv[9];
#pragma unroll
      for (int k = 0; k < 9; ++k) { const int i = F.tid + 512 * k, rr = i >> 5, ck = i & 31, t = t0 - 1 + rr; tv[k] = (u32x4){0u, 0u, 0u, 0u};
          if (i < 130 * 32 && t >= 0 && t < SEQ) tv[k] = *(const GAS u32x4*)(P + (size_t)(NCTX + b * SEQ + t) * INW + seg * 256 + ck * 8); }
#pragma unroll
      for (int k = 0; k < 9; ++k) { const int i = F.tid + 512 * k, rr = i >> 5, ck = i & 31; if (i < 130 * 32) *(LAS u32x4*)(tile + rr * 264 + ck * 8) = tv[k]; } }
    __syncthreads();
    GAS bf16* OUT = (GAS bf16*)(F.ws + WS_U + (seg == 0 ? U_HV : seg == 1 ? U_HX1 : U_HX2));
    const int ch = F.tid & 255, col = seg * 256 + ch;
    const float w0 = F.in[I_HCW + F.z][(l * 3 + 0) * 768 + col], w1 = F.in[I_HCW + F.z][(l * 3 + 1) * 768 + col], w2 = F.in[I_HCW + F.z][(l * 3 + 2) * 768 + col], bb = F.in[I_HCB + F.z][l * 768 + col];
#pragma unroll
    for (int k = 0; k < 8; ++k) { const int tc = (F.tid >> 8) + 2 * k; float z[10];
#pragma unroll
        for (int j = 0; j < 10; ++j) z[j] = bf2f(tile[(8 * tc + j) * 264 + ch]);
        float o[8];
#pragma unroll
        for (int j = 0; j < 8; ++j) o[j] = bb + w0 * z[j] + w1 * z[j + 1] + w2 * z[j + 2];
        u32x4 w; w.x = pk2(o[0], o[1]); w.y = pk2(o[2], o[3]); w.z = pk2(o[4], o[5]); w.w = pk2(o[6], o[7]);
        *(GAS u32x4*)(OUT + ((size_t)ch * NB + b) * SEQ + t0 + 8 * tc) = w; }
}

constexpr int HY_NA = 642, HY_CP = 656, HY_GT_BYTES = (8 * HY_CP + 16) * 16  , HY_UP = 4488, HY_UB_OFF = HY_GT_BYTES, HY_UB_BYTES = 8 * HY_UP * 2  ;
static_assert(HY_UB_OFF + HY_UB_BYTES + 64 <= LDS_BYTES - 512, "hyena LDS");
#define HY_CB(r) ((int)((0xD95D9510u >> (4 * (r))) & 15u))
#define HY_SWZ(xb) ((xb) ^ (((xb) >> 2) & 64))
__device__ __forceinline__ void unit_hy_conv(Frame& F, int l, int order, int ch) {
    LAUNDER(F);
    LAS unsigned char* GT = F.lds; LAS unsigned char* UB = F.lds + HY_UB_OFF; LAS float* RED = (LAS float*)F.lds;
    const GAS bf16* TG = (const GAS bf16*)(F.ws + WS_TG) + ((size_t)(l * 2 + order) * 256 + ch) * 8192;
    const GAS bf16* U = (const GAS bf16*)(F.ws + WS_U + (order == 0 ? U_HV : U_Z1T)) + (size_t)ch * NB * SEQ;
    const GAS bf16* XM = (const GAS bf16*)(F.ws + WS_U + (order == 0 ? U_HX1 : U_HX2)) + (size_t)ch * NB * SEQ;
    GAS bf16* OUT = (GAS bf16*)(F.ws + WS_U + (order == 0 ? U_Z1T : U_HYT)) + (size_t)ch * NB * SEQ;
    const float bias = F.in[I_HBIAS + F.z][(l * 2 + order) * 256 + ch];
    const int lane = F.lane, w = F.wave, nt = w & 3, kh = w >> 2, half = lane >> 5, i = lane & 31, col = lane & 31, bb = col >> 2, np = col & 3;
    LDS_BARRIER();
    { u32x4 uv[8];
#pragma unroll
      for (int b = 0; b < 8; ++b) uv[b] = *(const GAS u32x4*)(U + (size_t)b * SEQ + 8 * F.tid);
#pragma unroll
      for (int b = 0; b < 8; ++b) *(LAS u32x4*)(UB + b * (HY_UP * 2) + HY_SWZ((192 + 8 * F.tid) * 2)) = uv[b]; }
    for (int k = F.tid; k < 8 * 49; k += 512) { const int b = k / 49, c = k % 49; const int el = c < 24 ? 8 * c : 4288 + 8 * (c - 24); *(LAS u32x4*)(UB + b * (HY_UP * 2) + HY_SWZ(el * 2)) = (u32x4){0u, 0u, 0u, 0u}; }
    u32x4 glo[2], ghi[2];
#define HY_TAPS(q_) do { const int Y0_ = -(1024 * (q_) + 1024); _Pragma("unroll") for (int k = 0; k < 2; ++k) { const int yp = Y0_ + 8 * (F.tid + 512 * k) + 4096;     \
            glo[k] = *(const GAS u32x4*)(TG + (yp < 8184 ? yp : 8184)); ghi[k] = *(const GAS u32x4*)(TG + (yp + 8 < 8184 ? yp + 8 : 8184)); } } while (0)
    HY_TAPS(0);
#pragma unroll 1
    for (int q = 0; q < 4; ++q) {
        const int T0 = 1024 * q, Y0 = -(T0 + 1024);
        LDS_BARRIER();
#pragma unroll
        for (int k = 0; k < 2; ++k) { const int a = F.tid + 512 * k; if (a >= HY_NA) continue;
            const int yp = Y0 + 8 * a + 4096; const u32x4 z4 = (u32x4){0u, 0u, 0u, 0u}; const u32x4 lo = (yp < 8192) ? glo[k] : z4, hi = (yp + 8 < 8192) ? ghi[k] : z4;
            const unsigned wv[8] = {lo.x, lo.y, lo.z, lo.w, hi.x, hi.y, hi.z, hi.w};
#pragma unroll
            for (int r = 0; r < 8; ++r) { u32x4 o;
                if ((r & 1) == 0) { o.x = wv[r / 2]; o.y = wv[r / 2 + 1]; o.z = wv[r / 2 + 2]; o.w = wv[r / 2 + 3]; }
                else { const int d = r / 2; o.x = (wv[d] >> 16) | (wv[d + 1] << 16); o.y = (wv[d + 1] >> 16) | (wv[d + 2] << 16); o.z = (wv[d + 2] >> 16) | (wv[d + 3] << 16); o.w = (wv[d + 3] >> 16) | (wv[d + 4] << 16); }
                *(LAS u32x4*)(GT + (r * HY_CP + HY_CB(r) + a) * 16) = o; } }
        LDS_BARRIER();
        if (q + 1 < 4) HY_TAPS(q + 1);
        u32x2 xmv[4];
#pragma unroll
        for (int rg = 0; rg < 4; ++rg) xmv[rg] = *(const GAS u32x2*)(XM + (size_t)bb * SEQ + T0 + 256 * nt + 64 * np + 32 * kh + 8 * rg + 4 * half);
        const int K_lo = -(T0 + 256 * nt + 192), ks0 = K_lo + 16 * 134 * kh;
        const int rcp = (8 - (i & 7)) & 7;
        int aidx = (ks0 - 32 - Y0) / 8 + half - ((i + 7) >> 3);
        const LAS unsigned char* ap = GT + (rcp * HY_CP + HY_CB(rcp)) * 16;
        const LAS unsigned char* brow = UB + bb * (HY_UP * 2); int xb = (192 + ks0 + T0 + 256 * nt + 64 * np + 8 * half) * 2;
        bf16x8 a0, a1, a2 = *(const LAS bf16x8*)(ap + aidx * 16), a3 = *(const LAS bf16x8*)(ap + (aidx + 2) * 16), b0, b1;
        aidx += 4;
        f32x16 acc0 = zero16(), acc1 = zero16();
        a0 = *(const LAS bf16x8*)(ap + aidx * 16); b0 = *(const LAS bf16x8*)(brow + HY_SWZ(xb));
#define HY_STEP(An, Ac, Am, Bn, Bc) do { aidx += 2; xb += 32; An = *(const LAS bf16x8*)(ap + aidx * 16); Bn = *(const LAS bf16x8*)(brow + HY_SWZ(xb)); __builtin_amdgcn_sched_barrier(0); \
            acc0 = __builtin_amdgcn_mfma_f32_32x32x16_bf16(Ac, Bc, acc0, 0, 0, 0); acc1 = __builtin_amdgcn_mfma_f32_32x32x16_bf16(Am, Bc, acc1, 0, 0, 0); __builtin_amdgcn_sched_barrier(0); } while (0)
#pragma unroll 1
        for (int st = 0; st < 132; st += 4) { HY_STEP(a1, a0, a2, b1, b0); HY_STEP(a2, a1, a3, b0, b1); HY_STEP(a3, a2, a0, b1, b0); HY_STEP(a0, a3, a1, b0, b1); }
        HY_STEP(a1, a0, a2, b1, b0); HY_STEP(a2, a1, a3, b0, b1);
#undef HY_STEP
        LDS_BARRIER();
        { LAS float* mine = RED + ((nt * 2 + (1 - kh)) * 16) * 64;
#pragma unroll
          for (int r = 0; r < 16; ++r) mine[r * 64 + lane] = (kh == 0) ? acc1[r] : acc0[r]; }
        LDS_BARRIER();
        { const LAS float* oth = RED + ((nt * 2 + kh) * 16) * 64;
          const int mb = kh;
#pragma unroll
          for (int rg = 0; rg < 4; ++rg) {
              const int t = T0 + 256 * nt + 64 * np + 32 * mb + 8 * rg + 4 * half;
              const u32x2 xm = xmv[rg];
              const u32x2 uu = *(const LAS u32x2*)(UB + bb * (HY_UP * 2) + HY_SWZ((192 + t) * 2));
              const float xv[4] = {bflo(xm.x), bfhi(xm.x), bflo(xm.y), bfhi(xm.y)}, uv[4] = {bflo(uu.x), bfhi(uu.x), bflo(uu.y), bfhi(uu.y)};
              float o[4];
#pragma unroll
              for (int j = 0; j < 4; ++j) { const int r = 4 * rg + j; const float y = (kh == 0 ? acc0[r] : acc1[r]) + oth[r * 64 + lane]; o[j] = xv[j] * (y + uv[j] * bias); }
              u32x2 ov; ov.x = pk2(o[0], o[1]); ov.y = pk2(o[2], o[3]);
              *(GAS u32x2*)(OUT + (size_t)bb * SEQ + t) = ov; } }
    }
#undef HY_TAPS
    LDS_BARRIER();
}

__device__ __forceinline__ void unit_hy_ctx(Frame& F, int l, int ch) {
    LAUNDER(F);
    LAS float* z = (LAS float*)F.lds;
    LAS float* vv = z + 3 * 8 * 258;
    LAS float* g = vv + 3 * 8 * 256;
    LAS float* z1 = g + 2 * 512;
    const GAS bf16* P = (const GAS bf16*)(F.ws + WS_U + U_P);
    __syncthreads();
    { unsigned zv[13];
#pragma unroll
      for (int q = 0; q < 13; ++q) { const int k = F.tid + 512 * q, seg = k / (8 * 258), r = k % (8 * 258), b = r / 258, tt = r % 258 - 1; zv[q] = 0u;
          if (k < 3 * 8 * 258 && tt >= 0 && tt < 256) zv[q] = P[(size_t)(b * 256 + tt) * INW + seg * 256 + ch]; }
#pragma unroll
      for (int q = 0; q < 13; ++q) { const int k = F.tid + 512 * q; if (k < 3 * 8 * 258) z[k] = bf2f(zv[q]); } }
    for (int k = F.tid; k < 2 * 512; k += 512) { const int o = k >> 9, y = k & 511; g[k] = bf2f(((const GAS bf16*)(F.ws + WS_TGC))[((size_t)(l * 2 + o) * 256 + ch) * 512 + y]); }
    __syncthreads();
    for (int k = F.tid; k < 3 * 8 * 256; k += 512) { const int seg = k / 2048, r = k % 2048, b = r >> 8, t = r & 255; const int col = seg * 256 + ch; const LAS float* zz = z + (seg * 8 + b) * 258 + t;
        vv[k] = F.in[I_HCB + F.z][l * 768 + col] + F.in[I_HCW + F.z][(l * 3 + 0) * 768 + col] * zz[0] + F.in[I_HCW + F.z][(l * 3 + 1) * 768 + col] * zz[1] + F.in[I_HCW + F.z][(l * 3 + 2) * 768 + col] * zz[2]; }
    __syncthreads();
    const int b = F.tid >> 6, tq = F.tid & 63;
    const float bias0 = F.in[I_HBIAS + F.z][(l * 2 + 0) * 256 + ch], bias1 = F.in[I_HBIAS + F.z][(l * 2 + 1) * 256 + ch];
#define HYC_CONV(GOFF, U) \
    float a0 = 0.f, a1 = 0.f, a2 = 0.f, a3 = 0.f; { const LAS float* gp = g + (GOFF) + 256 - 4 * tq; float m1 = gp[-1], m2 = gp[-2], m3 = gp[-3]; \
      _Pragma("unroll 2") for (int s0 = 0; s0 < 256; s0 += 4) { const f32x4 w = *(const LAS f32x4*)(gp + s0); const f32x4 uu = *(const LAS f32x4*)((U) + s0); \
          a0 += w[0] * uu[0]; a1 += m1 * uu[0];   a2 += m2 * uu[0];   a3 += m3 * uu[0]; \
          a0 += w[1] * uu[1]; a1 += w[0] * uu[1]; a2 += m1 * uu[1];   a3 += m2 * uu[1]; \
          a0 += w[2] * uu[2]; a1 += w[1] * uu[2]; a2 += w[0] * uu[2]; a3 += m1 * uu[2]; \
          a0 += w[3] * uu[3]; a1 += w[2] * uu[3]; a2 += w[1] * uu[3]; a3 += w[0] * uu[3]; \
          m1 = w[3]; m2 = w[2]; m3 = w[1]; } }
    { const LAS float* u = vv + b * 256;
      HYC_CONV(0, u);
      const f32x4 x1 = *(const LAS f32x4*)(vv + (8 + b) * 256 + 4 * tq), ut = *(const LAS f32x4*)(u + 4 * tq);
      f32x4 o; o[0] = x1[0] * (a0 + ut[0] * bias0); o[1] = x1[1] * (a1 + ut[1] * bias0); o[2] = x1[2] * (a2 + ut[2] * bias0); o[3] = x1[3] * (a3 + ut[3] * bias0);
      *(LAS f32x4*)(z1 + b * 256 + 4 * tq) = o; }
    __syncthreads();
    { const LAS float* u = z1 + b * 256;
      HYC_CONV(512, u);
      GAS bf16* HYC = (GAS bf16*)(F.ws + WS_HYC);
      const f32x4 x2 = *(const LAS f32x4*)(vv + (16 + b) * 256 + 4 * tq), ut = *(const LAS f32x4*)(u + 4 * tq);
      const float o[4] = {x2[0] * (a0 + ut[0] * bias1), x2[1] * (a1 + ut[1] * bias1), x2[2] * (a2 + ut[2] * bias1), x2[3] * (a3 + ut[3] * bias1)};
#pragma unroll
      for (int i = 0; i < 4; ++i) HYC[(size_t)(b * 256 + 4 * tq + i) * 256 + ch] = (bf16)f2bf(o[i]); }
#undef HYC_CONV
    __syncthreads();
}

constexpr int AT_KP = 72  , AT_VP = 96  , AT_K_BYTES = 320 * AT_KP * 2  , AT_V_OFF = AT_K_BYTES;
typedef short s16x4 __attribute__((ext_vector_type(4)));
__device__ __forceinline__ void unit_attn(Frame& F, int l, int u) {
    LAUNDER(F);
    const bool lat = u < 1024; const int v_ = u - 1024;
    const int b = lat ? (u >> 7) : (v_ >> 3), kvh = lat ? ((u >> 6) & 1) : ((v_ >> 2) & 1), qt = lat ? (u & 63) : (v_ & 3);
    const GAS bf16* P = (const GAS bf16*)(F.ws + WS_U + U_P); const GAS bf16* QR = (const GAS bf16*)(F.ws + WS_U + U_QR); const GAS bf16* KR = (const GAS bf16*)(F.ws + WS_U + U_KR); GAS bf16* ATT = (GAS bf16*)(F.ws + WS_U + U_ATT);
    LAS unsigned char* KL = F.lds; LAS bf16* VL = (LAS bf16*)(F.lds + AT_V_OFF);
    const int lane = F.lane, w = F.wave, g = w >> 1, hh = w & 1, half = lane >> 5, ql = lane & 31;
    const int rowbase = lat ? NCTX + b * SEQ : b * CTXL;
    const int tq = 64 * qt + 32 * hh + ql;
    const int qrow = rowbase + tq, head = kvh * 4 + g;
    bf16x8 qf[4];
#pragma unroll
    for (int ks = 0; ks < 4; ++ks) qf[ks] = *(const GAS bf16x8*)(QR + (size_t)qrow * 512 + head * 64 + 16 * ks + 8 * half);
    float m_run = F.in[I_SINK + F.z][l * 8 + head] * 1.4426950408889634f, l_run = 1.0f;
    f32x16 o0 = zero16(), o1 = zero16();
    const LAS bf16* vbase = VL + (4 * half + ((lane & 15) >> 2)) * AT_VP + 16 * ((lane >> 4) & 1) + 4 * (lane & 3);
#pragma unroll 1
    for (int stage = lat ? 0 : 1; stage < 2; ++stage) {
        const int nkeys = stage == 0 ? 320 : 256;
        const int kbase = stage == 0 ? 64 * qt - 128 : 0;
        const int krow0 = stage == 0 ? NCTX + b * SEQ : b * CTXL;
        const int klimit = stage == 0 ? SEQ : CTXL;
        __syncthreads();
        { u32x4 kv[5], vv[5];
#pragma unroll
          for (int k = 0; k < 5; ++k) { const int i = F.tid + 512 * k, kk = i >> 3, c = i & 7, kp = kbase + kk; kv[k] = (u32x4){0u, 0u, 0u, 0u}; vv[k] = kv[k];
              if (i < nkeys * 8 && kp >= 0 && kp < klimit) { kv[k] = *(const GAS u32x4*)(KR + (size_t)(krow0 + kp) * 128 + kvh * 64 + 8 * c); vv[k] = *(const GAS u32x4*)(P + (size_t)(krow0 + kp) * INW + K_END + kvh * 64 + 8 * c); } }
#pragma unroll
          for (int k = 0; k < 5; ++k) { const int i = F.tid + 512 * k, kk = i >> 3, c = i & 7;
              if (i < nkeys * 8) { *(LAS u32x4*)(KL + (kk * AT_KP + 8 * c) * 2) = kv[k]; *(LAS u32x4*)(VL + kk * AT_VP + 8 * c) = vv[k]; } } }
        __syncthreads();
        const int ntile = stage == 0 ? 9 : 8, kk00 = stage == 0 ? 32 * hh : 0;
#pragma unroll 1
        for (int tt = 0; tt < ntile; ++tt) {
            const int kk0 = kk00 + 32 * tt;
            f32x16 st;
#pragma unroll
            for (int r = 0; r < 16; ++r) st[r] = -m_run;
            asm volatile("" : "+v"(st));
#pragma unroll
            for (int ks = 0; ks < 4; ++ks) { const bf16x8 kf = *(const LAS bf16x8*)(KL + ((kk0 + ql) * AT_KP + 16 * ks + 8 * half) * 2); st = __builtin_amdgcn_mfma_f32_32x32x16_bf16(kf, qf[ks], st, 0, 0, 0); }
            const int kp0 = kbase + kk0;
            if (stage == 0 && (tt == 0 || tt == 8 || kp0 < 0 || kp0 + 32 > SEQ)) {
#pragma unroll
                for (int r = 0; r < 16; ++r) { const int kp = kp0 + 8 * (r >> 2) + 4 * half + (r & 3); const int dd = kp - tq; const bool ok = (dd <= 128) && (dd >= -128) && (kp >= 0) && (kp < SEQ); st[r] = ok ? st[r] : -1e30f; } }
            float mx = st[0];
#pragma unroll
            for (int r = 1; r < 16; ++r) mx = fmaxf(mx, st[r]);
            mx = pair32_max(mx);
            if (__builtin_amdgcn_ballot_w64(mx > 8.0f) != 0ull) {
                const float delta = fmaxf(mx, 0.f), alpha = __builtin_amdgcn_exp2f(-delta);
                m_run += delta; l_run *= alpha;
#pragma unroll
                for (int r = 0; r < 16; ++r) { st[r] -= delta; o0[r] *= alpha; o1[r] *= alpha; } }
#pragma unroll
            for (int r = 0; r < 16; ++r) st[r] = __builtin_amdgcn_exp2f(st[r]);
            f32x2 rs2 = (f32x2){st[0], st[1]};
#pragma unroll
            for (int r = 1; r < 8; ++r) rs2 += (f32x2){st[2 * r], st[2 * r + 1]};
            float rsum = pair32_sum(rs2[0] + rs2[1]);
            l_run += rsum;
#pragma unroll
            for (int ks = 0; ks < 2; ++ks) {
                union { bf16x8 v; unsigned w[4]; } pf;
                pf.w[0] = pk2(st[8 * ks + 0], st[8 * ks + 1]); pf.w[1] = pk2(st[8 * ks + 2], st[8 * ks + 3]); pf.w[2] = pk2(st[8 * ks + 4], st[8 * ks + 5]); pf.w[3] = pk2(st[8 * ks + 6], st[8 * ks + 7]);
                union { bf16x8 v; s16x4 h[2]; } v0, v1;
                const LAS bf16* vp = vbase + (kk0 + 16 * ks) * AT_VP;
                v0.h[0] = __builtin_amdgcn_ds_read_tr16_b64_v4i16((LAS s16x4*)vp); v0.h[1] = __builtin_amdgcn_ds_read_tr16_b64_v4i16((LAS s16x4*)(vp + 8 * AT_VP));
                v1.h[0] = __builtin_amdgcn_ds_read_tr16_b64_v4i16((LAS s16x4*)(vp + 32)); v1.h[1] = __builtin_amdgcn_ds_read_tr16_b64_v4i16((LAS s16x4*)(vp + 8 * AT_VP + 32));
                o0 = __builtin_amdgcn_mfma_f32_32x32x16_bf16(v0.v, pf.v, o0, 0, 0, 0);
                o1 = __builtin_amdgcn_mfma_f32_32x32x16_bf16(v1.v, pf.v, o1, 0, 0, 0);
            }
        }
    }
    const float inv = 1.0f / l_run;
    GAS bf16* orow = ATT + (size_t)qrow * 512 + head * 64;
#pragma unroll
    for (int rg = 0; rg < 4; ++rg) { const int d = 8 * rg + 4 * half;
        u32x2 a; a.x = pk2(o0[4 * rg] * inv, o0[4 * rg + 1] * inv); a.y = pk2(o0[4 * rg + 2] * inv, o0[4 * rg + 3] * inv); *(GAS u32x2*)(orow + d) = a;
        u32x2 c; c.x = pk2(o1[4 * rg] * inv, o1[4 * rg + 1] * inv); c.y = pk2(o1[4 * rg + 2] * inv, o1[4 * rg + 3] * inv); *(GAS u32x2*)(orow + 32 + d) = c; }
    __syncthreads();
}

__device__ __forceinline__ size_t s5_state_off(int cid, int b, int dir, int g) { return ((((size_t)cid * NB + b) * 2 + dir) * 16 + g) * 128; }
__device__ __forceinline__ int s5_row0(int cid, int b) { return cid < 8 ? b * CTXL + 32 * cid : NCTX + b * SEQ + 32 * (cid - 8); }
__device__ __forceinline__ void cmac(float& sr, float& si, float ar, float ai, float br, float bi) {
    float nr, ni;
    asm volatile("v_fma_f32 %0, %2, %3, %6\n\tv_fma_f32 %1, %2, %4, %7\n\tv_fma_f32 %0, -%5, %4, %0\n\tv_fma_f32 %1, %5, %3, %1" : "=&v"(nr), "=&v"(ni) : "v"(ar), "v"(sr), "v"(si), "v"(ai), "v"(br), "v"(bi));
    sr = nr; si = ni;
}
constexpr int S5_SP = 132;
template <int MODE> __device__ __forceinline__ void unit_s5(Frame& F, int l, int u) {
    LAUNDER(F);
    const int g = u >> 4, b = (u >> 1) & 7, hf = u & 1;
    const int lane = F.lane, w = F.wave, half = lane >> 5, ql = lane & 31;
    const GAS bf16* P = (const GAS bf16*)(F.ws + WS_U + U_P);
    LAS float* Sb = (LAS float*)(F.lds + w * (32 * S5_SP * 4));
    GAS float* LOC = (GAS float*)(F.ws + WS_LOC); const GAS float* SPREV = (const GAS float*)(F.ws + WS_SPREV); GAS bf16* S5Y = (GAS bf16*)(F.ws + WS_S5Y);
    __syncthreads();
    bf16x8 bfr[2][4], cfr[2][4]; f32x2 abv[2];
#pragma unroll
    for (int dir = 0; dir < 2; ++dir) { const int idx = (l * 2 + dir) * 16 + g;
        const GAS bf16* BbT = (const GAS bf16*)(F.ws + WS_S5T + S5_BBT) + (size_t)idx * 2048; const GAS bf16* CmT = (const GAS bf16*)(F.ws + WS_S5T + S5_CMT) + (size_t)idx * 2048;
#pragma unroll
        for (int nt = 0; nt < 4; ++nt) { bfr[dir][nt] = *(const GAS bf16x8*)(BbT + (32 * nt + ql) * 16 + 8 * half); if (MODE == 1) cfr[dir][nt] = *(const GAS bf16x8*)(CmT + (lane & 15) * 128 + 32 * nt + 8 * (lane >> 4)); }
        abv[dir] = ((const GAS f32x2*)(F.ws + WS_S5T + S5_AB))[idx * 64 + lane]; }
    int cid = 68 * hf + w;
    bf16x8 uf_n = *(const GAS bf16x8*)(P + (size_t)(s5_row0(cid, b) + ql) * INW + V_END + 16 * g + 8 * half);
    const int c0 = 4 * (lane >> 4);
    f32x4 dsk = (f32x4){0.f, 0.f, 0.f, 0.f}; float sp_n[2][2] = {{0.f, 0.f}, {0.f, 0.f}}; u32x2 uu_n[2] = {(u32x2){0u, 0u}, (u32x2){0u, 0u}};
#define S5_PREFETCH(cd) do { _Pragma("unroll") for (int d_ = 0; d_ < 2; ++d_) { const GAS float* q_ = SPREV + s5_state_off((cd), b, d_, g); sp_n[d_][0] = q_[lane]; sp_n[d_][1] = q_[64 + lane]; } \
        _Pragma("unroll") for (int n_ = 0; n_ < 2; ++n_) uu_n[n_] = *(const GAS u32x2*)(P + (size_t)(s5_row0((cd), b) + 16 * n_ + (lane & 15)) * INW + V_END + 16 * g + c0); } while (0)
    if (MODE == 1) { dsk = *(const GAS f32x4*)(F.in[I_S5D + F.z] + l * 256 + 16 * g + c0); S5_PREFETCH(cid); }
#pragma unroll 1
    for (; cid < 68 * hf + 68; cid += 8) {
        const int row0 = s5_row0(cid, b);
        const bool skip_out = (MODE == 1) && (l == DEPTH - 1) && (cid < 8);
        const bf16x8 uf = uf_n;
        const float sp_c[2][2] = {{sp_n[0][0], sp_n[0][1]}, {sp_n[1][0], sp_n[1][1]}}; const u32x2 uu_c[2] = {uu_n[0], uu_n[1]};
        if (cid + 8 < 68 * hf + 68) { uf_n = *(const GAS bf16x8*)(P + (size_t)(s5_row0(cid + 8, b) + ql) * INW + V_END + 16 * g + 8 * half);
            if (MODE == 1) S5_PREFETCH(cid + 8); }
        f32x4 yacc[2] = {zero4(), zero4()};
#pragma unroll
        for (int dir = 0; dir < 2; ++dir) { if (skip_out) continue;
#pragma unroll
            for (int nt = 0; nt < 4; ++nt) {
                f32x16 acc = (f32x16){0.f, 0.f, 0.f, 0.f, 0.f, 0.f, 0.f, 0.f, 0.f, 0.f, 0.f, 0.f, 0.f, 0.f, 0.f, 0.f};
                acc = __builtin_amdgcn_mfma_f32_32x32x16_bf16(uf, bfr[dir][nt], acc, 0, 0, 0);
                asm volatile("s_nop 15\n\ts_nop 3" : "+v"(acc));
                u32x4 w0, w1;
                w0.x = pk2(acc[0], acc[1]); w0.y = pk2(acc[2], acc[3]); w0.z = pk2(acc[4], acc[5]); w0.w = pk2(acc[6], acc[7]);
                w1.x = pk2(acc[8], acc[9]); w1.y = pk2(acc[10], acc[11]); w1.z = pk2(acc[12], acc[13]); w1.w = pk2(acc[14], acc[15]);
                LAS unsigned char* bq = (LAS unsigned char*)Sb + (32 * nt + ql) * 80 + 32 * half;
                *(LAS u32x4*)bq = w0; *(LAS u32x4*)(bq + 16) = w1; }
            LDS_WAIT(); __builtin_amdgcn_wave_barrier();
            { const f32x2 ab = abv[dir]; float sr = 0.f, si = 0.f;
              if (MODE == 1) { sr = sp_c[dir][0]; si = sp_c[dir][1]; }
              float br[32], bi[32];
              { u32x4 qr[4], qi[4];
#pragma unroll
                for (int c = 0; c < 4; ++c) { qr[c] = *(const LAS u32x4*)((const LAS unsigned char*)Sb + lane * 80 + 16 * c); qi[c] = *(const LAS u32x4*)((const LAS unsigned char*)Sb + (64 + lane) * 80 + 16 * c); }
#pragma unroll
                for (int k = 0; k < 32; ++k) { const int pos = 16 * ((k >> 2) & 1) + 4 * (k >> 3) + (k & 3), d = pos >> 1; const unsigned wr_ = qr[d >> 2][d & 3], wi_ = qi[d >> 2][d & 3];
                    br[k] = (pos & 1) ? bfhi(wr_) : bflo(wr_); bi[k] = (pos & 1) ? bfhi(wi_) : bflo(wi_); } }
              if (dir == 0) {
#pragma unroll
                  for (int k = 0; k < 32; ++k) { cmac(sr, si, ab.x, ab.y, br[k], bi[k]); br[k] = sr; bi[k] = si; }
              } else {
#pragma unroll
                  for (int k = 31; k >= 0; --k) { cmac(sr, si, ab.x, ab.y, br[k], bi[k]); br[k] = sr; bi[k] = si; }
              }
              if (MODE == 1) {
#pragma unroll
                  for (int c = 0; c < 4; ++c) { u32x4 wr_, wi_;
#pragma unroll
                      for (int e = 0; e < 4; ++e) { const int m = 4 * c + e, k = 8 * ((m >> 1) & 3) + 4 * (m >> 3) + 2 * (m & 1); wr_[e] = pk2(br[k], br[k + 1]); wi_[e] = pk2(bi[k], bi[k + 1]); }
                      *(LAS u32x4*)((LAS unsigned char*)Sb + lane * 80 + 16 * c) = wr_; *(LAS u32x4*)((LAS unsigned char*)Sb + (64 + lane) * 80 + 16 * c) = wi_; } }
              if (MODE == 0) { GAS float* lp = LOC + s5_state_off(cid, b, dir, g); lp[lane] = sr; lp[64 + lane] = si; } }
            if (MODE == 1) {
                LDS_WAIT(); __builtin_amdgcn_wave_barrier();
                const int kq = lane >> 4, gq = (lane & 15) >> 2, gp = lane & 3;
                const LAS unsigned char* tb = (const LAS unsigned char*)Sb + (8 * kq + gq) * 80 + 32 * (gp & 1) + 8 * (gp >> 1);
#pragma unroll
                for (int ks = 0; ks < 4; ++ks) { const bf16x8 cf = cfr[dir][ks];
#pragma unroll
                    for (int ntk = 0; ntk < 2; ++ntk) { const LAS unsigned char* tp = tb + (32 * ks) * 80 + 16 * ntk;
                        union { bf16x8 v; s16x4 h[2]; } sf;
                        sf.h[0] = __builtin_amdgcn_ds_read_tr16_b64_v4i16((LAS s16x4*)tp); sf.h[1] = __builtin_amdgcn_ds_read_tr16_b64_v4i16((LAS s16x4*)(tp + 4 * 80));
                        yacc[ntk] = __builtin_amdgcn_mfma_f32_16x16x32_bf16(cf, sf.v, yacc[ntk], 0, 0, 0); } }
                LDS_WAIT(); __builtin_amdgcn_wave_barrier();
            }
        }
        if (MODE == 1 && !skip_out) {
#pragma unroll
            for (int ntk = 0; ntk < 2; ++ntk) { const int row = row0 + 16 * ntk + (lane & 15);
                const u32x2 uu = uu_c[ntk];
                const float y0 = yacc[ntk][0] + bflo(uu.x) * dsk[0], y1 = yacc[ntk][1] + bfhi(uu.x) * dsk[1], y2 = yacc[ntk][2] + bflo(uu.y) * dsk[2], y3 = yacc[ntk][3] + bfhi(uu.y) * dsk[3];
                u32x2 o; o.x = pk2(y0, y1); o.y = pk2(y2, y3); *(GAS u32x2*)(S5Y + (size_t)row * 256 + 16 * g + c0) = o; }
        }
    }
#undef S5_PREFETCH
    __syncthreads();
}
__device__ __forceinline__ void unit_s5_carry(Frame& F, int l, int u) {
    LAUNDER(F);
    const int gt = u * 512 + F.tid, p = gt & 63, g = (gt >> 6) & 15, dir = (gt >> 10) & 1, b = gt >> 11;
    const GAS float* LOC = (const GAS float*)(F.ws + WS_LOC); GAS float* SPREV = (GAS float*)(F.ws + WS_SPREV);
    const f32x2 a32 = ((const GAS f32x2*)(F.ws + WS_S5T + S5_A32))[((l * 2 + dir) * 16 + g) * 64 + p];
    float sr = 0.f, si = 0.f;
#pragma unroll 1
    for (int k0 = 0; k0 < NCH; k0 += 8) {
        float lr[8], li[8];
#pragma unroll
        for (int j = 0; j < 8; ++j) { const int k = k0 + j, cid = dir == 0 ? k : (k < 8 ? 7 - k : 143 - k); const GAS float* lp = LOC + s5_state_off(cid, b, dir, g); lr[j] = lp[p]; li[j] = lp[64 + p]; }
#pragma unroll
        for (int j = 0; j < 8; ++j) { const int k = k0 + j, cid = dir == 0 ? k : (k < 8 ? 7 - k : 143 - k); GAS float* sp = SPREV + s5_state_off(cid, b, dir, g); sp[p] = sr; sp[64 + p] = si;
            cmac(sr, si, a32.x, a32.y, lr[j], li[j]); }
    }
}

constexpr int MX_P = 1032, GA_P = 264, MX_BYTES = 32 * MX_P * 2  , GA_OFF = MX_BYTES;
__device__ __forceinline__ float gelu_tanh(float x) { const float t = 0.7978845608028654f * (x + 0.044715f * x * x * x); const float e = __expf(2.0f * t); return 0.5f * x * (1.0f + (1.0f - 2.0f * __builtin_amdgcn_rcpf(e + 1.0f))); }
__device__ __forceinline__ void unit_mixfinal(Frame& F, int l, int u) {
    LAUNDER(F);
    const int row0 = u * 32, lane = F.lane, w = F.wave;
    LAS bf16* MX = (LAS bf16*)F.lds; LAS bf16* GA = (LAS bf16*)(F.lds + GA_OFF);
    const GAS bf16* ATT = (const GAS bf16*)(F.ws + WS_U + U_ATT); const GAS bf16* S5Y = (const GAS bf16*)(F.ws + WS_S5Y);
    bf16x8 wfr[8][2]; f32x4 gbv[2];
    { const GAS bf16* GLUT = (const GAS bf16*)(F.ws + WS_S5T + S5_GLUT) + (size_t)l * 256 * 256;
#pragma unroll
      for (int ks = 0; ks < 8; ++ks)
#pragma unroll
          for (int nt = 0; nt < 2; ++nt) wfr[ks][nt] = *(const GAS bf16x8*)(GLUT + (size_t)(32 * w + 16 * nt + (lane & 15)) * 256 + 32 * ks + 8 * (lane >> 4));
#pragma unroll
      for (int nt = 0; nt < 2; ++nt) gbv[nt] = *(const GAS f32x4*)(F.in[I_GLUB + F.z] + l * 256 + 32 * w + 16 * nt + 4 * (lane >> 4)); }
    __syncthreads();
    const bool isctx = row0 < NCTX; const int bq = isctx ? 0 : (row0 - NCTX) / SEQ, t0 = isctx ? 0 : (row0 - NCTX) % SEQ;
    u32x4 hyv[2], atv[4], s5v[2];
#pragma unroll
    for (int k = 0; k < 2; ++k) { const int i = F.tid + 512 * k;
        if (isctx) { const int r = i >> 5, c = i & 31; hyv[k] = *(const GAS u32x4*)((const GAS bf16*)(F.ws + WS_HYC) + (size_t)(row0 + r) * 256 + 8 * c); }
        else { const int ch = i >> 2, part = i & 3; hyv[k] = *(const GAS u32x4*)((const GAS bf16*)(F.ws + WS_U + U_HYT) + ((size_t)ch * NB + bq) * SEQ + t0 + 8 * part); }
        { const int r = i >> 5, c = i & 31; s5v[k] = *(const GAS u32x4*)(S5Y + (size_t)(row0 + r) * 256 + 8 * c); } }
#pragma unroll
    for (int k = 0; k < 4; ++k) { const int i = F.tid + 512 * k, r = i >> 6, c = i & 63; atv[k] = *(const GAS u32x4*)(ATT + (size_t)(row0 + r) * 512 + 8 * c); }
#pragma unroll
    for (int k = 0; k < 2; ++k) { const int i = F.tid + 512 * k;
        if (isctx) { const int r = i >> 5, c = i & 31; *(LAS u32x4*)(MX + r * MX_P + 8 * c) = hyv[k]; }
        else { const int ch = i >> 2, part = i & 3; const unsigned vw[4] = {hyv[k].x, hyv[k].y, hyv[k].z, hyv[k].w};
#pragma unroll
            for (int j = 0; j < 4; ++j) { MX[(8 * part + 2 * j) * MX_P + ch] = (bf16)(vw[j] & 0xffffu); MX[(8 * part + 2 * j + 1) * MX_P + ch] = (bf16)(vw[j] >> 16); } }
        { const int r = i >> 5, c = i & 31; const u32x4 v = s5v[k];
          u32x4 o; o.x = pk2(gelu_tanh(bflo(v.x)), gelu_tanh(bfhi(v.x))); o.y = pk2(gelu_tanh(bflo(v.y)), gelu_tanh(bfhi(v.y))); o.z = pk2(gelu_tanh(bflo(v.z)), gelu_tanh(bfhi(v.z))); o.w = pk2(gelu_tanh(bflo(v.w)), gelu_tanh(bfhi(v.w)));
          *(LAS u32x4*)(GA + r * GA_P + 8 * c) = o; } }
#pragma unroll
    for (int k = 0; k < 4; ++k) { const int i = F.tid + 512 * k, r = i >> 6, c = i & 63; *(LAS u32x4*)(MX + r * MX_P + 256 + 8 * c) = atv[k]; }
    __syncthreads();
    { const int c16 = lane & 15, kq = lane >> 4;
      f32x4 acc[2][2];
#pragma unroll
      for (int mt = 0; mt < 2; ++mt)
#pragma unroll
          for (int nt = 0; nt < 2; ++nt) acc[mt][nt] = zero4();
#pragma unroll
      for (int ks = 0; ks < 8; ++ks) {
          bf16x8 wf[2], gf[2];
#pragma unroll
          for (int nt = 0; nt < 2; ++nt) wf[nt] = wfr[ks][nt];
#pragma unroll
          for (int mt = 0; mt < 2; ++mt) gf[mt] = *(const LAS bf16x8*)(GA + (16 * mt + c16) * GA_P + 32 * ks + 8 * kq);
#pragma unroll
          for (int mt = 0; mt < 2; ++mt)
#pragma unroll
              for (int nt = 0; nt < 2; ++nt) acc[mt][nt] = __builtin_amdgcn_mfma_f32_16x16x32_bf16(wf[nt], gf[mt], acc[mt][nt], 0, 0, 0); }
#pragma unroll
      for (int mt = 0; mt < 2; ++mt)
#pragma unroll
          for (int nt = 0; nt < 2; ++nt) { const int n0 = 32 * w + 16 * nt + 4 * kq, tok = 16 * mt + c16;
              const f32x4 gb = gbv[nt]; const u32x2 gg = *(const LAS u32x2*)(GA + tok * GA_P + n0);
              const float g0 = bflo(gg.x), g1 = bfhi(gg.x), g2 = bflo(gg.y), g3 = bfhi(gg.y);
              u32x2 o; o.x = pk2(g0 * __builtin_amdgcn_rcpf(1.0f + __expf(-(acc[mt][nt][0] + gb[0]))), g1 * __builtin_amdgcn_rcpf(1.0f + __expf(-(acc[mt][nt][1] + gb[1]))));
              o.y = pk2(g2 * __builtin_amdgcn_rcpf(1.0f + __expf(-(acc[mt][nt][2] + gb[2]))), g3 * __builtin_amdgcn_rcpf(1.0f + __expf(-(acc[mt][nt][3] + gb[3]))));
              *(LAS u32x2*)(MX + tok * MX_P + 768 + n0) = o; } }
    __syncthreads();
    { GAS bf16* MIXN = (GAS bf16*)(F.ws + WS_U + U_MIXN);
      const int c0 = lane < 32 ? 256 + 16 * lane : lane < 48 ? 16 * (lane - 32) : 768 + 16 * (lane - 48);
      const GAS float* gn = F.in[I_MIXG + F.z] + l * 1024 + c0;
      f32x4 gv[4];
#pragma unroll
      for (int j = 0; j < 4; ++j) gv[j] = *(const GAS f32x4*)(gn + 4 * j);
      float x[4][16], ss[4];
#pragma unroll
      for (int k = 0; k < 4; ++k) { const int tok = 4 * w + k; const u32x4 a = *(const LAS u32x4*)(MX + tok * MX_P + c0), c = *(const LAS u32x4*)(MX + tok * MX_P + c0 + 8);
          const unsigned ww[8] = {a.x, a.y, a.z, a.w, c.x, c.y, c.z, c.w}; float s_ = 0.f;
#pragma unroll
          for (int j = 0; j < 8; ++j) { x[k][2 * j] = bflo(ww[j]); x[k][2 * j + 1] = bfhi(ww[j]); s_ += x[k][2 * j] * x[k][2 * j] + x[k][2 * j + 1] * x[k][2 * j + 1]; }
          ss[k] = s_; }
#pragma unroll
      for (int o = 1; o < 16; o <<= 1)
#pragma unroll
          for (int k = 0; k < 4; ++k) ss[k] += lane_xor(ss[k], lane, o);
#pragma unroll
      for (int k = 0; k < 4; ++k) { const float t = lane_xor(ss[k], lane, 16); ss[k] += lane < 32 ? t : 0.f; }
      const float invw = lane < 32 ? 1.0f / 512.0f : 1.0f / 256.0f;
#pragma unroll
      for (int k = 0; k < 4; ++k) { const int tok = 4 * w + k; const float rs = 1.0f / sqrtf(ss[k] * invw + EPS);
          u32x4 o8;
          o8.x = pk4_fp8(x[k][0] * rs * gv[0][0], x[k][1] * rs * gv[0][1], x[k][2] * rs * gv[0][2], x[k][3] * rs * gv[0][3]);
          o8.y = pk4_fp8(x[k][4] * rs * gv[1][0], x[k][5] * rs * gv[1][1], x[k][6] * rs * gv[1][2], x[k][7] * rs * gv[1][3]);
          o8.z = pk4_fp8(x[k][8] * rs * gv[2][0], x[k][9] * rs * gv[2][1], x[k][10] * rs * gv[2][2], x[k][11] * rs * gv[2][3]);
          o8.w = pk4_fp8(x[k][12] * rs * gv[3][0], x[k][13] * rs * gv[3][1], x[k][14] * rs * gv[3][2], x[k][15] * rs * gv[3][3]);
          *(GAS u32x4*)((GAS unsigned char*)MIXN + (size_t)(row0 + tok) * 1024 + c0) = o8; } }
    __syncthreads();
}

constexpr int PH_PER_LAYER = 11, PH_L0 = 2, PH_FINAL = PH_L0 + PH_PER_LAYER * DEPTH, NPH = PH_FINAL + 1;

__global__ void __launch_bounds__(512, 2) fwd_kernel(Params p) {
    extern __shared__ __attribute__((aligned(16))) unsigned char lds_raw[];
    Frame F;
    F.lds = (LAS unsigned char*)lds_raw; F.ws = p.ws; F.ctl = (GAS unsigned*)(p.ws + WS_CTL); F.in = p.in; F.out = p.out;
    F.tid = threadIdx.x; F.lane = F.tid & 63; F.wave = __builtin_amdgcn_readfirstlane(F.tid >> 6); F.G = gridDim.x; F.bid = blockIdx.x; F.z = 0;
    if (F.tid < 16) ((volatile LAS unsigned*)(F.lds + LDS_MISC))[F.tid] = 0u;
    __syncthreads();
#if MK_ONE_LAUNCH
    XcdBarrier bar = xcd_barrier_post((unsigned*)(F.ctl + CW_BAR), (volatile LAS unsigned*)(F.lds + LDS_MISC));
#ifndef PROBE_STAMPS
#define PROBE_STAMPS 0
#endif
#ifndef SEL1
#define SEL1 3
#endif
#ifndef SEL2
#define SEL2 4
#endif
#define STAMP(k) do { if (PROBE_STAMPS && F.bid == 0 && F.tid == 0) ((GAS unsigned long long*)(F.ctl + 80000))[(k)] = __builtin_amdgcn_s_memrealtime(); } while (0)
#define SEAM(k) do { if (p.ph_lo <= (k) && (k) + 1 < p.ph_hi) xcd_barrier(bar); STAMP((k) + 1); } while (0)
#else
#define SEAM(k) do { } while (0)
#endif
#ifndef PHMASK
#define PHMASK 0xFFFFFFFFu
#endif
#define IN(k) (p.ph_lo <= (k) && (k) < p.ph_hi)
#ifndef REP_PRO
#define REP_PRO 1
#endif
#ifndef REP_M1
#define REP_M1 1
#endif
#ifndef REP_M2
#define REP_M2 1
#endif
#ifndef REP_M3
#define REP_M3 1
#endif
#ifndef REP_MIX
#define REP_MIX 1
#endif
#ifndef REP_GATHER
#define REP_GATHER 1
#endif
#ifndef REP_GIN
#define REP_GIN 1
#endif
#ifndef REP_UP
#define REP_UP 1
#endif
#ifndef REP_DOWN
#define REP_DOWN 1
#endif
#ifndef STATIC_Q
#define STATIC_Q 0
#endif
#define ON(b) (((PHMASK) >> (b)) & 1u)
#define TAIL_WCONV(total_units) do { if (l + 1 < DEPTH) { const int tot_ = (total_units), rounds_ = (tot_ + F.G - 1) / F.G, mine_ = (tot_ > F.bid) ? (tot_ - F.bid + F.G - 1) / F.G : 0; \
        if (mine_ < rounds_) { for (int k_ = 0; k_ < 2; ++k_) { const int u_ = wq_next(F, 16 + l + 1); if (u_ >= 768) break; unit_wconv(F, l + 1, u_); } } } } while (0)
#define FRESH() do { asm volatile("s_mov_b32 %0, 0" : "=s"(F.z)); asm volatile("" : "+s"(F.ws), "+s"(F.lds), "+v"(F.tid), "+v"(F.lane)); F.ctl = (GAS unsigned*)(F.ws + WS_CTL); } while (0)
    const int lo = p.ph_lo, hi = p.ph_hi; (void)lo; (void)hi;
    unsigned long long ut0_ = 0; (void)ut0_;
#define UT0() do { if (PROBE_STAMPS) ut0_ = __builtin_amdgcn_s_memrealtime(); } while (0)
#define UT1(k) do { if (PROBE_STAMPS) { const unsigned long long d_ = __builtin_amdgcn_s_memrealtime() - ut0_; if (F.bid == 0 && F.tid == 0) { GAS unsigned long long* s_ = (GAS unsigned long long*)(F.ctl + 80000); s_[100 + 2 * (k)] += d_; s_[101 + 2 * (k)] += 1; } } } while (0)

    STAMP(0);
    if (ON(11) && IN(0)) for (int rep = 0; rep < REP_PRO; ++rep) { FRESH(); ph_prologue0(F); }
    SEAM(0);
    if (ON(12) && IN(1)) for (int rep = 0; rep < REP_PRO; ++rep) { FRESH(); ph_prologue1(F); }
    SEAM(1);
    { constexpr int l = 0;
        const int pb = PH_L0 + PH_PER_LAYER * l;
        if (ON(0) && IN(pb + 0)) { FRESH(); ph_norm1(F, l); }
        SEAM(pb + 0);
        if (ON(1) && IN(pb + 1)) for (int rep = 0; rep < REP_GIN; ++rep) { FRESH();
            SchedStd S; S.so.init(NTOK, INW, F.G, F.bid); S.row_off = 0; S.A = (const GAS char*)(F.ws + WS_H); S.Bt = (const GAS char*)(F.ws + WS_WIN) + (size_t)l * INW * D * 2;
            EpiP E{(GAS bf16*)(F.ws + WS_U + U_P), INW};
            pg8::gemm_phase<EpiP, SchedStd>(F.lds, S, E, F.tid);
            TAIL_WCONV((NTOK / 256) * (INW / 256));
        }
        SEAM(pb + 1);
        if (ON(2) && IN(pb + 2)) for (int rep = 0; rep < REP_M1; ++rep) { FRESH();
            constexpr int N0 = 544, N1 = N0 + 768, N2 = N1 + 256, N3 = N2;
            for (int u_ = F.bid;; u_ += F.G) { __syncthreads(); const int u = STATIC_Q ? u_ : wq_next(F, l * 4 + 0); if (u >= N3) break;
                if (u < N0) unit_prep_qk(F, u);
                else if (u < N1) unit_hy_prep(F, l, u - N0);
                else unit_s5<0>(F, l, u - N1); }
        }
        SEAM(pb + 2);
        if (ON(3) && IN(pb + 3)) for (int rep = 0; rep < REP_M2; ++rep) { FRESH();
            constexpr int N0 = 32, N1 = N0 + 256, N2 = N1 + 1088, N3 = N2 + 256;
            for (int u_ = F.bid;; u_ += F.G) { __syncthreads(); const int u = STATIC_Q ? u_ : wq_next(F, l * 4 + 1); if (u >= N3) break;
                if (u < N0) unit_s5_carry(F, l, u);
                else if (u < N1) { UT0(); unit_hy_conv(F, l, 0, u - N0); UT1(1); }
                else if (u < N2) { if (!(l == DEPTH - 1 && u - N1 >= 1024)) { UT0(); unit_attn(F, l, u - N1); UT1(0); } }
                else if (l < DEPTH - 1) unit_hy_ctx(F, l, u - N2); }
        }
        SEAM(pb + 3);
        if (ON(4) && IN(pb + 4)) for (int rep = 0; rep < REP_M3; ++rep) { FRESH();
            constexpr int N0 = 256, N1 = N0 + 256;
            for (int u_ = F.bid;; u_ += F.G) { __syncthreads(); const int u = STATIC_Q ? u_ : wq_next(F, l * 4 + 2); if (u >= N1) break;
                if (u < N0) { UT0(); unit_hy_conv(F, l, 1, u); UT1(2); }
                else { UT0(); unit_s5<1>(F, l, u - N0); UT1(3); } }
            for (;;) { const int u = wq_next(F, 16 + l); if (u >= 768) break; unit_wconv(F, l, u); }
        }
        SEAM(pb + 4);
        if (ON(5) && IN(pb + 5)) for (int rep = 0; rep < REP_MIX; ++rep) { FRESH(); for (;;) { const int u = wq_next(F, l * 4 + 3) + ((l == DEPTH - 1) ? NCTX / 32 : 0); if (u >= NTOK / 32) break; unit_mixfinal(F, l, u); } }
        SEAM(pb + 5);
        if (ON(6) && IN(pb + 6)) { FRESH();
            const int roff = (l == DEPTH - 1) ? NCTX : 0;
            SchedStd8 S; S.so.init(NTOK - roff, D, F.G, F.bid); S.row_off = roff; S.A = (const GAS char*)(F.ws + WS_U + U_MIXN); S.Bt = (const GAS char*)(F.ws + WS_WOUT) + (size_t)l * D * D;
            EpiOut E{(GAS bf16*)(F.ws + WS_U + U_DELTA), (const GAS float*)(F.ws + WS_MOD) + (size_t)l * 9 * 6144};
            pg8::gemm_phase<EpiOut, SchedStd8>(F.lds, S, E, F.tid);
            TAIL_WCONV(((NTOK - roff) / 256) * (D / 256));
        }
        SEAM(pb + 6);
        if (ON(7) && IN(pb + 7)) { FRESH(); ph_norm2_router(F, l); }
        SEAM(pb + 7);
        if (ON(8) && IN(pb + 8)) { }
        if (ON(9) && IN(pb + 9)) for (int rep = 0; rep < REP_UP; ++rep) { FRESH();
            volatile LAS int* tab = (volatile LAS int*)(F.lds + LDS_BYTES - 512);
            moe_tables(F, l, tab);
            {
              const GAS unsigned* ELIST = (const GAS unsigned*)(F.ws + WS_ELIST); LAS unsigned* gt = (LAS unsigned*)(F.lds + pg8::GATHER_TAB);
              const int total = tab[16] * 8;
              for (int it = F.tid; it < 16 * 256; it += 512) { const int k = it >> 8, r = it & 255, L = k * F.G + F.bid;
                  if (L < total) { const int mg = L >> 3; int e = 0; for (int q = 1; q < 16; ++q) e += (mg >= tab[q]) ? 1 : 0; const int pos = 256 * (mg - tab[e]) + r;
                      gt[it] = pos < tab[32 + e] ? (ELIST[(size_t)e * ECAP + pos] >> 1) * 1024u : 0u; } }
              __syncthreads(); }
            SchedMoe<0> S; S.tab = tab; S.G = F.G; S.c = F.bid; S.A = (const GAS char*)(F.ws + WS_H); S.W0 = (const GAS char*)(F.ws + wmoe_off(l)); S.W1 = (const GAS char*)(F.ws + wmoe_off(l) + 32 * MiB);
            EpiUp E{(GAS unsigned char*)(F.ws + WS_U + U_ACT)};
            pg8::gemm_phase<EpiUp, SchedMoe<0>>(F.lds, S, E, F.tid);
            TAIL_WCONV(tab[16] * 8);
        }
        SEAM(pb + 9);
        if (ON(10) && IN(pb + 10)) for (int rep = 0; rep < REP_DOWN; ++rep) { FRESH();
            volatile LAS int* tab = (volatile LAS int*)(F.lds + LDS_BYTES - 512);
            moe_tables(F, l, tab);
            SchedMoe<1> S; S.tab = tab; S.G = F.G; S.c = F.bid; S.A = (const GAS char*)(F.ws + WS_U + U_ACT); S.W0 = (const GAS char*)(F.ws + wmoe_off(l) + 64 * MiB); S.W1 = nullptr;
            EpiDown E{(GAS bf16*)(F.ws + WS_U + U_YB), (const GAS unsigned*)(F.ws + WS_ELIST), (const GAS float*)(F.ws + WS_WLIST)};
            pg8::gemm_phase<EpiDown, SchedMoe<1>>(F.lds, S, E, F.tid);
            TAIL_WCONV(tab[16] * 4);
        }
        SEAM(pb + 10);
        }
    { constexpr int l = 1;
        const int pb = PH_L0 + PH_PER_LAYER * l;
        if (ON(0) && IN(pb + 0)) { FRESH(); ph_norm1(F, l); }
        SEAM(pb + 0);
        if (ON(1) && IN(pb + 1)) for (int rep = 0; rep < REP_GIN; ++rep) { FRESH();
            SchedStd S; S.so.init(NTOK, INW, F.G, F.bid); S.row_off = 0; S.A = (const GAS char*)(F.ws + WS_H); S.Bt = (const GAS char*)(F.ws + WS_WIN) + (size_t)l * INW * D * 2;
            EpiP E{(GAS bf16*)(F.ws + WS_U + U_P), INW};
            pg8::gemm_phase<EpiP, SchedStd>(F.lds, S, E, F.tid);
            TAIL_WCONV((NTOK / 256) * (INW / 256));
        }
        SEAM(pb + 1);
        if (ON(2) && IN(pb + 2)) for (int rep = 0; rep < REP_M1; ++rep) { FRESH();
            constexpr int N0 = 544, N1 = N0 + 768, N2 = N1 + 256, N3 = N2;
            for (int u_ = F.bid;; u_ += F.G) { __syncthreads(); const int u = STATIC_Q ? u_ : wq_next(F, l * 4 + 0); if (u >= N3) break;
                if (u < N0) unit_prep_qk(F, u);
                else if (u < N1) unit_hy_prep(F, l, u - N0);
                else unit_s5<0>(F, l, u - N1); }
        }
        SEAM(pb + 2);
        if (ON(3) && IN(pb + 3)) for (int rep = 0; rep < REP_M2; ++rep) { FRESH();
            constexpr int N0 = 32, N1 = N0 + 256, N2 = N1 + 1088, N3 = N2 + 256;
            for (int u_ = F.bid;; u_ += F.G) { __syncthreads(); const int u = STATIC_Q ? u_ : wq_next(F, l * 4 + 1); if (u >= N3) break;
                if (u < N0) unit_s5_carry(F, l, u);
                else if (u < N1) { UT0(); unit_hy_conv(F, l, 0, u - N0); UT1(1); }
                else if (u < N2) { if (!(l == DEPTH - 1 && u - N1 >= 1024)) { UT0(); unit_attn(F, l, u - N1); UT1(0); } }
                else if (l < DEPTH - 1) unit_hy_ctx(F, l, u - N2); }
        }
        SEAM(pb + 3);
        if (ON(4) && IN(pb + 4)) for (int rep = 0; rep < REP_M3; ++rep) { FRESH();
            constexpr int N0 = 256, N1 = N0 + 256;
            for (int u_ = F.bid;; u_ += F.G) { __syncthreads(); const int u = STATIC_Q ? u_ : wq_next(F, l * 4 + 2); if (u >= N1) break;
                if (u < N0) { UT0(); unit_hy_conv(F, l, 1, u); UT1(2); }
                else { UT0(); unit_s5<1>(F, l, u - N0); UT1(3); } }
            for (;;) { const int u = wq_next(F, 16 + l); if (u >= 768) break; unit_wconv(F, l, u); }
        }
        SEAM(pb + 4);
        if (ON(5) && IN(pb + 5)) for (int rep = 0; rep < REP_MIX; ++rep) { FRESH(); for (;;) { const int u = wq_next(F, l * 4 + 3) + ((l == DEPTH - 1) ? NCTX / 32 : 0); if (u >= NTOK / 32) break; unit_mixfinal(F, l, u); } }
        SEAM(pb + 5);
        if (ON(6) && IN(pb + 6)) { FRESH();
            const int roff = (l == DEPTH - 1) ? NCTX : 0;
            SchedStd8 S; S.so.init(NTOK - roff, D, F.G, F.bid); S.row_off = roff; S.A = (const GAS char*)(F.ws + WS_U + U_MIXN); S.Bt = (const GAS char*)(F.ws + WS_WOUT) + (size_t)l * D * D;
            EpiOut E{(GAS bf16*)(F.ws + WS_U + U_DELTA), (const GAS float*)(F.ws + WS_MOD) + (size_t)l * 9 * 6144};
            pg8::gemm_phase<EpiOut, SchedStd8>(F.lds, S, E, F.tid);
            TAIL_WCONV(((NTOK - roff) / 256) * (D / 256));
        }
        SEAM(pb + 6);
        if (ON(7) && IN(pb + 7)) { FRESH(); ph_norm2_router(F, l); }
        SEAM(pb + 7);
        if (ON(8) && IN(pb + 8)) { }
        if (ON(9) && IN(pb + 9)) for (int rep = 0; rep < REP_UP; ++rep) { FRESH();
            volatile LAS int* tab = (volatile LAS int*)(F.lds + LDS_BYTES - 512);
            moe_tables(F, l, tab);
            {
              const GAS unsigned* ELIST = (const GAS unsigned*)(F.ws + WS_ELIST); LAS unsigned* gt = (LAS unsigned*)(F.lds + pg8::GATHER_TAB);
              const int total = tab[16] * 8;
              for (int it = F.tid; it < 16 * 256; it += 512) { const int k = it >> 8, r = it & 255, L = k * F.G + F.bid;
                  if (L < total) { const int mg = L >> 3; int e = 0; for (int q = 1; q < 16; ++q) e += (mg >= tab[q]) ? 1 : 0; const int pos = 256 * (mg - tab[e]) + r;
                      gt[it] = pos < tab[32 + e] ? (ELIST[(size_t)e * ECAP + pos] >> 1) * 1024u : 0u; } }
              __syncthreads(); }
            SchedMoe<0> S; S.tab = tab; S.G = F.G; S.c = F.bid; S.A = (const GAS char*)(F.ws + WS_H); S.W0 = (const GAS char*)(F.ws + wmoe_off(l)); S.W1 = (const GAS char*)(F.ws + wmoe_off(l) + 32 * MiB);
            EpiUp E{(GAS unsigned char*)(F.ws + WS_U + U_ACT)};
            pg8::gemm_phase<EpiUp, SchedMoe<0>>(F.lds, S, E, F.tid);
            TAIL_WCONV(tab[16] * 8);
        }
        SEAM(pb + 9);
        if (ON(10) && IN(pb + 10)) for (int rep = 0; rep < REP_DOWN; ++rep) { FRESH();
            volatile LAS int* tab = (volatile LAS int*)(F.lds + LDS_BYTES - 512);
            moe_tables(F, l, tab);
            SchedMoe<1> S; S.tab = tab; S.G = F.G; S.c = F.bid; S.A = (const GAS char*)(F.ws + WS_U + U_ACT); S.W0 = (const GAS char*)(F.ws + wmoe_off(l) + 64 * MiB); S.W1 = nullptr;
            EpiDown E{(GAS bf16*)(F.ws + WS_U + U_YB), (const GAS unsigned*)(F.ws + WS_ELIST), (const GAS float*)(F.ws + WS_WLIST)};
            pg8::gemm_phase<EpiDown, SchedMoe<1>>(F.lds, S, E, F.tid);
            TAIL_WCONV(tab[16] * 4);
        }
        SEAM(pb + 10);
        }
    { constexpr int l = 2;
        const int pb = PH_L0 + PH_PER_LAYER * l;
        if (ON(0) && IN(pb + 0)) { FRESH(); ph_norm1(F, l); }
        SEAM(pb + 0);
        if (ON(1) && IN(pb + 1)) for (int rep = 0; rep < REP_GIN; ++rep) { FRESH();
            SchedStd S; S.so.init(NTOK, INW, F.G, F.bid); S.row_off = 0; S.A = (const GAS char*)(F.ws + WS_H); S.Bt = (const GAS char*)(F.ws + WS_WIN) + (size_t)l * INW * D * 2;
            EpiP E{(GAS bf16*)(F.ws + WS_U + U_P), INW};
            pg8::gemm_phase<EpiP, SchedStd>(F.lds, S, E, F.tid);
            TAIL_WCONV((NTOK / 256) * (INW / 256));
        }
        SEAM(pb + 1);
        if (ON(2) && IN(pb + 2)) for (int rep = 0; rep < REP_M1; ++rep) { FRESH();
            constexpr int N0 = 544, N1 = N0 + 768, N2 = N1 + 256, N3 = N2;
            for (int u_ = F.bid;; u_ += F.G) { __syncthreads(); const int u = STATIC_Q ? u_ : wq_next(F, l * 4 + 0); if (u >= N3) break;
                if (u < N0) unit_prep_qk(F, u);
                else if (u < N1) unit_hy_prep(F, l, u - N0);
                else unit_s5<0>(F, l, u - N1); }
        }
        SEAM(pb + 2);
        if (ON(3) && IN(pb + 3)) for (int rep = 0; rep < REP_M2; ++rep) { FRESH();
            constexpr int N0 = 32, N1 = N0 + 256, N2 = N1 + 1088, N3 = N2 + 256;
            for (int u_ = F.bid;; u_ += F.G) { __syncthreads(); const int u = STATIC_Q ? u_ : wq_next(F, l * 4 + 1); if (u >= N3) break;
                if (u < N0) unit_s5_carry(F, l, u);
                else if (u < N1) { UT0(); unit_hy_conv(F, l, 0, u - N0); UT1(1); }
                else if (u < N2) { if (!(l == DEPTH - 1 && u - N1 >= 1024)) { UT0(); unit_attn(F, l, u - N1); UT1(0); } }
                else if (l < DEPTH - 1) unit_hy_ctx(F, l, u - N2); }
        }
        SEAM(pb + 3);
        if (ON(4) && IN(pb + 4)) for (int rep = 0; rep < REP_M3; ++rep) { FRESH();
            constexpr int N0 = 256, N1 = N0 + 256;
            for (int u_ = F.bid;; u_ += F.G) { __syncthreads(); const int u = STATIC_Q ? u_ : wq_next(F, l * 4 + 2); if (u >= N1) break;
                if (u < N0) { UT0(); unit_hy_conv(F, l, 1, u); UT1(2); }
                else { UT0(); unit_s5<1>(F, l, u - N0); UT1(3); } }
            for (;;) { const int u = wq_next(F, 16 + l); if (u >= 768) break; unit_wconv(F, l, u); }
        }
        SEAM(pb + 4);
        if (ON(5) && IN(pb + 5)) for (int rep = 0; rep < REP_MIX; ++rep) { FRESH(); for (;;) { const int u = wq_next(F, l * 4 + 3) + ((l == DEPTH - 1) ? NCTX / 32 : 0); if (u >= NTOK / 32) break; unit_mixfinal(F, l, u); } }
        SEAM(pb + 5);
        if (ON(6) && IN(pb + 6)) { FRESH();
            const int roff = (l == DEPTH - 1) ? NCTX : 0;
            SchedStd8 S; S.so.init(NTOK - roff, D, F.G, F.bid); S.row_off = roff; S.A = (const GAS char*)(F.ws + WS_U + U_MIXN); S.Bt = (const GAS char*)(F.ws + WS_WOUT) + (size_t)l * D * D;
            EpiOut E{(GAS bf16*)(F.ws + WS_U + U_DELTA), (const GAS float*)(F.ws + WS_MOD) + (size_t)l * 9 * 6144};
            pg8::gemm_phase<EpiOut, SchedStd8>(F.lds, S, E, F.tid);
            TAIL_WCONV(((NTOK - roff) / 256) * (D / 256));
        }
        SEAM(pb + 6);
        if (ON(7) && IN(pb + 7)) { FRESH(); ph_norm2_router(F, l); }
        SEAM(pb + 7);
        if (ON(8) && IN(pb + 8)) { }
        if (ON(9) && IN(pb + 9)) for (int rep = 0; rep < REP_UP; ++rep) { FRESH();
            volatile LAS int* tab = (volatile LAS int*)(F.lds + LDS_BYTES - 512);
            moe_tables(F, l, tab);
            {
              const GAS unsigned* ELIST = (const GAS unsigned*)(F.ws + WS_ELIST); LAS unsigned* gt = (LAS unsigned*)(F.lds + pg8::GATHER_TAB);
              const int total = tab[16] * 8;
              for (int it = F.tid; it < 16 * 256; it += 512) { const int k = it >> 8, r = it & 255, L = k * F.G + F.bid;
                  if (L < total) { const int mg = L >> 3; int e = 0; for (int q = 1; q < 16; ++q) e += (mg >= tab[q]) ? 1 : 0; const int pos = 256 * (mg - tab[e]) + r;
                      gt[it] = pos < tab[32 + e] ? (ELIST[(size_t)e * ECAP + pos] >> 1) * 1024u : 0u; } }
              __syncthreads(); }
            SchedMoe<0> S; S.tab = tab; S.G = F.G; S.c = F.bid; S.A = (const GAS char*)(F.ws + WS_H); S.W0 = (const GAS char*)(F.ws + wmoe_off(l)); S.W1 = (const GAS char*)(F.ws + wmoe_off(l) + 32 * MiB);
            EpiUp E{(GAS unsigned char*)(F.ws + WS_U + U_ACT)};
            pg8::gemm_phase<EpiUp, SchedMoe<0>>(F.lds, S, E, F.tid);
            TAIL_WCONV(tab[16] * 8);
        }
        SEAM(pb + 9);
        if (ON(10) && IN(pb + 10)) for (int rep = 0; rep < REP_DOWN; ++rep) { FRESH();
            volatile LAS int* tab = (volatile LAS int*)(F.lds + LDS_BYTES - 512);
            moe_tables(F, l, tab);
            SchedMoe<1> S; S.tab = tab; S.G = F.G; S.c = F.bid; S.A = (const GAS char*)(F.ws + WS_U + U_ACT); S.W0 = (const GAS char*)(F.ws + wmoe_off(l) + 64 * MiB); S.W1 = nullptr;
            EpiDown E{(GAS bf16*)(F.ws + WS_U + U_YB), (const GAS unsigned*)(F.ws + WS_ELIST), (const GAS float*)(F.ws + WS_WLIST)};
            pg8::gemm_phase<EpiDown, SchedMoe<1>>(F.lds, S, E, F.tid);
            TAIL_WCONV(tab[16] * 4);
        }
        SEAM(pb + 10);
        }
    { constexpr int l = 3;
        const int pb = PH_L0 + PH_PER_LAYER * l;
        if (ON(0) && IN(pb + 0)) { FRESH(); ph_norm1(F, l); }
        SEAM(pb + 0);
        if (ON(1) && IN(pb + 1)) for (int rep = 0; rep < REP_GIN; ++rep) { FRESH();
            SchedStd S; S.so.init(NTOK, INW, F.G, F.bid); S.row_off = 0; S.A = (const GAS char*)(F.ws + WS_H); S.Bt = (const GAS char*)(F.ws + WS_WIN) + (size_t)l * INW * D * 2;
            EpiP E{(GAS bf16*)(F.ws + WS_U + U_P), INW};
            pg8::gemm_phase<EpiP, SchedStd>(F.lds, S, E, F.tid);
            TAIL_WCONV((NTOK / 256) * (INW / 256));
        }
        SEAM(pb + 1);
        if (ON(2) && IN(pb + 2)) for (int rep = 0; rep < REP_M1; ++rep) { FRESH();
            constexpr int N0 = 544, N1 = N0 + 768, N2 = N1 + 256, N3 = N2;
            for (int u_ = F.bid;; u_ += F.G) { __syncthreads(); const int u = STATIC_Q ? u_ : wq_next(F, l * 4 + 0); if (u >= N3) break;
                if (u < N0) unit_prep_qk(F, u);
                else if (u < N1) unit_hy_prep(F, l, u - N0);
                else unit_s5<0>(F, l, u - N1); }
        }
        SEAM(pb + 2);
        if (ON(3) && IN(pb + 3)) for (int rep = 0; rep < REP_M2; ++rep) { FRESH();
            constexpr int N0 = 32, N1 = N0 + 256, N2 = N1 + 1088, N3 = N2 + 256;
            for (int u_ = F.bid;; u_ += F.G) { __syncthreads(); const int u = STATIC_Q ? u_ : wq_next(F, l * 4 + 1); if (u >= N3) break;
                if (u < N0) unit_s5_carry(F, l, u);
                else if (u < N1) { UT0(); unit_hy_conv(F, l, 0, u - N0); UT1(1); }
                else if (u < N2) { if (!(l == DEPTH - 1 && u - N1 >= 1024)) { UT0(); unit_attn(F, l, u - N1); UT1(0); } }
                else if (l < DEPTH - 1) unit_hy_ctx(F, l, u - N2); }
        }
        SEAM(pb + 3);
        if (ON(4) && IN(pb + 4)) for (int rep = 0; rep < REP_M3; ++rep) { FRESH();
            constexpr int N0 = 256, N1 = N0 + 256;
            for (int u_ = F.bid;; u_ += F.G) { __syncthreads(); const int u = STATIC_Q ? u_ : wq_next(F, l * 4 + 2); if (u >= N1) break;
                if (u < N0) { UT0(); unit_hy_conv(F, l, 1, u); UT1(2); }
                else { UT0(); unit_s5<1>(F, l, u - N0); UT1(3); } }
            for (;;) { const int u = wq_next(F, 16 + l); if (u >= 768) break; unit_wconv(F, l, u); }
        }
        SEAM(pb + 4);
        if (ON(5) && IN(pb + 5)) for (int rep = 0; rep < REP_MIX; ++rep) { FRESH(); for (;;) { const int u = wq_next(F, l * 4 + 3) + ((l == DEPTH - 1) ? NCTX / 32 : 0); if (u >= NTOK / 32) break; unit_mixfinal(F, l, u); } }
        SEAM(pb + 5);
        if (ON(6) && IN(pb + 6)) { FRESH();
            const int roff = (l == DEPTH - 1) ? NCTX : 0;
            SchedStd8 S; S.so.init(NTOK - roff, D, F.G, F.bid); S.row_off = roff; S.A = (const GAS char*)(F.ws + WS_U + U_MIXN); S.Bt = (const GAS char*)(F.ws + WS_WOUT) + (size_t)l * D * D;
            EpiOut E{(GAS bf16*)(F.ws + WS_U + U_DELTA), (const GAS float*)(F.ws + WS_MOD) + (size_t)l * 9 * 6144};
            pg8::gemm_phase<EpiOut, SchedStd8>(F.lds, S, E, F.tid);
            TAIL_WCONV(((NTOK - roff) / 256) * (D / 256));
        }
        SEAM(pb + 6);
        if (ON(7) && IN(pb + 7)) { FRESH(); ph_norm2_router(F, l); }
        SEAM(pb + 7);
        if (ON(8) && IN(pb + 8)) { }
        if (ON(9) && IN(pb + 9)) for (int rep = 0; rep < REP_UP; ++rep) { FRESH();
            volatile LAS int* tab = (volatile LAS int*)(F.lds + LDS_BYTES - 512);
            moe_tables(F, l, tab);
            {
              const GAS unsigned* ELIST = (const GAS unsigned*)(F.ws + WS_ELIST); LAS unsigned* gt = (LAS unsigned*)(F.lds + pg8::GATHER_TAB);
              const int total = tab[16] * 8;
              for (int it = F.tid; it < 16 * 256; it += 512) { const int k = it >> 8, r = it & 255, L = k * F.G + F.bid;
                  if (L < total) { const int mg = L >> 3; int e = 0; for (int q = 1; q < 16; ++q) e += (mg >= tab[q]) ? 1 : 0; const int pos = 256 * (mg - tab[e]) + r;
                      gt[it] = pos < tab[32 + e] ? (ELIST[(size_t)e * ECAP + pos] >> 1) * 1024u : 0u; } }
              __syncthreads(); }
            SchedMoe<0> S; S.tab = tab; S.G = F.G; S.c = F.bid; S.A = (const GAS char*)(F.ws + WS_H); S.W0 = (const GAS char*)(F.ws + wmoe_off(l)); S.W1 = (const GAS char*)(F.ws + wmoe_off(l) + 32 * MiB);
            EpiUp E{(GAS unsigned char*)(F.ws + WS_U + U_ACT)};
            pg8::gemm_phase<EpiUp, SchedMoe<0>>(F.lds, S, E, F.tid);
            TAIL_WCONV(tab[16] * 8);
        }
        SEAM(pb + 9);
        if (ON(10) && IN(pb + 10)) for (int rep = 0; rep < REP_DOWN; ++rep) { FRESH();
            volatile LAS int* tab = (volatile LAS int*)(F.lds + LDS_BYTES - 512);
            moe_tables(F, l, tab);
            SchedMoe<1> S; S.tab = tab; S.G = F.G; S.c = F.bid; S.A = (const GAS char*)(F.ws + WS_U + U_ACT); S.W0 = (const GAS char*)(F.ws + wmoe_off(l) + 64 * MiB); S.W1 = nullptr;
            EpiDown E{(GAS bf16*)(F.ws + WS_U + U_YB), (const GAS unsigned*)(F.ws + WS_ELIST), (const GAS float*)(F.ws + WS_WLIST)};
            pg8::gemm_phase<EpiDown, SchedMoe<1>>(F.lds, S, E, F.tid);
            TAIL_WCONV(tab[16] * 4);
        }
        SEAM(pb + 10);
        }
    if (ON(13) && IN(PH_FINAL)) { FRESH(); ph_norm1(F, DEPTH); }
#if PROBE_STAMPS && MK_ONE_LAUNCH
    xcd_barrier(bar); STAMP(PH_FINAL + 1);
    if (F.bid == 0 && F.tid == 0) {
        const GAS unsigned long long* st = (const GAS unsigned long long*)(F.ctl + 80000);
        const int sel = SEL1; unsigned long long t = 0;
        if (sel < 11) { for (int l = 0; l < DEPTH; ++l) { const int k = PH_L0 + PH_PER_LAYER * l + sel; t += st[k + 1] - st[k]; } }
        else if (sel == 100) t = st[2] - st[0]; else if (sel >= 200) t = st[100 + (sel - 200)]; else t = st[PH_FINAL + 1] - st[PH_FINAL];
        const unsigned long long t0 = __builtin_amdgcn_s_memrealtime();
        while (__builtin_amdgcn_s_memrealtime() - t0 < 8ull * t) __builtin_amdgcn_s_sleep(8);
    }
#endif
}

extern "C" void kernel_launch(void* const* d_in, const int* in_sizes, int n_in, void* d_out, int out_size, void* d_ws, size_t ws_size, hipStream_t stream) {
    static int grid = 0;
    if (grid == 0) {
        if (n_in != 38 || out_size != NLAT * D || ws_size < WS_END) { fprintf(stderr, "kernel_launch: unexpected shapes: n_in %d out %d ws %zu (need %zu)\n", n_in, out_size, ws_size, (size_t)WS_END); grid = -1; return; }
        int dev = 0, cus = 0, per_cu = 0;
        if (hipGetDevice(&dev) != hipSuccess || hipDeviceGetAttribute(&cus, hipDeviceAttributeMultiprocessorCount, dev) != hipSuccess) { grid = -1; return; }
        if (hipFuncSetAttribute((const void*)fwd_kernel, hipFuncAttributeMaxDynamicSharedMemorySize, LDS_BYTES) != hipSuccess) { fprintf(stderr, "kernel_launch: hipFuncSetAttribute failed\n"); grid = -1; return; }
        if (hipOccupancyMaxActiveBlocksPerMultiprocessor(&per_cu, (const void*)fwd_kernel, 512, LDS_BYTES) != hipSuccess || per_cu < 1) fprintf(stderr, "kernel_launch: occupancy query reports %d per CU\n", per_cu);
        grid = cus > 0 ? cus : 256;
    }
    if (grid < 0) return;
    (void)in_sizes;
    hipMemsetAsync((char*)d_ws + WS_CTL, 0, CTL_BYTES, stream);
    Params p{};
    for (int i = 0; i < 38; ++i) p.in[i] = (const GAS float*)d_in[i];
    p.out = (GAS float*)d_out; p.ws = (GAS unsigned char*)d_ws;
#if MK_ONE_LAUNCH
    p.ph_lo = 0; p.ph_hi = NPH;
    hipLaunchKernelGGL(fwd_kernel, dim3(grid), dim3(512), LDS_BYTES, stream, p);
#else
    for (int k = 0; k < NPH; ++k) { p.ph_lo = k; p.ph_hi = k + 1; hipLaunchKernelGGL(fwd_kernel, dim3(grid), dim3(512), LDS_BYTES, stream, p); }
#endif
}
```

```cpp
#include <hip/hip_runtime.h>
#include <stdio.h>
#include <stdint.h>

#ifndef PROBE_STAMPS
#define PROBE_STAMPS 0
#endif
#ifndef MK_ONE_LAUNCH
#define MK_ONE_LAUNCH 1
#endif

#define GAS __attribute__((address_space(1)))
#define LAS __attribute__((address_space(3)))
typedef unsigned short bf16;
typedef short bf16x8 __attribute__((ext_vector_type(8)));
typedef float f32x2 __attribute__((ext_vector_type(2)));
typedef float f32x4 __attribute__((ext_vector_type(4)));
typedef float f32x16 __attribute__((ext_vector_type(16)));
typedef unsigned u32x2 __attribute__((ext_vector_type(2)));
typedef unsigned u32x4 __attribute__((ext_vector_type(4)));

constexpr int D = 1024, NB = 8, SEQ = 4096, CTXL = 256, DEPTH = 4;
constexpr int NCTX = NB * CTXL, NLAT = NB * SEQ, NTOK = NCTX + NLAT;
constexpr int INW = 1792, HY_END = 768, Q_END = 1280, K_END = 1408, V_END = 1536;
constexpr int NEXP = 16, ECAP = NTOK;
constexpr int XG_ROWS = 2 * NTOK + NEXP * 256;
constexpr float EPS = 1e-6f;
constexpr int NCH = 136;

constexpr size_t MiB = 1u << 20;
constexpr size_t WS_CTL = 0, CTL_BYTES = 1 * MiB;
constexpr size_t WS_WIN = 1 * MiB, WS_WOUT = 15 * MiB, WS_WMOE = 23 * MiB, WS_MOD = 119 * MiB, WS_TG = 120 * MiB, WS_TGC = 152 * MiB, WS_S5T = 154 * MiB;
constexpr size_t WS_XS = 156 * MiB, WS_H = 292 * MiB, WS_LOC = 360 * MiB, WS_SPREV = 377 * MiB, WS_S5Y = 394 * MiB, WS_ELIST = 411 * MiB, WS_WLIST = 414 * MiB, WS_HYC = 417 * MiB;
constexpr size_t WS_U = 418 * MiB;
constexpr size_t U_XG = 0, U_ACT = 144 * MiB, U_YB = 288 * MiB;
constexpr size_t U_DELTA = 0;
constexpr size_t U_P = 0, U_QR = 119 * MiB, U_KR = 153 * MiB, U_HV = 162 * MiB, U_HX1 = 178 * MiB, U_HX2 = 194 * MiB, U_Z1T = 210 * MiB, U_HYT = 226 * MiB, U_ATT = 242 * MiB, U_MIXN = 276 * MiB;
constexpr size_t U_RAWL = 0, U_RAWC = 64 * MiB, U_PART = 68 * MiB;
constexpr size_t WS_WMOE2 = WS_U + 424 * MiB;
constexpr size_t WS_END = WS_WMOE2 + 96 * MiB;
__host__ __device__ constexpr size_t wmoe_off(int l) { return (l & 1) ? WS_WMOE2 : WS_WMOE; }
constexpr size_t S5_BBT = 0, S5_CMT = 512 * 1024, S5_AB = 1024 * 1024, S5_A32 = 1088 * 1024, S5_GLUT = 1152 * 1024, S5_ROPE = 1664 * 1024;
constexpr int CW_BAR = 4096, CW_WQ = 8192, CW_CNT = 16384, CW_NORM = 32768;

constexpr int LDS_BYTES = 163840;
constexpr int LDS_MISC = LDS_BYTES - 64;

__device__ __forceinline__ unsigned f2bf(float f) { unsigned u = __builtin_bit_cast(unsigned, f); return (u + 0x7fffu + ((u >> 16) & 1u)) >> 16; }
__device__ __forceinline__ unsigned pk2(float lo, float hi) { unsigned r; asm("v_cvt_pk_bf16_f32 %0, %1, %2" : "=v"(r) : "v"(lo), "v"(hi)); return r; }
__device__ __forceinline__ float bf2f(unsigned b) { return __builtin_bit_cast(float, b << 16); }
__device__ __forceinline__ float bflo(unsigned w) { return __builtin_bit_cast(float, w << 16); }
__device__ __forceinline__ float bfhi(unsigned w) { return __builtin_bit_cast(float, w & 0xffff0000u); }
struct U2 { unsigned x, y; };
__device__ __forceinline__ U2 swap32(float v) { const unsigned a = __builtin_bit_cast(unsigned, v); const auto r = __builtin_amdgcn_permlane32_swap(a, a, false, false); U2 o; o.x = r[0]; o.y = r[1]; return o; }
__device__ __forceinline__ U2 swap16(float v) { const unsigned a = __builtin_bit_cast(unsigned, v); const auto r = __builtin_amdgcn_permlane16_swap(a, a, false, false); U2 o; o.x = r[0]; o.y = r[1]; return o; }
__device__ __forceinline__ float lane_xor(float v, int lane, int o) {
    const int x = __builtin_bit_cast(int, v);
    if (o == 1) return __builtin_bit_cast(float, __builtin_amdgcn_update_dpp(0, x, 0xB1, 0xF, 0xF, true));
    if (o == 2) return __builtin_bit_cast(float, __builtin_amdgcn_update_dpp(0, x, 0x4E, 0xF, 0xF, true));
    if (o == 4) { const int t = __builtin_amdgcn_update_dpp(0, x, 0x141, 0xF, 0xF, true); return __builtin_bit_cast(float, __builtin_amdgcn_update_dpp(0, t, 0x1B, 0xF, 0xF, true)); }
    if (o == 8) return __builtin_bit_cast(float, __builtin_amdgcn_update_dpp(0, x, 0x128, 0xF, 0xF, true));
    if (o == 16) { const U2 r = swap16(v); return __builtin_bit_cast(float, (lane & 16) ? r.x : r.y); }
    { const U2 r = swap32(v); return __builtin_bit_cast(float, (lane & 32) ? r.x : r.y); }
}
__device__ __forceinline__ float pair32_max(float v) { const U2 r = swap32(v); return fmaxf(__builtin_bit_cast(float, r.x), __builtin_bit_cast(float, r.y)); }
__device__ __forceinline__ float pair32_sum(float v) { const U2 r = swap32(v); return __builtin_bit_cast(float, r.x) + __builtin_bit_cast(float, r.y); }
__device__ __forceinline__ float wave_sum(float v, int lane) {
    (void)lane;
    v += __builtin_bit_cast(float, __builtin_amdgcn_update_dpp(0, __builtin_bit_cast(int, v), 0xB1, 0xF, 0xF, true));
    v += __builtin_bit_cast(float, __builtin_amdgcn_update_dpp(0, __builtin_bit_cast(int, v), 0x4E, 0xF, 0xF, true));
    v += __builtin_bit_cast(float, __builtin_amdgcn_update_dpp(0, __builtin_bit_cast(int, v), 0x141, 0xF, 0xF, true));
    v += __builtin_bit_cast(float, __builtin_amdgcn_update_dpp(0, __builtin_bit_cast(int, v), 0x140, 0xF, 0xF, true));
    { const U2 r = swap16(v); v = __builtin_bit_cast(float, r.x) + __builtin_bit_cast(float, r.y); }
    return pair32_sum(v);
}
__device__ __forceinline__ f32x16 zero16() { f32x16 z;
#pragma unroll
    for (int r = 0; r < 16; ++r) z[r] = 0.f;
    asm volatile("" : "+v"(z)); return z; }
__device__ __forceinline__ f32x4 zero4() { f32x4 z = (f32x4){0.f, 0.f, 0.f, 0.f}; asm volatile("" : "+v"(z)); return z; }
#define LDS_BARRIER() do { asm volatile("s_waitcnt lgkmcnt(0)" ::: "memory"); __builtin_amdgcn_s_barrier(); asm volatile("" ::: "memory"); } while (0)
#define LDS_WAIT() asm volatile("s_waitcnt lgkmcnt(0)" ::: "memory")
#define VM_WAIT() asm volatile("s_waitcnt vmcnt(0)" ::: "memory")

#define XB_TMO      128
#define XB_XCNT(j)  (256  + 64 * (j))
#define XB_XSUB(j)  (1280 + 64 * (j))
#define XB_XGEN(j)  (2304 + 64 * (j))
#define XB_TOP      3328
#define XB_TOPGEN   3392
#define XCD_BAR_WORDS 3456
#define XB_SPIN_CAP (1u << 18)

__device__ __forceinline__ unsigned xb_ld(unsigned* p)              { return __hip_atomic_load(p, __ATOMIC_RELAXED, __HIP_MEMORY_SCOPE_AGENT); }
__device__ __forceinline__ unsigned xb_add(unsigned* p, unsigned v) { return __hip_atomic_fetch_add(p, v, __ATOMIC_RELAXED, __HIP_MEMORY_SCOPE_AGENT); }
__device__ __forceinline__ unsigned xb_xcc_id() { return (unsigned)__builtin_amdgcn_s_getreg((3 << 11) | 20) & 0xFu; }
#define XB_SPIN(cond, bar) do { unsigned _sp = 0; while (cond) { __builtin_amdgcn_s_sleep(1); \
    if ((++_sp & 255u) == 0u) { if (xb_ld(&(bar)[XB_TMO])) break; if (_sp > XB_SPIN_CAP) { atomicAdd(&(bar)[XB_TMO], 1u); break; } } } } while (0)

struct XcdBarrier {
    unsigned* bar; unsigned x;
    volatile LAS unsigned* st;
};

__device__ __forceinline__ XcdBarrier xcd_barrier_post(unsigned* bar, volatile LAS unsigned* st) {
    XcdBarrier b; b.bar = bar; b.x = xb_xcc_id(); b.st = st;
    if (threadIdx.x == 0) (void)xb_add(&bar[XB_XCNT(b.x)], 1u);
    return b;
}
__device__ __forceinline__ void xcd_barrier_complete(unsigned* bar, unsigned x, unsigned& nloc, unsigned& nx) {
    const unsigned G = gridDim.x * gridDim.y * gridDim.z;
    unsigned sum, cnt, mine, sp = 0u;
    for (;;) {
        sum = 0u; cnt = 0u; mine = 0u;
#pragma unroll
        for (unsigned j = 0; j < 16; ++j) { const unsigned c = xb_ld(&bar[XB_XCNT(j)]); sum += c; cnt += (c > 0u) ? 1u : 0u; mine = (j == x) ? c : mine; }
        if (sum == G) break;
        __builtin_amdgcn_s_sleep(1);
        if ((++sp & 255u) == 0u) { if (xb_ld(&bar[XB_TMO])) break; if (sp > XB_SPIN_CAP) { atomicAdd(&bar[XB_TMO], 1u); break; } }
    }
    nloc = mine > 0u ? mine : 1u; nx = cnt > 0u ? cnt : 1u;
}

__device__ __forceinline__ void xcd_barrier(const XcdBarrier& b) {
    asm volatile("s_waitcnt vmcnt(0)" ::: "memory");
    __syncthreads();
    if (threadIdx.x == 0) {
        unsigned* bar = b.bar;
        __builtin_amdgcn_s_waitcnt(0);
        unsigned nloc = b.st[0], nx = b.st[1];
        if (nloc == 0u) { xcd_barrier_complete(bar, b.x, nloc, nx); b.st[0] = nloc; b.st[1] = nx; }
        const unsigned old = xb_add(&bar[XB_XSUB(b.x)], 1u);
        const unsigned gen = old / nloc;
        if (old + 1u == (gen + 1u) * nloc) {
            __builtin_amdgcn_fence(__ATOMIC_RELEASE, "agent");
            asm volatile("s_waitcnt vmcnt(0)" ::: "memory");
            const unsigned og = xb_add(&bar[XB_TOP], 1u);
            const unsigned tg = og / nx;
            if (og + 1u == (tg + 1u) * nx) xb_add(&bar[XB_TOPGEN], 1u);
            else XB_SPIN(xb_ld(&bar[XB_TOPGEN]) == tg, bar);
            __builtin_amdgcn_fence(__ATOMIC_ACQUIRE, "agent");
            xb_add(&bar[XB_XGEN(b.x)], 1u);
            asm volatile("s_waitcnt vmcnt(0)" ::: "memory");
        } else {
            XB_SPIN(xb_ld(&bar[XB_XGEN(b.x)]) == gen, bar);
            __builtin_amdgcn_fence(__ATOMIC_ACQUIRE, "agent");
            asm volatile("s_waitcnt vmcnt(0)" ::: "memory");
        }
    }
    __syncthreads();
}

struct Params { const GAS float* in[38]; GAS float* out; GAS unsigned char* ws; int ph_lo, ph_hi; };
enum { I_X = 0, I_C, I_CTX, I_CCTX, I_N1G, I_N2G, I_ADAW, I_ADAB, I_WIN, I_WOUT, I_MIXG, I_HCW, I_HCB, I_HW1, I_HB1, I_HF1, I_HW2, I_HB2, I_HF2, I_HW3, I_HBIAS, I_SINK,
       I_LRE, I_LIM, I_LDT, I_BRE, I_BIM, I_CRE, I_CIM, I_S5D, I_GLUW, I_GLUB, I_RW, I_RB, I_WG, I_WU, I_WD, I_FG };

struct Frame {
    LAS unsigned char* lds;
    GAS unsigned* ctl;
    GAS unsigned char* ws;
    const GAS float* const* in;
    GAS float* out;
    int tid, lane, wave, G, bid, z;
};

#define LAUNDER(F) do { asm volatile("s_mov_b32 %0, 0" : "=s"((F).z)); asm volatile("" : "+s"((F).ws), "+s"((F).lds), "+v"((F).tid), "+v"((F).lane)); (F).ctl = (GAS unsigned*)((F).ws + WS_CTL); } while (0)
__device__ __forceinline__ int wq_next(Frame& F, int qid) {
    volatile LAS unsigned* m = (volatile LAS unsigned*)(F.lds + LDS_MISC);
    __syncthreads();
    if (F.tid == 0) m[4] = __hip_atomic_fetch_add(F.ctl + CW_WQ + 64 * qid, 1u, __ATOMIC_RELAXED, __HIP_MEMORY_SCOPE_AGENT);
    __syncthreads();
    return __builtin_amdgcn_readfirstlane((int)m[4]);
}
namespace pg8 {
#define PG8_LAS __attribute__((address_space(3)))
typedef unsigned short bf16_t;
constexpr int BM = 256, BK = 64, HALF = 128, HTB = HALF * BK * 2  , STAGE_BYTES = 8 * HTB, NXCD = 8, WGM = 8;
constexpr size_t ROWB = 2048;
constexpr int GATHER_TAB = 131072;

__host__ __device__ __forceinline__ int lds_byte(int r, int c) { const int st = (r >> 4) * 2 + (c >> 5), rr = r & 15, cc = c & 31, ob = rr * 64 + cc * 2; return st * 1024 + (ob ^ (((ob >> 9) & 1) << 5)); }
__host__ __device__ __forceinline__ void stage_rc(int b, int& R, int& C) { const int st = b / 1024, sb = b % 1024, swz = sb ^ (((sb >> 9) & 1) << 5); R = (st >> 1) * 16 + swz / 64; C = (st & 1) * 32 + (swz % 64) / 2; }
__host__ __device__ __forceinline__ int perm32(int rho) { const int n = rho >> 4, i = rho & 15; return 8 * (i >> 2) + 4 * n + (i & 3); }

struct Unit { const GAS char* A; const GAS char* B0; const GAS char* B1; int i0, i1, i2, i3; };

struct StaticOrder {
    int nM, nN, nwg, G, c;
    __device__ void init(int M, int N, int G_, int c_) { nM = M / BM; nN = N / BM; nwg = nM * nN; G = G_; c = c_; }
    __device__ bool next(int i, int& pm, int& pn) const {
        const long L = (long)i * G + c; if (L >= nwg) return false;
        int wgid = (int)L; { const int q = nwg / NXCD, r = nwg % NXCD, xcd = wgid % NXCD, off = wgid / NXCD; wgid = (xcd < r ? xcd * (q + 1) : r * (q + 1) + (xcd - r) * q) + off; }
        const int nig = WGM * nN, gid = wgid / nig, fm = gid * WGM, gsz = (nM - fm) < WGM ? (nM - fm) : WGM;
        pm = fm + ((wgid % nig) % gsz); pn = (wgid % nig) / gsz; return true;
    }
};
__device__ __forceinline__ unsigned cvt_pk_bf16(float lo, float hi) { unsigned r; asm volatile("v_cvt_pk_bf16_f32 %0, %1, %2" : "=v"(r) : "v"(lo), "v"(hi)); return r; }

typedef int i32x8 __attribute__((ext_vector_type(8)));
typedef int i32x4v __attribute__((ext_vector_type(4)));
__device__ __forceinline__ i32x8 cat8(bf16x8 lo, bf16x8 hi) { const i32x4v a = __builtin_bit_cast(i32x4v, lo), b = __builtin_bit_cast(i32x4v, hi); return __builtin_shufflevector(a, b, 0, 1, 2, 3, 4, 5, 6, 7); }
template <class Epi, class Sched>
__device__ __forceinline__ void gemm_phase(PG8_LAS unsigned char* lds, const Sched& S, const Epi& E, const int tid) {
    constexpr bool STAMP = false; unsigned long long* stamps = nullptr;
    const int wid = __builtin_amdgcn_readfirstlane(tid >> 6), lane = tid & 63, wr = wid >> 2, wc = wid & 3, fr = lane & 15, fq = lane >> 4;
    constexpr bool F8 = Sched::FP8;
    constexpr int KB = F8 ? 1024 : 2048  , nt = KB / 128;
    int ts_lo = 0, ts_hi = 0, nts = 0; const unsigned long long rt_entry = STAMP ? (unsigned long long)wall_clock64() : 0ull;
#define PG8_STAMP() do { if (STAMP && wid == 0 && nts < 64) { const unsigned long long _c = (unsigned long long)clock64(); \
        ts_lo = (lane == nts) ? (int)(unsigned)_c : ts_lo; ts_hi = (lane == nts) ? (int)(unsigned)(_c >> 32) : ts_hi; ++nts; } } while (0)
    PG8_STAMP();
    unsigned voffA[2], voffB[2];
#pragma unroll
    for (int i = 0; i < 2; ++i) { int R, C; stage_rc(tid * 16 + i * 8192, R, C); const int Rb = Epi::PERM ? ((R & ~31) + perm32(R & 31)) : R;
        voffA[i] = (unsigned)(R * KB + C * 2); voffB[i] = (unsigned)(Rb * KB + C * 2); }
    int gR[2], gC[2];
#pragma unroll
    for (int i = 0; i < 2; ++i) { int R, C; stage_rc(tid * 16 + i * 8192, R, C); gR[i] = R; gC[i] = C * 2; }
    unsigned vA[2][2], vN[2][2];
#define PG8_GLOAD(dst, k) do { const PG8_LAS unsigned* t_ = (const PG8_LAS unsigned*)(lds + GATHER_TAB + 1024 * (k)); _Pragma("unroll") for (int h_ = 0; h_ < 2; ++h_) _Pragma("unroll") for (int i_ = 0; i_ < 2; ++i_) dst[h_][i_] = t_[h_ * 128 + gR[i_]] + (unsigned)gC[i_]; } while (0)
#define PG8_APTR(base, half) ((base) + (Sched::GATHER ? (size_t)0 : (size_t)(half) * hstep))
#pragma unroll
    for (int h = 0; h < 2; ++h)
#pragma unroll
        for (int i = 0; i < 2; ++i) { vA[h][i] = voffA[i]; vN[h][i] = voffA[i]; }
    const size_t kstep = (size_t)(BK * 2);
    const size_t hstep = (size_t)HALF * KB;
    const unsigned ldsw = (unsigned)wid * 1024u;
    const int aoff = F8 ? lds_byte(wr * 64 + fr, fq * 16) : lds_byte(wr * 64 + fr, fq * 8), boff = F8 ? lds_byte(wc * 32 + fr, fq * 16) : lds_byte(wc * 32 + fr, fq * 8);

#define PG8_SA(b, h) (((b) * 2 + (h)) * HTB)
#define PG8_SB(b, h) ((4 + (b) * 2 + (h)) * HTB)
#define PG8_STAGE(bufoff, gbase, voff) do { _Pragma("unroll") for (int _i = 0; _i < 2; ++_i) \
        __builtin_amdgcn_global_load_lds((const GAS unsigned*)((gbase) + (voff)[_i]), (PG8_LAS unsigned*)(lds + (bufoff) + ldsw + _i * 8192), 16, 0, 0); } while (0)
#define PG8_LDA(dst, b, h) do { _Pragma("unroll") for (int m = 0; m < 4; ++m) { if constexpr (F8) dst##8[m] = cat8(*(const PG8_LAS bf16x8*)(lds + PG8_SA(b, h) + aoff + m * 2048), *(const PG8_LAS bf16x8*)(lds + PG8_SA(b, h) + aoff + m * 2048 + 16)); \
        else { _Pragma("unroll") for (int k = 0; k < 2; ++k) dst[m][k] = *(const PG8_LAS bf16x8*)(lds + PG8_SA(b, h) + aoff + m * 2048 + k * 1024); } } } while (0)
#define PG8_LDB(dst, b, h) do { _Pragma("unroll") for (int n = 0; n < 2; ++n) { if constexpr (F8) dst##8[n] = cat8(*(const PG8_LAS bf16x8*)(lds + PG8_SB(b, h) + boff + n * 2048), *(const PG8_LAS bf16x8*)(lds + PG8_SB(b, h) + boff + n * 2048 + 16)); \
        else { _Pragma("unroll") for (int k = 0; k < 2; ++k) dst[n][k] = *(const PG8_LAS bf16x8*)(lds + PG8_SB(b, h) + boff + n * 2048 + k * 1024); } } } while (0)
#define PG8_MMA(ai, bj, At, Bt) do { __builtin_amdgcn_s_setprio(1); _Pragma("unroll") for (int m = 0; m < 4; ++m) _Pragma("unroll") for (int n = 0; n < 2; ++n) { \
        if constexpr (F8) asm volatile("v_mfma_scale_f32_16x16x128_f8f6f4 %0, %1, %2, %0, %3, %3 op_sel_hi:[0,0,0]" : "+v"(acc[ai][bj][m][n]) : "v"(Bt##8[n]), "v"(At##8[m]), "v"(sc1));   \
        else { _Pragma("unroll") for (int k = 0; k < 2; ++k) acc[ai][bj][m][n] = __builtin_amdgcn_mfma_f32_16x16x32_bf16(Bt[n][k], At[m][k], acc[ai][bj][m][n], 0, 0, 0); } } __builtin_amdgcn_s_setprio(0); } while (0)
#define PG8_WAIT_V(n) asm volatile("s_waitcnt vmcnt(" #n ")" ::: "memory")
#define PG8_WAIT_L(n) asm volatile("s_waitcnt lgkmcnt(" #n ")" ::: "memory")
#define PG8_BAR __builtin_amdgcn_s_barrier()
#define PG8_SCHED __builtin_amdgcn_sched_barrier(0)
    Unit cur, nxt; int ui = 0;
    if (!S.next(0, cur)) return;
    f32x4 acc[2][2][4][2];
#pragma unroll
    for (int a = 0; a < 2; ++a)
#pragma unroll
        for (int b = 0; b < 2; ++b)
#pragma unroll
            for (int m = 0; m < 4; ++m)
#pragma unroll
                for (int n = 0; n < 2; ++n) acc[a][b][m][n] = (f32x4){0.f, 0.f, 0.f, 0.f};
    const int sc1 = 0x7F7F7F7F;
    bf16x8 At[4][2], B0[2][2], B1[2][2]; i32x8 At8[4], B08[2], B18[2];
    const GAS char* cA = cur.A; const GAS char* cB0 = cur.B0; const GAS char* cB1 = cur.B1;
    S.a_ready(cur);
    if (Sched::GATHER) { PG8_GLOAD(vA, 0); }
    PG8_STAGE(PG8_SB(0, 0), cB0, voffB); PG8_STAGE(PG8_SA(0, 0), PG8_APTR(cA, 0), vA[0]); PG8_STAGE(PG8_SB(0, 1), cB1, voffB); PG8_STAGE(PG8_SA(0, 1), PG8_APTR(cA, 1), vA[1]);
    if (wr == 1) PG8_BAR;
    PG8_WAIT_V(4); PG8_BAR;
    PG8_STAGE(PG8_SB(1, 0), cB0 + kstep, voffB); PG8_STAGE(PG8_SA(1, 0), PG8_APTR(cA + kstep, 0), vA[0]); PG8_STAGE(PG8_SB(1, 1), cB1 + kstep, voffB);
    PG8_WAIT_V(6); PG8_BAR;
    PG8_STAMP();
    for (;;) {
        const bool has_next = S.next(ui + 1, nxt);
        if (Sched::GATHER && has_next) { PG8_GLOAD(vN, ui + 1); }
        const GAS char* nA = has_next ? nxt.A : cA; const GAS char* nB0 = has_next ? nxt.B0 : cB0; const GAS char* nB1 = has_next ? nxt.B1 : cB1;
#pragma unroll 1
        for (int t = 0; t < nt; t += 2) {
            const bool last = (t == nt - 2);
            const GAS char* a1 = cA + (size_t)(t + 1) * kstep;
            const GAS char* a2 = last ? nA : cA + (size_t)(t + 2) * kstep; const GAS char* b2 = last ? nB0 : cB0 + (size_t)(t + 2) * kstep; const GAS char* c2 = last ? nB1 : cB1 + (size_t)(t + 2) * kstep;
            const GAS char* a3 = a2 + kstep; const GAS char* b3 = b2 + kstep; const GAS char* c3 = c2 + kstep;
            if (last && has_next) S.a_ready(nxt);
            unsigned vS[2][2];
#pragma unroll
            for (int h = 0; h < 2; ++h)
#pragma unroll
                for (int i = 0; i < 2; ++i) vS[h][i] = (Sched::GATHER && last && has_next) ? vN[h][i] : vA[h][i];
            PG8_LDB(B0, 0, 0); PG8_SCHED; PG8_LDA(At, 0, 0); PG8_STAGE(PG8_SA(1, 1), PG8_APTR(a1, 1), vA[1]);
            PG8_WAIT_L(8); PG8_BAR; PG8_WAIT_L(0); PG8_MMA(0, 0, At, B0); PG8_BAR; PG8_SCHED;
            PG8_LDB(B1, 0, 1); PG8_STAGE(PG8_SB(0, 0), b2, voffB);
            PG8_BAR; PG8_WAIT_L(0); PG8_MMA(0, 1, At, B1); PG8_BAR;
            PG8_LDA(At, 0, 1); PG8_STAGE(PG8_SA(0, 0), PG8_APTR(a2, 0), vS[0]);
            PG8_BAR; PG8_WAIT_L(0); PG8_MMA(1, 0, At, B0); PG8_BAR; PG8_SCHED;
            PG8_STAGE(PG8_SB(0, 1), c2, voffB);
            PG8_WAIT_V(6); PG8_BAR; PG8_MMA(1, 1, At, B1); PG8_BAR;
            PG8_LDB(B0, 1, 0); PG8_SCHED; PG8_LDA(At, 1, 0); PG8_STAGE(PG8_SA(0, 1), PG8_APTR(a2, 1), vS[1]);
            PG8_WAIT_L(8); PG8_BAR; PG8_WAIT_L(0); PG8_MMA(0, 0, At, B0); PG8_BAR; PG8_SCHED;
            PG8_LDB(B1, 1, 1); PG8_STAGE(PG8_SB(1, 0), b3, voffB);
            PG8_BAR; PG8_WAIT_L(0); PG8_MMA(0, 1, At, B1); PG8_BAR;
            PG8_LDA(At, 1, 1); PG8_STAGE(PG8_SA(1, 0), PG8_APTR(a3, 0), vS[0]);
            PG8_BAR; PG8_WAIT_L(0); PG8_MMA(1, 0, At, B0); PG8_BAR; PG8_SCHED;
            PG8_STAGE(PG8_SB(1, 1), c3, voffB);
            PG8_WAIT_V(6); PG8_BAR; PG8_MMA(1, 1, At, B1); PG8_BAR;
        }
        PG8_STAMP();
        if constexpr (F8) asm volatile("s_nop 15\n\ts_nop 7" ::: "memory");
        if constexpr (!Epi::AFTER_DRAIN) { E(acc, cur, wr, wc, fr, fq); S.done(cur); }
        PG8_STAMP();
        if (!has_next) break;
#pragma unroll
        for (int a = 0; a < 2; ++a)
#pragma unroll
            for (int b = 0; b < 2; ++b)
#pragma unroll
                for (int m = 0; m < 4; ++m)
#pragma unroll
                    for (int n = 0; n < 2; ++n) acc[a][b][m][n] = (f32x4){0.f, 0.f, 0.f, 0.f};
        cur = nxt; cA = nA; cB0 = nB0; cB1 = nB1; ++ui;
#pragma unroll
        for (int h = 0; h < 2; ++h)
#pragma unroll
            for (int i = 0; i < 2; ++i) vA[h][i] = vN[h][i];
    }
    PG8_WAIT_V(0);
    if (wr == 0) PG8_BAR;
    PG8_BAR;
    if constexpr (Epi::AFTER_DRAIN) { E.fused(acc, cur, wr, wc, fr, fq, lds, wid, lane); S.done(cur); }
    PG8_STAMP();
    if (STAMP && wid == 0) { stamps[lane] = lane < nts ? (((unsigned long long)(unsigned)ts_hi << 32) | (unsigned)ts_lo) : 0ull;
        if (lane == 62) stamps[62] = rt_entry; if (lane == 63) stamps[63] = (unsigned long long)wall_clock64(); }
#undef PG8_STAMP
#undef PG8_SA
#undef PG8_SB
#undef PG8_STAGE
#undef PG8_GLOAD
#undef PG8_APTR
#undef PG8_LDA
#undef PG8_LDB
#undef PG8_MMA
#undef PG8_WAIT_V
#undef PG8_WAIT_L
#undef PG8_BAR
#undef PG8_SCHED
}
}

struct SchedStd {
    static constexpr bool GATHER = false, FP8 = false;
    pg8::StaticOrder so; const GAS char* A; const GAS char* Bt; int row_off;
    __device__ __forceinline__ bool next(int i, pg8::Unit& u) const {
        int pm, pn; if (!so.next(i, pm, pn)) return false;
        u.A = A + (size_t)(pm * 256 + row_off) * pg8::ROWB; u.B0 = Bt + (size_t)pn * 256 * pg8::ROWB; u.B1 = u.B0 + 128 * pg8::ROWB; u.i0 = pm * 256 + row_off; u.i1 = pn * 256; u.i2 = 0; u.i3 = 0; return true;
    }
    __device__ __forceinline__ void a_ready(const pg8::Unit&) const {}
    __device__ __forceinline__ void done(const pg8::Unit&) const {}
};
struct SchedStd8 {
    static constexpr bool GATHER = false, FP8 = true;
    pg8::StaticOrder so; const GAS char* A; const GAS char* Bt; int row_off;
    __device__ __forceinline__ bool next(int i, pg8::Unit& u) const {
        int pm, pn; if (!so.next(i, pm, pn)) return false;
        u.A = A + (size_t)(pm * 256 + row_off) * 1024; u.B0 = Bt + (size_t)pn * 256 * 1024; u.B1 = u.B0 + 128 * 1024; u.i0 = pm * 256 + row_off; u.i1 = pn * 256; u.i2 = 0; u.i3 = 0; return true;
    }
    __device__ __forceinline__ void a_ready(const pg8::Unit&) const {}
    __device__ __forceinline__ void done(const pg8::Unit&) const {}
};
template <int DOWN> struct SchedMoe {
    static constexpr bool GATHER = (DOWN == 0);
    static constexpr bool FP8 = true;
    static constexpr size_t RB = 1024;
    const volatile LAS int* tab; int G, c; const GAS char* A; const GAS char* W0; const GAS char* W1;
    __device__ __forceinline__ bool next(int i, pg8::Unit& u) const {
        constexpr int NT = DOWN ? 4 : 8;
        const int L = i * G + c, total = __builtin_amdgcn_readfirstlane(tab[16]) * NT; if (L >= total) return false;
        const int nt = L % NT, mg = L / NT; int e = 0;
        for (int k = 1; k < 16; ++k) e += (mg >= __builtin_amdgcn_readfirstlane(tab[k])) ? 1 : 0;
        const int mt = mg - __builtin_amdgcn_readfirstlane(tab[e]);
        u.A = GATHER ? A : A + (size_t)mg * 256 * RB;
        if (DOWN) { u.B0 = W0 + ((size_t)e * 1024 + 256 * nt) * RB; u.B1 = u.B0 + 128 * RB; u.i0 = e * ECAP + 256 * mt; u.i1 = 256 * nt; u.i2 = __builtin_amdgcn_readfirstlane(tab[32 + e]) - 256 * mt; u.i3 = 0; }
        else      { u.B0 = W0 + ((size_t)e * 1024 + 128 * nt) * RB; u.B1 = W1 + ((size_t)e * 1024 + 128 * nt) * RB; u.i0 = 256 * mg; u.i1 = 128 * nt; u.i2 = 0; u.i3 = 0; }
        return true;
    }
    __device__ __forceinline__ void a_ready(const pg8::Unit&) const {}
    __device__ __forceinline__ void done(const pg8::Unit&) const {}
};
struct EpiP {
    static constexpr bool PERM = true, AFTER_DRAIN = false;
    GAS bf16* O; int ldc;
    __device__ __forceinline__ void operator()(const f32x4 (&acc)[2][2][4][2], const pg8::Unit& u, int wr, int wc, int fr, int fq) const {
        const int row0 = u.i0 + wr * 64 + fr, col0 = u.i1 + wc * 32 + 8 * fq;
#pragma unroll
        for (int ai = 0; ai < 2; ++ai)
#pragma unroll
            for (int m = 0; m < 4; ++m) { GAS bf16* rowp = O + (size_t)(row0 + ai * 128 + m * 16) * ldc + col0;
#pragma unroll
                for (int bj = 0; bj < 2; ++bj) { const f32x4 v0 = acc[ai][bj][m][0], v1 = acc[ai][bj][m][1];
                    u32x4 w; w.x = pg8::cvt_pk_bf16(v0[0], v0[1]); w.y = pg8::cvt_pk_bf16(v0[2], v0[3]); w.z = pg8::cvt_pk_bf16(v1[0], v1[1]); w.w = pg8::cvt_pk_bf16(v1[2], v1[3]);
                    *(GAS u32x4*)(rowp + bj * 128) = w; }
                asm volatile("" ::: "memory"); }
    }
};
constexpr float W8_SCALE = 64.0f, W8_INV = 1.0f / 64.0f;
struct EpiOut {
    static constexpr bool PERM = true, AFTER_DRAIN = false;
    GAS bf16* O; const GAS float* mod_l;
    __device__ __forceinline__ void operator()(const f32x4 (&acc)[2][2][4][2], const pg8::Unit& u, int wr, int wc, int fr, int fq) const {
        const int row0 = u.i0 + wr * 64 + fr, col0 = u.i1 + wc * 32 + 8 * fq;
        const int bidx = u.i0 < NCTX ? 8 : (u.i0 - NCTX) / SEQ;
        const GAS float* g1 = mod_l + bidx * 6144 + 2 * 1024 + col0;
        f32x4 gv[2][2];
#pragma unroll
        for (int bj = 0; bj < 2; ++bj)
#pragma unroll
            for (int n = 0; n < 2; ++n) gv[bj][n] = *(const GAS f32x4*)(g1 + bj * 128 + 4 * n) * W8_INV;
#pragma unroll
        for (int ai = 0; ai < 2; ++ai)
#pragma unroll
            for (int m = 0; m < 4; ++m) { GAS bf16* rowp = O + (size_t)(row0 + ai * 128 + m * 16) * D + col0;
#pragma unroll
                for (int bj = 0; bj < 2; ++bj) { const f32x4 v0 = acc[ai][bj][m][0] * gv[bj][0], v1 = acc[ai][bj][m][1] * gv[bj][1];
                    u32x4 w; w.x = pg8::cvt_pk_bf16(v0[0], v0[1]); w.y = pg8::cvt_pk_bf16(v0[2], v0[3]); w.z = pg8::cvt_pk_bf16(v1[0], v1[1]); w.w = pg8::cvt_pk_bf16(v1[2], v1[3]);
                    *(GAS u32x4*)(rowp + bj * 128) = w; }
                asm volatile("" ::: "memory"); }
    }
};
__device__ __forceinline__ float silu_mul(float g, float u) { return g * u * __builtin_amdgcn_rcpf(1.0f + __expf(-g)); }
__device__ __forceinline__ unsigned pk4_fp8(float a, float b, float c, float d) { int r = 0; r = __builtin_amdgcn_cvt_pk_fp8_f32(a, b, r, false); r = __builtin_amdgcn_cvt_pk_fp8_f32(c, d, r, true); return (unsigned)r; }
__device__ __forceinline__ f32x4 silu_mul4(f32x4 g, f32x4 u) {
    const f32x4 ea = g * (-1.4426950408889634f * W8_INV);
    f32x4 e;
#pragma unroll
    for (int i = 0; i < 4; ++i) e[i] = __builtin_amdgcn_exp2f(ea[i]);
    const f32x4 d = e + 1.0f;
    f32x4 r;
#pragma unroll
    for (int i = 0; i < 4; ++i) r[i] = __builtin_amdgcn_rcpf(d[i]);
    return (g * u) * (r * (W8_INV * W8_INV));
}
struct EpiUp {
    static constexpr bool PERM = true, AFTER_DRAIN = false;
    GAS unsigned char* ACT;
    __device__ __forceinline__ void operator()(const f32x4 (&acc)[2][2][4][2], const pg8::Unit& u, int wr, int wc, int fr, int fq) const {
        const int row0 = u.i0 + wr * 64 + fr, col0 = u.i1 + wc * 32 + 8 * fq;
#pragma unroll
        for (int ai = 0; ai < 2; ++ai)
#pragma unroll
            for (int m = 0; m < 4; ++m) { GAS unsigned char* rowp = ACT + (size_t)(row0 + ai * 128 + m * 16) * 1024 + col0;
                const f32x4 s0 = silu_mul4(acc[ai][0][m][0], acc[ai][1][m][0]), s1 = silu_mul4(acc[ai][0][m][1], acc[ai][1][m][1]);
                u32x2 w; w.x = pk4_fp8(s0[0], s0[1], s0[2], s0[3]); w.y = pk4_fp8(s1[0], s1[1], s1[2], s1[3]);
                *(GAS u32x2*)rowp = w; asm volatile("" ::: "memory"); }
    }
};
struct EpiDown {
    static constexpr bool PERM = true, AFTER_DRAIN = false;
    GAS bf16* YB; const GAS unsigned* elist; const GAS float* wlist;
    __device__ __forceinline__ void operator()(const f32x4 (&acc)[2][2][4][2], const pg8::Unit& u, int wr, int wc, int fr, int fq) const {
        const int rl0 = wr * 64 + fr, col0 = u.i1 + wc * 32 + 8 * fq;
        unsigned ent[2][4]; float wv[2][4];
#pragma unroll
        for (int ai = 0; ai < 2; ++ai)
#pragma unroll
            for (int m = 0; m < 4; ++m) { const int rl = rl0 + ai * 128 + m * 16, idx = u.i0 + (rl < u.i2 ? rl : 0); ent[ai][m] = elist[idx]; wv[ai][m] = wlist[idx]; }
        asm volatile("" ::: "memory");
#pragma unroll
        for (int ai = 0; ai < 2; ++ai)
#pragma unroll
            for (int m = 0; m < 4; ++m) { const int rl = rl0 + ai * 128 + m * 16;
                if (rl < u.i2) { const float w = wv[ai][m] * W8_INV; GAS bf16* rowp = YB + (size_t)ent[ai][m] * D + col0;
#pragma unroll
                    for (int bj = 0; bj < 2; ++bj) { const f32x4 v0 = acc[ai][bj][m][0] * w, v1 = acc[ai][bj][m][1] * w;
                        u32x4 o; o.x = pg8::cvt_pk_bf16(v0[0], v0[1]); o.y = pg8::cvt_pk_bf16(v0[2], v0[3]); o.z = pg8::cvt_pk_bf16(v1[0], v1[1]); o.w = pg8::cvt_pk_bf16(v1[2], v1[3]);
                        *(GAS u32x4*)(rowp + bj * 128) = o; } }
                asm volatile("" ::: "memory"); }
    }
};

__device__ __forceinline__ void transpose_item(const GAS float* W, int K, int N, GAS bf16* WT, LAS float* scr, int item, int lane) {
    const int nblk = N / 32, kb = item / nblk, nb = item % nblk, k0 = 64 * kb, n0 = 32 * nb;
    float wv[32];
#pragma unroll
    for (int i = 0; i < 32; ++i) wv[i] = W[(size_t)(k0 + 2 * i + (lane >> 5)) * N + n0 + (lane & 31)];
#pragma unroll
    for (int i = 0; i < 32; ++i) scr[(2 * i + (lane >> 5)) * 33 + (lane & 31)] = wv[i];
    LDS_WAIT(); asm volatile("" ::: "memory");
    const int c = lane & 7;
#pragma unroll
    for (int j = 0; j < 4; ++j) { const int n = (lane >> 3) + 8 * j; const LAS float* s = scr + (8 * c) * 33 + n;
        u32x4 o; o.x = pk2(s[0 * 33], s[1 * 33]); o.y = pk2(s[2 * 33], s[3 * 33]); o.z = pk2(s[4 * 33], s[5 * 33]); o.w = pk2(s[6 * 33], s[7 * 33]);
        *(GAS u32x4*)(WT + (size_t)(n0 + n) * K + k0 + 8 * c) = o; }
    LDS_WAIT(); asm volatile("" ::: "memory");
}

__device__ __forceinline__ void unit_mod(Frame& F, int u) {
    LAUNDER(F);
    const int l = u / 96, cb = u % 96, n0 = cb * 64;
    LAS float* sc = (LAS float*)F.lds;
    LAS float* red = sc + 9 * 1024;
    const GAS float* c = F.in[I_C + F.z]; const GAS float* cc = F.in[I_CCTX + F.z];
    for (int i = F.tid; i < 9 * 1024; i += 512) { const int r = i >> 10, k = i & 1023; const float v = r < 8 ? c[r * 1024 + k] : cc[k]; sc[i] = v / (1.0f + expf(-v)); }
    __syncthreads();
    const int col = F.tid & 63, ks = F.tid >> 6;
    float acc[9];
#pragma unroll
    for (int r = 0; r < 9; ++r) acc[r] = 0.f;
    const GAS float* w = F.in[I_ADAW + F.z] + ((size_t)l * 1024 + ks * 128) * 6144 + n0 + col;
#pragma unroll 1
    for (int k0 = 0; k0 < 128; k0 += 16) { float wv[16];
#pragma unroll
        for (int k = 0; k < 16; ++k) wv[k] = w[(size_t)(k0 + k) * 6144];
#pragma unroll
        for (int k = 0; k < 16; ++k)
#pragma unroll
            for (int r = 0; r < 9; ++r) acc[r] += sc[r * 1024 + ks * 128 + k0 + k] * wv[k]; }
#pragma unroll
    for (int r = 0; r < 9; ++r) red[(ks * 9 + r) * 64 + col] = acc[r];
    __syncthreads();
    GAS float* MOD = (GAS float*)(F.ws + WS_MOD);
    for (int i = F.tid; i < 9 * 64; i += 512) { const int r = i >> 6, cl = i & 63; float s = 0.f;
#pragma unroll
        for (int k = 0; k < 8; ++k) s += red[(k * 9 + r) * 64 + cl];
        MOD[((size_t)l * 9 + r) * 6144 + n0 + cl] = s + F.in[I_ADAB + F.z][l * 6144 + n0 + cl]; }
    __syncthreads();
}

__device__ __forceinline__ void unit_taps1(Frame& F, int u) {
    LAUNDER(F);
    const int l = u / 272, r = u % 272; const int Lsel = r >= 256 ? 1 : 0, blk = Lsel ? r - 256 : r, L = Lsel ? 256 : 4096, pos0 = blk * 16;
    LAS float* feats = (LAS float*)F.lds;
    LAS float* h1 = feats + 16 * 36;
    LAS float* h2 = h1 + 16 * 64;
    const float invLm1 = 1.0f / (float)(L - 1);
    for (int i = F.tid; i < 16 * 33; i += 512) { const int p = i / 33, f = i % 33; const float pos = (float)(pos0 + p); float v;
        if (f == 0) v = pos * invLm1;
        else { const int bi = (f - 1) & 15; const float band = 1e-4f + (float)bi * ((15.0f - 1e-4f) / 15.0f); const float ang = (float)(2.0 * 3.14159265358979323846 / (double)L) * pos * band;
            v = f <= 16 ? cosf(ang) : -sinf(ang); }
        feats[p * 36 + f] = v; }
    __syncthreads();
    for (int i = F.tid; i < 16 * 64; i += 512) { const int p = i >> 6, j = i & 63; float s = F.in[I_HB1 + F.z][l * 64 + j]; const GAS float* w1 = F.in[I_HW1 + F.z] + (size_t)l * 33 * 64 + j;
        for (int f = 0; f < 33; ++f) s += feats[p * 36 + f] * w1[f * 64];
        h1[p * 64 + j] = sinf(F.in[I_HF1 + F.z][l * 64 + j] * s); }
    __syncthreads();
    for (int i = F.tid; i < 16 * 64; i += 512) { const int p = i >> 6, j = i & 63; float s = F.in[I_HB2 + F.z][l * 64 + j]; const GAS float* w2 = F.in[I_HW2 + F.z] + (size_t)l * 64 * 64 + j;
        for (int k = 0; k < 64; ++k) s += h1[p * 64 + k] * w2[k * 64];
        h2[p * 64 + j] = sinf(F.in[I_HF2 + F.z][l * 64 + j] * s); }
    __syncthreads();
    float acc[2][16];
#pragma unroll
    for (int c = 0; c < 2; ++c)
#pragma unroll
        for (int p = 0; p < 16; ++p) acc[c][p] = 0.f;
    const GAS float* w3 = F.in[I_HW3 + F.z] + (size_t)l * 64 * 1024 + F.tid;
#pragma unroll 1
    for (int k0 = 0; k0 < 64; k0 += 8) { float wa[8], wb[8];
#pragma unroll
        for (int k = 0; k < 8; ++k) { wa[k] = w3[(k0 + k) * 1024]; wb[k] = w3[(k0 + k) * 1024 + 512]; }
#pragma unroll
        for (int k = 0; k < 8; ++k)
#pragma unroll
            for (int p = 0; p < 16; ++p) { const float hv = h2[p * 64 + k0 + k]; acc[0][p] += hv * wa[k]; acc[1][p] += hv * wb[k]; } }
    GAS float* RAW = (GAS float*)(F.ws + WS_U + (Lsel ? U_RAWC + (size_t)l * 256 * 1024 * 4 : U_RAWL + (size_t)l * 4096 * 1024 * 4));
    GAS float* PART = (GAS float*)(F.ws + WS_U + U_PART) + (size_t)(l * 2 + Lsel) * 256 * 1024;
#pragma unroll
    for (int c = 0; c < 2; ++c) { const int col = F.tid + 512 * c, order = col >> 9, dir = (col >> 8) & 1, ch = col & 255;
        const float decay = fabsf(-3.0701134573253944f + (float)ch * ((-15.350567286626973f + 3.0701134573253944f) / 255.0f)); float asum = 0.f;
#pragma unroll
        for (int p = 0; p < 16; ++p) { const int pos = pos0 + p; const float t = (float)pos * invLm1; const float v = acc[c][p] * expf(-t * decay);
            RAW[(size_t)pos * 1024 + col] = v; if (!(dir == 1 && pos == 0)) asum += fabsf(v); }
        PART[(size_t)blk * 1024 + col] = asum; }
    __syncthreads();
}

__device__ __forceinline__ void unit_taps2(Frame& F, int u) {
    LAUNDER(F);
    int Lsel, l, order, dir, cb, pb;
    if (u < 4096) { Lsel = 0; pb = u & 63; cb = (u >> 6) & 3; dir = (u >> 8) & 1; order = (u >> 9) & 1; l = u >> 10; }
    else { const int v = u - 4096; Lsel = 1; pb = v & 3; cb = (v >> 2) & 3; dir = (v >> 4) & 1; order = (v >> 5) & 1; l = v >> 6; }
    const int L = Lsel ? 256 : 4096, pos0 = pb * 64, ch0 = cb * 64, colb = order * 512 + dir * 256 + ch0;
    LAS float* tile = (LAS float*)F.lds;
    const GAS float* RAW = (const GAS float*)(F.ws + WS_U + (Lsel ? U_RAWC + (size_t)l * 256 * 1024 * 4 : U_RAWL + (size_t)l * 4096 * 1024 * 4));
    const GAS float* PART = (const GAS float*)(F.ws + WS_U + U_PART) + (size_t)(l * 2 + Lsel) * 256 * 1024; LAS float* nrm = tile + 64 * 65;
    { const int cc = F.tid & 63, pr = F.tid >> 6;
#pragma unroll
      for (int i = 0; i < 8; ++i) { const int p = pr + 8 * i; tile[p * 65 + cc] = RAW[(size_t)(pos0 + p) * 1024 + colb + cc]; } }
    { const int ch = F.tid >> 3, pc = F.tid & 7, nblk = Lsel ? 16 : 256; float sacc = 0.f;
#pragma unroll 8
      for (int bk = pc; bk < nblk; bk += 8) sacc += PART[(size_t)bk * 1024 + order * 512 + ch0 + ch] + PART[(size_t)bk * 1024 + order * 512 + 256 + ch0 + ch];
      nrm[ch * 8 + pc] = sacc; }
    __syncthreads();
    GAS bf16* TG = Lsel ? (GAS bf16*)(F.ws + WS_TGC) + ((size_t)(l * 2 + order) * 256) * 512 : (GAS bf16*)(F.ws + WS_TG) + ((size_t)(l * 2 + order) * 256) * 8192;
    { const int ch = F.tid >> 3, pc = F.tid & 7; const float inv = 1.0f / (((nrm[ch * 8 + 0] + nrm[ch * 8 + 1]) + (nrm[ch * 8 + 2] + nrm[ch * 8 + 3])) + ((nrm[ch * 8 + 4] + nrm[ch * 8 + 5]) + (nrm[ch * 8 + 6] + nrm[ch * 8 + 7])));
      GAS bf16* row = TG + (size_t)(ch0 + ch) * (2 * L);
#pragma unroll
      for (int j = 0; j < 8; ++j) { const int p = 8 * pc + j, pos = pos0 + p; const unsigned v = f2bf(tile[p * 65 + ch] * inv);
          if (dir == 0) row[L - pos] = (bf16)v;
          else { if (pos == 0) row[0] = 0; else row[L + pos] = (bf16)v; } } }
    __syncthreads();
}

__device__ __forceinline__ void unit_s5tab(Frame& F, int u) {
    LAUNDER(F);
    LAS float* co = (LAS float*)F.lds;
    const int idx = u;
    if (F.tid < 64) { const int p = F.tid;
        const double lr = (double)F.in[I_LRE + F.z][idx * 64 + p], li = (double)F.in[I_LIM + F.z][idx * 64 + p], dt = exp((double)F.in[I_LDT + F.z][idx]);
        const double mag = exp(lr * dt), ar = mag * cos(li * dt), ai = mag * sin(li * dt);
        const double nr = ar - 1.0, ni = ai, den = lr * lr + li * li;
        co[p] = (float)((nr * lr + ni * li) / den); co[64 + p] = (float)((ni * lr - nr * li) / den);
        const double m32 = exp(lr * dt * 32.0);
        GAS f32x2* AB = (GAS f32x2*)(F.ws + WS_S5T + S5_AB); GAS f32x2* A32 = (GAS f32x2*)(F.ws + WS_S5T + S5_A32);
        AB[idx * 64 + p] = (f32x2){(float)ar, (float)ai};
        A32[idx * 64 + p] = (f32x2){(float)(m32 * cos(li * dt * 32.0)), (float)(m32 * sin(li * dt * 32.0))}; }
    __syncthreads();
    GAS bf16* BbT = (GAS bf16*)(F.ws + WS_S5T + S5_BBT) + (size_t)idx * 2048; GAS bf16* CmT = (GAS bf16*)(F.ws + WS_S5T + S5_CMT) + (size_t)idx * 2048;
    for (int i = F.tid; i < 2048; i += 512) { const int n = i >> 4, c = i & 15, p = n & 63;
        const float br = F.in[I_BRE + F.z][((size_t)idx * 64 + p) * 16 + c], bi = F.in[I_BIM + F.z][((size_t)idx * 64 + p) * 16 + c];
        BbT[i] = (bf16)f2bf(n < 64 ? co[p] * br - co[64 + p] * bi : co[p] * bi + co[64 + p] * br); }
    for (int i = F.tid; i < 2048; i += 512) { const int c = i >> 7, n = i & 127, p = n & 63;
        CmT[i] = (bf16)f2bf(n < 64 ? F.in[I_CRE + F.z][((size_t)idx * 16 + c) * 64 + p] : -F.in[I_CIM + F.z][((size_t)idx * 16 + c) * 64 + p]); }
    __syncthreads();
}

__device__ __forceinline__ void transpose_item_fp8(const GAS float* W, int K, int N, GAS unsigned char* WT, LAS float* scr, int item, int lane) {
    const int nblk = N / 32, kb = item / nblk, nb = item % nblk, k0 = 64 * kb, n0 = 32 * nb;
    float wv[32];
#pragma unroll
    for (int i = 0; i < 32; ++i) wv[i] = W[(size_t)(k0 + 2 * i + (lane >> 5)) * N + n0 + (lane & 31)];
#pragma unroll
    for (int i = 0; i < 32; ++i) scr[(2 * i + (lane >> 5)) * 33 + (lane & 31)] = wv[i];
    LDS_WAIT(); asm volatile("" ::: "memory");
    const int c = lane & 7;
#pragma unroll
    for (int j = 0; j < 4; ++j) { const int n = (lane >> 3) + 8 * j; const LAS float* s = scr + (8 * c) * 33 + n;
        u32x2 o; o.x = pk4_fp8(s[0 * 33] * W8_SCALE, s[1 * 33] * W8_SCALE, s[2 * 33] * W8_SCALE, s[3 * 33] * W8_SCALE); o.y = pk4_fp8(s[4 * 33] * W8_SCALE, s[5 * 33] * W8_SCALE, s[6 * 33] * W8_SCALE, s[7 * 33] * W8_SCALE);
        *(GAS u32x2*)(WT + (size_t)(n0 + n) * K + k0 + 8 * c) = o; }
    LDS_WAIT(); asm volatile("" ::: "memory");
}
__device__ __forceinline__ void ph_prologue0(Frame& F) {
    { LAS float* scr = (LAS float*)(F.lds + F.wave * 8704);
      const int gw = F.bid * 8 + F.wave, NGW = F.G * 8;
      constexpr int I_IN = 16 * 56, I_OUT = 16 * 32, I_GLU = 4 * 8, PER_L = I_IN + I_OUT + I_GLU;
      for (int it = gw; it < DEPTH * PER_L; it += NGW) { const int l = it / PER_L; int r = it % PER_L;
          if (r < I_IN) { transpose_item(F.in[I_WIN + F.z] + (size_t)l * D * INW, D, INW, (GAS bf16*)(F.ws + WS_WIN) + (size_t)l * INW * D, scr, r, F.lane); continue; } r -= I_IN;
          if (r < I_OUT) { transpose_item_fp8(F.in[I_WOUT + F.z] + (size_t)l * D * D, D, D, (GAS unsigned char*)(F.ws + WS_WOUT) + (size_t)l * D * D, scr, r, F.lane); continue; } r -= I_OUT;
          transpose_item(F.in[I_GLUW + F.z] + (size_t)l * 256 * 256, 256, 256, (GAS bf16*)(F.ws + WS_S5T + S5_GLUT) + (size_t)l * 256 * 256, scr, r, F.lane); } }
    __syncthreads();
    for (int u = F.bid; u < 384 + 1088 + 128 + 1; u += F.G) {
        if (u < 384) unit_mod(F, u);
        else if (u < 384 + 1088) unit_taps1(F, u - 384);
        else if (u < 384 + 1088 + 128) unit_s5tab(F, u - 384 - 1088);
        else { GAS f32x2* ROPE = (GAS f32x2*)(F.ws + WS_S5T + S5_ROPE);
            for (int i = F.tid; i < 64 * 16; i += 512) { const int pos = i >> 4, j = i & 15; const double ang = (double)pos * pow(10000.0, -(double)j / 16.0); ROPE[i] = (f32x2){(float)cos(ang), (float)sin(ang)}; } }
    }
}
__device__ __forceinline__ void unit_wconv(Frame& F, int l, int u) {
    LAUNDER(F);
    LAS float* scr = (LAS float*)(F.lds + F.wave * 8704);
#pragma unroll 1
    for (int k = 0; k < 4; ++k) { const int it = u * 32 + k * 8 + F.wave; const int mat = it >> 9, r = it & 511, kind = mat >> 4, e = mat & 15;
        const GAS float* W = F.in[I_WG + kind + F.z] + ((size_t)l * 16 + e) * D * D;
        GAS unsigned char* WT = (GAS unsigned char*)(F.ws + wmoe_off(l) + (size_t)kind * 32 * MiB) + (size_t)e * D * D;
        transpose_item_fp8(W, D, D, WT, scr, r, F.lane); }
    __syncthreads();
}
__device__ __forceinline__ void ph_prologue1(Frame& F) {
    for (int u = F.bid; u < 4096 + 256; u += F.G) unit_taps2(F, u);
    for (;;) { const int u = wq_next(F, 16); if (u >= 768) break; unit_wconv(F, 0, u); }
}

#ifndef PROBE_NO_MOE
#define PROBE_NO_MOE 0
#endif
__device__ __forceinline__ int bidx_of_row(int row) { return row < NCTX ? 8 : (row - NCTX) / SEQ; }

__device__ __forceinline__ void ph_norm1(Frame& F, int l) {
    GAS bf16* XS = (GAS bf16*)(F.ws + WS_XS); GAS bf16* H = (GAS bf16*)(F.ws + WS_H); const GAS bf16* YB = (const GAS bf16*)(F.ws + WS_U + U_YB); const GAS float* MOD = (const GAS float*)(F.ws + WS_MOD);
    const int lane = F.lane, row_lo = (l == DEPTH) ? NCTX : 0, nrows = NTOK - row_lo, RPB = (nrows + F.G - 1) / F.G;
    const int rbeg = row_lo + F.bid * RPB, rend = (rbeg + RPB < NTOK) ? rbeg + RPB : NTOK;
    f32x4 vn[4]; u32x2 y0n[4], y1n[4];
    f32x4 ga[4], gb[4], g2v[4]; int cur_bi = -1;
#define N1_LOAD(r) do { const GAS float* src_ = ((r) < NCTX ? F.in[I_CTX + F.z] + (size_t)(r) * D : F.in[I_X + F.z] + (size_t)((r) - NCTX) * D); \
        _Pragma("unroll") for (int j = 0; j < 4; ++j) { const int col_ = 4 * lane + 256 * j; \
            if (l == 0) vn[j] = *(const GAS f32x4*)(src_ + col_); else { const u32x2 xb_ = *(const GAS u32x2*)(XS + (size_t)(r) * D + col_); vn[j] = (f32x4){bflo(xb_.x), bfhi(xb_.x), bflo(xb_.y), bfhi(xb_.y)}; } \
            if (l > 0) { y0n[j] = *(const GAS u32x2*)(YB + ((size_t)(r) * 2 + 0) * D + col_); y1n[j] = *(const GAS u32x2*)(YB + ((size_t)(r) * 2 + 1) * D + col_); } } } while (0)
    int row = rbeg + F.wave;
    if (row < rend) N1_LOAD(row);
    for (; row < rend; row += 8) {
        const int bi = bidx_of_row(row);
        if (bi != cur_bi) { cur_bi = bi;
#pragma unroll
            for (int j = 0; j < 4; ++j) { const int col = 4 * lane + 256 * j;
                if (l > 0) g2v[j] = *(const GAS f32x4*)(MOD + ((size_t)(l - 1) * 9 + bi) * 6144 + 5 * 1024 + col);
                if (l == DEPTH) { ga[j] = *(const GAS f32x4*)(F.in[I_FG + F.z] + col); gb[j] = (f32x4){0.f, 0.f, 0.f, 0.f}; }
                else { const GAS float* m = MOD + ((size_t)l * 9 + bi) * 6144; const f32x4 g = *(const GAS f32x4*)(F.in[I_N1G + F.z] + l * D + col), sh = *(const GAS f32x4*)(m + col), sc = *(const GAS f32x4*)(m + 1024 + col);
                    ga[j] = g * (sc + 1.0f); gb[j] = sh; } } }
        f32x4 v[4]; float ss = 0.f;
#pragma unroll
        for (int j = 0; j < 4; ++j) { v[j] = vn[j];
            if (l > 0) { v[j][0] += g2v[j][0] * (bflo(y0n[j].x) + bflo(y1n[j].x)); v[j][1] += g2v[j][1] * (bfhi(y0n[j].x) + bfhi(y1n[j].x)); v[j][2] += g2v[j][2] * (bflo(y0n[j].y) + bflo(y1n[j].y)); v[j][3] += g2v[j][3] * (bfhi(y0n[j].y) + bfhi(y1n[j].y)); }
            ss += (v[j][0] * v[j][0] + v[j][1] * v[j][1]) + (v[j][2] * v[j][2] + v[j][3] * v[j][3]); }
        if (row + 8 < rend) N1_LOAD(row + 8);
        if (l > 0 && l < DEPTH) {
#pragma unroll
            for (int j = 0; j < 4; ++j) { u32x2 xo; xo.x = pk2(v[j][0], v[j][1]); xo.y = pk2(v[j][2], v[j][3]); *(GAS u32x2*)(XS + (size_t)row * D + 4 * lane + 256 * j) = xo; } }
        const float rs = __builtin_amdgcn_rsqf(wave_sum(ss, lane) * (1.0f / D) + EPS);
        if (l == DEPTH) { GAS float* o = F.out + (size_t)(row - NCTX) * D;
#pragma unroll
            for (int j = 0; j < 4; ++j) *(GAS f32x4*)(o + 4 * lane + 256 * j) = (v[j] * rs) * ga[j]; }
        else {
#pragma unroll
            for (int j = 0; j < 4; ++j) { const f32x4 h = (v[j] * rs) * ga[j] + gb[j]; u32x2 o; o.x = pk2(h[0], h[1]); o.y = pk2(h[2], h[3]); *(GAS u32x2*)(H + (size_t)row * D + 4 * lane + 256 * j) = o; } }
    }
#undef N1_LOAD
}

__device__ __forceinline__ void ph_norm2_router(Frame& F, int l) {
    LAS float* rwT = (LAS float*)F.lds; LAS unsigned* rinfo = (LAS unsigned*)(F.lds + 65536); LAS unsigned* lcnt = rinfo + 160 * 4; LAS unsigned* lbase = lcnt + 16;
    __syncthreads();
    if (F.tid < 16) lcnt[F.tid] = 0u;
    for (int i = F.tid; i < 1024 * 4; i += 512) { const int k = i >> 2, e4 = i & 3; const f32x4 w = ((const GAS f32x4*)F.in[I_RW + F.z])[i];
        rwT[(4 * e4 + 0) * 1024 + k] = w[0]; rwT[(4 * e4 + 1) * 1024 + k] = w[1]; rwT[(4 * e4 + 2) * 1024 + k] = w[2]; rwT[(4 * e4 + 3) * 1024 + k] = w[3]; }
    __syncthreads();
    const int lane = F.lane, row_lo = (l == DEPTH - 1) ? NCTX : 0, RPB = (NTOK - row_lo + F.G - 1) / F.G, rbeg = row_lo + F.bid * RPB, rend = (rbeg + RPB < NTOK) ? rbeg + RPB : NTOK;
    GAS bf16* XS = (GAS bf16*)(F.ws + WS_XS); GAS bf16* H = (GAS bf16*)(F.ws + WS_H); const GAS float* MOD = (const GAS float*)(F.ws + WS_MOD); const GAS bf16* DL = (const GAS bf16*)(F.ws + WS_U + U_DELTA);
    GAS unsigned* ELIST = (GAS unsigned*)(F.ws + WS_ELIST); GAS float* WLIST = (GAS float*)(F.ws + WS_WLIST);
    float rb[16];
#pragma unroll
    for (int e = 0; e < 16; ++e) rb[e] = F.in[I_RB + F.z][e];
    f32x4 ga[4], gb[4]; int cur_bi = -1;
    f32x4 vn[4]; u32x2 dn[4];
    int row = rbeg + F.wave;
#define N2_LOAD(r) do { const GAS float* src_ = ((r) < NCTX ? F.in[I_CTX + F.z] + (size_t)(r) * D : F.in[I_X + F.z] + (size_t)((r) - NCTX) * D); \
        _Pragma("unroll") for (int j = 0; j < 4; ++j) { const int col_ = 4 * lane + 256 * j; \
            if (l == 0) vn[j] = *(const GAS f32x4*)(src_ + col_); else { const u32x2 xb_ = *(const GAS u32x2*)(XS + (size_t)(r) * D + col_); vn[j] = (f32x4){bflo(xb_.x), bfhi(xb_.x), bflo(xb_.y), bfhi(xb_.y)}; } \
            dn[j] = *(const GAS u32x2*)(DL + (size_t)(r) * D + col_); } } while (0)
    if (row < rend) N2_LOAD(row);
    int rl = -1;
    for (; row < rend; row += 8) {
        ++rl;
        const int bi = bidx_of_row(row);
        if (bi != cur_bi) { cur_bi = bi; const GAS float* m = MOD + ((size_t)l * 9 + bi) * 6144;
#pragma unroll
            for (int j = 0; j < 4; ++j) { const int col = 4 * lane + 256 * j; const f32x4 g = *(const GAS f32x4*)(F.in[I_N2G + F.z] + l * D + col), sh = *(const GAS f32x4*)(m + 3 * 1024 + col), sc = *(const GAS f32x4*)(m + 4 * 1024 + col);
                ga[j] = g * (sc + 1.0f); gb[j] = sh; } }
        f32x4 v[4]; float ss = 0.f;
#pragma unroll
        for (int j = 0; j < 4; ++j) { v[j][0] = vn[j][0] + bflo(dn[j].x); v[j][1] = vn[j][1] + bfhi(dn[j].x); v[j][2] = vn[j][2] + bflo(dn[j].y); v[j][3] = vn[j][3] + bfhi(dn[j].y);
            ss += (v[j][0] * v[j][0] + v[j][1] * v[j][1]) + (v[j][2] * v[j][2] + v[j][3] * v[j][3]); }
        if (row + 8 < rend) N2_LOAD(row + 8);
#pragma unroll
        for (int j = 0; j < 4; ++j) { u32x2 xo; xo.x = pk2(v[j][0], v[j][1]); xo.y = pk2(v[j][2], v[j][3]); *(GAS u32x2*)(XS + (size_t)row * D + 4 * lane + 256 * j) = xo; }
        const float rs = __builtin_amdgcn_rsqf(wave_sum(ss, lane) * (1.0f / D) + EPS);
        float lg[16];
#pragma unroll
        for (int e = 0; e < 16; ++e) lg[e] = 0.f;
#pragma unroll
        for (int j = 0; j < 4; ++j) { const int col = 4 * lane + 256 * j;
            const f32x4 h = (v[j] * rs) * ga[j] + gb[j];
            *(GAS unsigned*)((GAS unsigned char*)H + (size_t)row * D + col) = pk4_fp8(h[0], h[1], h[2], h[3]);
#pragma unroll
            for (int e = 0; e < 16; ++e) { const f32x4 w = *(const LAS f32x4*)(rwT + e * 1024 + col); lg[e] = __builtin_fmaf(h[3], w[3], __builtin_fmaf(h[2], w[2], __builtin_fmaf(h[1], w[1], __builtin_fmaf(h[0], w[0], lg[e])))); }
            asm volatile("" ::: "memory"); }
        float a8[8], a4[4], a2[2], a1;
        { const bool up = (lane & 32) != 0;
#pragma unroll
          for (int i = 0; i < 8; ++i) { const float send = up ? lg[i] : lg[i + 8], keep = up ? lg[i + 8] : lg[i]; a8[i] = keep + lane_xor(send, lane, 32); } }
        { const bool up = (lane & 16) != 0;
#pragma unroll
          for (int i = 0; i < 4; ++i) { const float send = up ? a8[i] : a8[i + 4], keep = up ? a8[i + 4] : a8[i]; a4[i] = keep + lane_xor(send, lane, 16); } }
        { const bool up = (lane & 8) != 0;
#pragma unroll
          for (int i = 0; i < 2; ++i) { const float send = up ? a4[i] : a4[i + 2], keep = up ? a4[i + 2] : a4[i]; a2[i] = keep + lane_xor(send, lane, 8); } }
        { const bool up = (lane & 4) != 0; const float send = up ? a2[0] : a2[1], keep = up ? a2[1] : a2[0]; a1 = keep + lane_xor(send, lane, 4); }
        a1 += lane_xor(a1, lane, 1); a1 += lane_xor(a1, lane, 2);
#pragma unroll
        for (int e = 0; e < 16; ++e) lg[e] = __builtin_bit_cast(float, __builtin_amdgcn_readlane(__builtin_bit_cast(int, a1), 4 * e));
        float mx = lg[0];
#pragma unroll
        for (int e = 1; e < 16; ++e) mx = fmaxf(mx, lg[e]);
        float pr[16], sum = 0.f;
#pragma unroll
        for (int e = 0; e < 16; ++e) { pr[e] = __expf(lg[e] - mx); sum += pr[e]; }
        const float inv = __builtin_amdgcn_rcpf(sum);
        float sel[16];
#pragma unroll
        for (int e = 0; e < 16; ++e) { pr[e] *= inv; sel[e] = pr[e] + rb[e]; }
        float best = -1e30f; int gi = 0;
#pragma unroll
        for (int g = 0; g < 4; ++g) { const float a = sel[4 * g], b = sel[4 * g + 1], c = sel[4 * g + 2], d = sel[4 * g + 3];
            const float hi1 = fmaxf(a, b), lo1 = fminf(a, b), hi2 = fmaxf(c, d), lo2 = fminf(c, d);
            const float top = fmaxf(hi1, hi2), second = fmaxf(fminf(hi1, hi2), fmaxf(lo1, lo2)); const float gs = top + second;
            if (gs > best) { best = gs; gi = g; } }
        float s0 = 0.f, s1 = 0.f, s2 = 0.f, s3 = 0.f, p0 = 0.f, p1 = 0.f, p2 = 0.f, p3 = 0.f;
#pragma unroll
        for (int g = 0; g < 4; ++g) if (g == gi) { s0 = sel[4 * g]; s1 = sel[4 * g + 1]; s2 = sel[4 * g + 2]; s3 = sel[4 * g + 3]; p0 = pr[4 * g]; p1 = pr[4 * g + 1]; p2 = pr[4 * g + 2]; p3 = pr[4 * g + 3]; }
        int i1 = 0; float b1 = s0; if (s1 > b1) { b1 = s1; i1 = 1; } if (s2 > b1) { b1 = s2; i1 = 2; } if (s3 > b1) { b1 = s3; i1 = 3; }
        int i2 = -1; float b2 = -1e30f;
        if (i1 != 0 && s0 > b2) { b2 = s0; i2 = 0; } if (i1 != 1 && s1 > b2) { b2 = s1; i2 = 1; } if (i1 != 2 && s2 > b2) { b2 = s2; i2 = 2; } if (i1 != 3 && s3 > b2) { b2 = s3; i2 = 3; }
        const float q1 = i1 == 0 ? p0 : i1 == 1 ? p1 : i1 == 2 ? p2 : p3, q2 = i2 == 0 ? p0 : i2 == 1 ? p1 : i2 == 2 ? p2 : p3;
        const float gsum = q1 + q2;
        if (lane < 2) { const int e = gi * 4 + (lane == 0 ? i1 : i2); const float gate = (lane == 0 ? q1 : q2) * __builtin_amdgcn_rcpf(gsum);
            const unsigned lp = __hip_atomic_fetch_add(lcnt + e, 1u, __ATOMIC_RELAXED, __HIP_MEMORY_SCOPE_WORKGROUP);
            const int ent = (rl * 8 + F.wave) * 2 + lane;
            rinfo[ent * 2 + 0] = ((unsigned)e << 24) | lp; rinfo[ent * 2 + 1] = __builtin_bit_cast(unsigned, gate); }
    }
#undef N2_LOAD
    __syncthreads();
    if (F.tid < 16) lbase[F.tid] = __hip_atomic_fetch_add(F.ctl + CW_CNT + (l * 16 + F.tid) * 64, lcnt[F.tid], __ATOMIC_RELAXED, __HIP_MEMORY_SCOPE_AGENT);
    __syncthreads();
    for (int ent = F.tid; ent < 160 * 2; ent += 512) { const int rslot = ent >> 1, k = rslot >> 3, w = rslot & 7; const int r = rbeg + w + 8 * k;
        if (r < rend) { const unsigned a0 = rinfo[ent * 2], e = a0 >> 24, pos = lbase[e] + (a0 & 0xffffffu);
            ELIST[(size_t)e * ECAP + pos] = (unsigned)r * 2u + (unsigned)(ent & 1); WLIST[(size_t)e * ECAP + pos] = __builtin_bit_cast(float, rinfo[ent * 2 + 1]); } }
    __syncthreads();
}

__device__ __forceinline__ void moe_tables(Frame& F, int l, volatile LAS int* tab) {
    __syncthreads();
    if (F.tid == 0) { int pref = 0;
        for (int e = 0; e < 16; ++e) { const int c = (int)__hip_atomic_load(F.ctl + CW_CNT + (l * 16 + e) * 64, __ATOMIC_RELAXED, __HIP_MEMORY_SCOPE_AGENT); tab[e] = pref; tab[32 + e] = c; pref += (c + 255) >> 8; }
        tab[16] = pref; }
    __syncthreads();
}
__device__ __forceinline__ void ph_gather(Frame& F, int l) {
    volatile LAS int* tab = (volatile LAS int*)(F.lds + LDS_BYTES - 512);
    moe_tables(F, l, tab);
    const int gw = F.bid * 8 + F.wave, NGW = F.G * 8;
    const GAS unsigned* ELIST = (const GAS unsigned*)(F.ws + WS_ELIST); const GAS bf16* H = (const GAS bf16*)(F.ws + WS_H); GAS bf16* XG = (GAS bf16*)(F.ws + WS_U + U_XG);
    for (int e = 0; e < 16; ++e) { const int cnt = __builtin_amdgcn_readfirstlane(tab[32 + e]), base = 256 * __builtin_amdgcn_readfirstlane(tab[e]);
        for (int pos = gw; pos < cnt; pos += NGW) { const unsigned tok = ELIST[(size_t)e * ECAP + pos] >> 1;
            const GAS u32x4* s = (const GAS u32x4*)(H + (size_t)tok * D); GAS u32x4* d = (GAS u32x4*)(XG + (size_t)(base + pos) * D);
            const u32x4 a = s[F.lane], b = s[64 + F.lane]; d[F.lane] = a; d[64 + F.lane] = b; }
        for (int pos = cnt + gw; pos < ((cnt + 255) & ~255); pos += NGW) { GAS u32x4* d = (GAS u32x4*)(XG + (size_t)(base + pos) * D); d[F.lane] = (u32x4){0u, 0u, 0u, 0u}; d[64 + F.lane] = (u32x4){0u, 0u, 0u, 0u}; } }
}

__device__ __forceinline__ void unit_prep_qk(Frame& F, int u) {
    LAUNDER(F);
    const GAS bf16* P = (const GAS bf16*)(F.ws + WS_U + U_P); GAS bf16* QR = (GAS bf16*)(F.ws + WS_U + U_QR); GAS bf16* KR = (GAS bf16*)(F.ws + WS_U + U_KR); const GAS f32x2* ROPE = (const GAS f32x2*)(F.ws + WS_S5T + S5_ROPE);
    u32x4 pa[5], pb[5];
#pragma unroll
    for (int q = 0; q < 5; ++q) { const int it = F.tid + 512 * q, r = it / 40, s = it % 40, hs = s >> 2, half = (s >> 1) & 1, ck = s & 1; const int row = u * 64 + r;
        const int scol = (hs < 8 ? HY_END + hs * 64 : Q_END + (hs - 8) * 64) + half * 32 + ck * 8;
        pa[q] = *(const GAS u32x4*)(P + (size_t)row * INW + scol); pb[q] = *(const GAS u32x4*)(P + (size_t)row * INW + scol + 16); }
#pragma unroll
    for (int q = 0; q < 5; ++q) { const int it = F.tid + 512 * q; const int r = it / 40, s = it % 40, hs = s >> 2, half = (s >> 1) & 1, ck = s & 1; const int row = u * 64 + r;
        const bool isq = hs < 8;
        const u32x4 a = pa[q], b = pb[q];
        const unsigned aw[4] = {a.x, a.y, a.z, a.w}, bw[4] = {b.x, b.y, b.z, b.w}; float x1[8], x2[8], o1[8], o2[8];
#pragma unroll
        for (int k = 0; k < 4; ++k) { x1[2 * k] = bflo(aw[k]); x1[2 * k + 1] = bfhi(aw[k]); x2[2 * k] = bflo(bw[k]); x2[2 * k + 1] = bfhi(bw[k]); }
        const float scl = isq ? 0.125f * 1.4426950408889634f : 1.0f;
        if (row >= NCTX) { const int t = (row - NCTX) & (SEQ - 1), pos = half ? (t & 63) : (t >> 6);
#pragma unroll
            for (int k = 0; k < 8; ++k) { const f32x2 cs = ROPE[pos * 16 + ck * 8 + k]; o1[k] = (x1[k] * cs.x - x2[k] * cs.y) * scl; o2[k] = (x1[k] * cs.y + x2[k] * cs.x) * scl; } }
        else {
#pragma unroll
            for (int k = 0; k < 8; ++k) { o1[k] = x1[k] * scl; o2[k] = x2[k] * scl; } }
        u32x4 oa, ob; oa.x = pk2(o1[0], o1[1]); oa.y = pk2(o1[2], o1[3]); oa.z = pk2(o1[4], o1[5]); oa.w = pk2(o1[6], o1[7]); ob.x = pk2(o2[0], o2[1]); ob.y = pk2(o2[2], o2[3]); ob.z = pk2(o2[4], o2[5]); ob.w = pk2(o2[6], o2[7]);
        GAS bf16* dst = isq ? QR + (size_t)row * 512 + hs * 64 + half * 32 + ck * 8 : KR + (size_t)row * 128 + (hs - 8) * 64 + half * 32 + ck * 8;
        *(GAS u32x4*)dst = oa; *(GAS u32x4*)(dst + 16) = ob; }
}

__device__ __forceinline__ void unit_hy_prep(Frame& F, int l, int u) {
    LAUNDER(F);
    const int seg = u / 256, b = (u >> 5) & 7, tb = u & 31, t0 = tb * 128;
    LAS bf16* tile = (LAS bf16*)F.lds;
    const GAS bf16* P = (const GAS bf16*)(F.ws + WS_U + U_P);
    __syncthreads();
    { u32x4 tv[9];
#pragma unroll
      for (int k = 0; k < 9; ++k) { const int i = F.tid + 512 * k, rr = i >> 5, ck = i & 31, t = t0 - 1 + rr; tv[k] = (u32x4){0u, 0u, 0u, 0u};
          if (i < 130 * 32 && t >= 0 && t < SEQ) tv[k] = *(const GAS u32x4*)(P + (size_t)(NCTX + b * SEQ + t) * INW + seg * 256 + ck * 8); }
#pragma unroll
      for (int k = 0; k < 9; ++k) { const int i = F.tid + 512 * k, rr = i >> 5, ck = i & 31; if (i < 130 * 32) *(LAS u32x4*)(tile + rr * 264 + ck * 8) = tv[k]; } }
    __syncthreads();
    GAS bf16* OUT = (GAS bf16*)(F.ws + WS_U + (seg == 0 ? U_HV : seg == 1 ? U_HX1 : U_HX2));
    const int ch = F.tid & 255, col = seg * 256 + ch;
    const float w0 = F.in[I_HCW + F.z][(l * 3 + 0) * 768 + col], w1 = F.in[I_HCW + F.z][(l * 3 + 1) * 768 + col], w2 = F.in[I_HCW + F.z][(l * 3 + 2) * 768 + col], bb = F.in[I_HCB + F.z][l * 768 + col];
#pragma unroll
    for (int k = 0; k < 8; ++k) { const int tc = (F.tid >> 8) + 2 * k; float z[10];
#pragma unroll
        for (int j = 0; j < 10; ++j) z[j] = bf2f(tile[(8 * tc + j) * 264 + ch]);
        float o[8];
#pragma unroll
        for (int j = 0; j < 8; ++j) o[j] = bb + w0 * z[j] + w1 * z[j + 1] + w2 * z[j + 2];
        u32x4 w; w.x = pk2(o[0], o[1]); w.y = pk2(o[2], o[3]); w.z = pk2(o[4], o[5]); w.w = pk2(o[6], o[7]);
        *(GAS u32x4*)(OUT + ((size_t)ch * NB + b) * SEQ + t0 + 8 * tc) = w; }
}

constexpr int HY_NA = 642, HY_CP = 656, HY_GT_BYTES = (8 * HY_CP + 16) * 16  , HY_UP = 4488, HY_UB_OFF = HY_GT_BYTES, HY_UB_BYTES = 8 * HY_UP * 2  ;
static_assert(HY_UB_OFF + HY_UB_BYTES + 64 <= LDS_BYTES - 512, "hyena LDS");
#define HY_CB(r) ((int)((0xD95D9510u >> (4 * (r))) & 15u))
#define HY_SWZ(xb) ((xb) ^ (((xb) >> 2) & 64))
__device__ __forceinline__ void unit_hy_conv(Frame& F, int l, int order, int ch) {
    LAUNDER(F);
    LAS unsigned char* GT = F.lds; LAS unsigned char* UB = F.lds + HY_UB_OFF; LAS float* RED = (LAS float*)F.lds;
    const GAS bf16* TG = (const GAS bf16*)(F.ws + WS_TG) + ((size_t)(l * 2 + order) * 256 + ch) * 8192;
    const GAS bf16* U = (const GAS bf16*)(F.ws + WS_U + (order == 0 ? U_HV : U_Z1T)) + (size_t)ch * NB * SEQ;
    const GAS bf16* XM = (const GAS bf16*)(F.ws + WS_U + (order == 0 ? U_HX1 : U_HX2)) + (size_t)ch * NB * SEQ;
    GAS bf16* OUT = (GAS bf16*)(F.ws + WS_U + (order == 0 ? U_Z1T : U_HYT)) + (size_t)ch * NB * SEQ;
    const float bias = F.in[I_HBIAS + F.z][(l * 2 + order) * 256 + ch];
    const int lane = F.lane, w = F.wave, nt = w & 3, kh = w >> 2, half = lane >> 5, i = lane & 31, col = lane & 31, bb = col >> 2, np = col & 3;
    LDS_BARRIER();
    { u32x4 uv[8];
#pragma unroll
      for (int b = 0; b < 8; ++b) uv[b] = *(const GAS u32x4*)(U + (size_t)b * SEQ + 8 * F.tid);
#pragma unroll
      for (int b = 0; b < 8; ++b) *(LAS u32x4*)(UB + b * (HY_UP * 2) + HY_SWZ((192 + 8 * F.tid) * 2)) = uv[b]; }
    for (int k = F.tid; k < 8 * 49; k += 512) { const int b = k / 49, c = k % 49; const int el = c < 24 ? 8 * c : 4288 + 8 * (c - 24); *(LAS u32x4*)(UB + b * (HY_UP * 2) + HY_SWZ(el * 2)) = (u32x4){0u, 0u, 0u, 0u}; }
    u32x4 glo[2], ghi[2];
#define HY_TAPS(q_) do { const int Y0_ = -(1024 * (q_) + 1024); _Pragma("unroll") for (int k = 0; k < 2; ++k) { const int yp = Y0_ + 8 * (F.tid + 512 * k) + 4096;     \
            glo[k] = *(const GAS u32x4*)(TG + (yp < 8184 ? yp : 8184)); ghi[k] = *(const GAS u32x4*)(TG + (yp + 8 < 8184 ? yp + 8 : 8184)); } } while (0)
    HY_TAPS(0);
#pragma unroll 1
    for (int q = 0; q < 4; ++q) {
        const int T0 = 1024 * q, Y0 = -(T0 + 1024);
        LDS_BARRIER();
#pragma unroll
        for (int k = 0; k < 2; ++k) { const int a = F.tid + 512 * k; if (a >= HY_NA) continue;
            const int yp = Y0 + 8 * a + 4096; const u32x4 z4 = (u32x4){0u, 0u, 0u, 0u}; const u32x4 lo = (yp < 8192) ? glo[k] : z4, hi = (yp + 8 < 8192) ? ghi[k] : z4;
            const unsigned wv[8] = {lo.x, lo.y, lo.z, lo.w, hi.x, hi.y, hi.z, hi.w};
#pragma unroll
            for (int r = 0; r < 8; ++r) { u32x4 o;
                if ((r & 1) == 0) { o.x = wv[r / 2]; o.y = wv[r / 2 + 1]; o.z = wv[r / 2 + 2]; o.w = wv[r / 2 + 3]; }
                else { const int d = r / 2; o.x = (wv[d] >> 16) | (wv[d + 1] << 16); o.y = (wv[d + 1] >> 16) | (wv[d + 2] << 16); o.z = (wv[d + 2] >> 16) | (wv[d + 3] << 16); o.w = (wv[d + 3] >> 16) | (wv[d + 4] << 16); }
                *(LAS u32x4*)(GT + (r * HY_CP + HY_CB(r) + a) * 16) = o; } }
        LDS_BARRIER();
        if (q + 1 < 4) HY_TAPS(q + 1);
        u32x2 xmv[4];
#pragma unroll
        for (int rg = 0; rg < 4; ++rg) xmv[rg] = *(const GAS u32x2*)(XM + (size_t)bb * SEQ + T0 + 256 * nt + 64 * np + 32 * kh + 8 * rg + 4 * half);
        const int K_lo = -(T0 + 256 * nt + 192), ks0 = K_lo + 16 * 134 * kh;
        const int rcp = (8 - (i & 7)) & 7;
        int aidx = (ks0 - 32 - Y0) / 8 + half - ((i + 7) >> 3);
        const LAS unsigned char* ap = GT + (rcp * HY_CP + HY_CB(rcp)) * 16;
        const LAS unsigned char* brow = UB + bb * (HY_UP * 2); int xb = (192 + ks0 + T0 + 256 * nt + 64 * np + 8 * half) * 2;
        bf16x8 a0, a1, a2, a3, a4 = *(const LAS bf16x8*)(ap + aidx * 16), a5 = *(const LAS bf16x8*)(ap + (aidx + 2) * 16), b0, b1, b2;
        aidx += 4;
        f32x16 acc0 = zero16(), acc1 = zero16();
        a0 = *(const LAS bf16x8*)(ap + aidx * 16); b0 = *(const LAS bf16x8*)(brow + HY_SWZ(xb));
        aidx += 2; xb += 32;
        a1 = *(const LAS bf16x8*)(ap + aidx * 16); b1 = *(const LAS bf16x8*)(brow + HY_SWZ(xb));
#define HY_STEP(An, Ac, Am, Bn, Bc) do { aidx += 2; xb += 32; An = *(const LAS bf16x8*)(ap + aidx * 16); Bn = *(const LAS bf16x8*)(brow + HY_SWZ(xb)); __builtin_amdgcn_sched_barrier(0); \
            acc0 = __builtin_amdgcn_mfma_f32_32x32x16_bf16(Ac, Bc, acc0, 0, 0, 0); acc1 = __builtin_amdgcn_mfma_f32_32x32x16_bf16(Am, Bc, acc1, 0, 0, 0); __builtin_amdgcn_sched_barrier(0); } while (0)
#pragma unroll 1
        for (int st = 0; st < 132; st += 6) { HY_STEP(a2, a0, a4, b2, b0); HY_STEP(a3, a1, a5, b0, b1); HY_STEP(a4, a2, a0, b1, b2); HY_STEP(a5, a3, a1, b2, b0); HY_STEP(a0, a4, a2, b0, b1); HY_STEP(a1, a5, a3, b1, b2); }
        HY_STEP(a2, a0, a4, b2, b0); HY_STEP(a3, a1, a5, b0, b1);
#undef HY_STEP
        LDS_BARRIER();
        { LAS float* mine = RED + ((nt * 2 + (1 - kh)) * 16) * 64;
#pragma unroll
          for (int r = 0; r < 16; ++r) mine[r * 64 + lane] = (kh == 0) ? acc1[r] : acc0[r]; }
        LDS_BARRIER();
        { const LAS float* oth = RED + ((nt * 2 + kh) * 16) * 64;
          const int mb = kh;
#pragma unroll
          for (int rg = 0; rg < 4; ++rg) {
              const int t = T0 + 256 * nt + 64 * np + 32 * mb + 8 * rg + 4 * half;
              const u32x2 xm = xmv[rg];
              const u32x2 uu = *(const LAS u32x2*)(UB + bb * (HY_UP * 2) + HY_SWZ((192 + t) * 2));
              const float xv[4] = {bflo(xm.x), bfhi(xm.x), bflo(xm.y), bfhi(xm.y)}, uv[4] = {bflo(uu.x), bfhi(uu.x), bflo(uu.y), bfhi(uu.y)};
              float o[4];
#pragma unroll
              for (int j = 0; j < 4; ++j) { const int r = 4 * rg + j; const float y = (kh == 0 ? acc0[r] : acc1[r]) + oth[r * 64 + lane]; o[j] = xv[j] * (y + uv[j] * bias); }
              u32x2 ov; ov.x = pk2(o[0], o[1]); ov.y = pk2(o[2], o[3]);
              *(GAS u32x2*)(OUT + (size_t)bb * SEQ + t) = ov; } }
    }
#undef HY_TAPS
    LDS_BARRIER();
}

__device__ __forceinline__ void unit_hy_ctx(Frame& F, int l, int ch) {
    LAUNDER(F);
    LAS float* z = (LAS float*)F.lds;
    LAS float* vv = z + 3 * 8 * 258;
    LAS float* g = vv + 3 * 8 * 256;
    LAS float* z1 = g + 2 * 512;
    const GAS bf16* P = (const GAS bf16*)(F.ws + WS_U + U_P);
    __syncthreads();
    { unsigned zv[13];
#pragma unroll
      for (int q = 0; q < 13; ++q) { const int k = F.tid + 512 * q, seg = k / (8 * 258), r = k % (8 * 258), b = r / 258, tt = r % 258 - 1; zv[q] = 0u;
          if (k < 3 * 8 * 258 && tt >= 0 && tt < 256) zv[q] = P[(size_t)(b * 256 + tt) * INW + seg * 256 + ch]; }
#pragma unroll
      for (int q = 0; q < 13; ++q) { const int k = F.tid + 512 * q; if (k < 3 * 8 * 258) z[k] = bf2f(zv[q]); } }
    for (int k = F.tid; k < 2 * 512; k += 512) { const int o = k >> 9, y = k & 511; g[k] = bf2f(((const GAS bf16*)(F.ws + WS_TGC))[((size_t)(l * 2 + o) * 256 + ch) * 512 + y]); }
    __syncthreads();
    for (int k = F.tid; k < 3 * 8 * 256; k += 512) { const int seg = k / 2048, r = k % 2048, b = r >> 8, t = r & 255; const int col = seg * 256 + ch; const LAS float* zz = z + (seg * 8 + b) * 258 + t;
        vv[k] = F.in[I_HCB + F.z][l * 768 + col] + F.in[I_HCW + F.z][(l * 3 + 0) * 768 + col] * zz[0] + F.in[I_HCW + F.z][(l * 3 + 1) * 768 + col] * zz[1] + F.in[I_HCW + F.z][(l * 3 + 2) * 768 + col] * zz[2]; }
    __syncthreads();
    const int b = F.tid >> 6, tq = F.tid & 63;
    const float bias0 = F.in[I_HBIAS + F.z][(l * 2 + 0) * 256 + ch], bias1 = F.in[I_HBIAS + F.z][(l * 2 + 1) * 256 + ch];
#define HYC_CONV(GOFF, U) \
    float a0 = 0.f, a1 = 0.f, a2 = 0.f, a3 = 0.f; { const LAS float* gp = g + (GOFF) + 256 - 4 * tq; float m1 = gp[-1], m2 = gp[-2], m3 = gp[-3]; \
      _Pragma("unroll 2") for (int s0 = 0; s0 < 256; s0 += 4) { const f32x4 w = *(const LAS f32x4*)(gp + s0); const f32x4 uu = *(const LAS f32x4*)((U) + s0); \
          a0 += w[0] * uu[0]; a1 += m1 * uu[0];   a2 += m2 * uu[0];   a3 += m3 * uu[0]; \
          a0 += w[1] * uu[1]; a1 += w[0] * uu[1]; a2 += m1 * uu[1];   a3 += m2 * uu[1]; \
          a0 += w[2] * uu[2]; a1 += w[1] * uu[2]; a2 += w[0] * uu[2]; a3 += m1 * uu[2]; \
          a0 += w[3] * uu[3]; a1 += w[2] * uu[3]; a2 += w[1] * uu[3]; a3 += w[0] * uu[3]; \
          m1 = w[3]; m2 = w[2]; m3 = w[1]; } }
    { const LAS float* u = vv + b * 256;
      HYC_CONV(0, u);
      const f32x4 x1 = *(const LAS f32x4*)(vv + (8 + b) * 256 + 4 * tq), ut = *(const LAS f32x4*)(u + 4 * tq);
      f32x4 o; o[0] = x1[0] * (a0 + ut[0] * bias0); o[1] = x1[1] * (a1 + ut[1] * bias0); o[2] = x1[2] * (a2 + ut[2] * bias0); o[3] = x1[3] * (a3 + ut[3] * bias0);
      *(LAS f32x4*)(z1 + b * 256 + 4 * tq) = o; }
    __syncthreads();
    { const LAS float* u = z1 + b * 256;
      HYC_CONV(512, u);
      GAS bf16* HYC = (GAS bf16*)(F.ws + WS_HYC);
      const f32x4 x2 = *(const LAS f32x4*)(vv + (16 + b) * 256 + 4 * tq), ut = *(const LAS f32x4*)(u + 4 * tq);
      const float o[4] = {x2[0] * (a0 + ut[0] * bias1), x2[1] * (a1 + ut[1] * bias1), x2[2] * (a2 + ut[2] * bias1), x2[3] * (a3 + ut[3] * bias1)};
#pragma unroll
      for (int i = 0; i < 4; ++i) HYC[(size_t)(b * 256 + 4 * tq + i) * 256 + ch] = (bf16)f2bf(o[i]); }
#undef HYC_CONV
    __syncthreads();
}

constexpr int AT_KP = 72  , AT_VP = 96  , AT_K_BYTES = 320 * AT_KP * 2  , AT_V_OFF = AT_K_BYTES;
typedef short s16x4 __attribute__((ext_vector_type(4)));
__device__ __forceinline__ void unit_attn(Frame& F, int l, int u) {
    LAUNDER(F);
    const bool lat = u < 1024; const int v_ = u - 1024;
    const int b = lat ? (u >> 7) : (v_ >> 3), kvh = lat ? ((u >> 6) & 1) : ((v_ >> 2) & 1), qt = lat ? (u & 63) : (v_ & 3);
    const GAS bf16* P = (const GAS bf16*)(F.ws + WS_U + U_P); const GAS bf16* QR = (const GAS bf16*)(F.ws + WS_U + U_QR); const GAS bf16* KR = (const GAS bf16*)(F.ws + WS_U + U_KR); GAS bf16* ATT = (GAS bf16*)(F.ws + WS_U + U_ATT);
    LAS unsigned char* KL = F.lds; LAS bf16* VL = (LAS bf16*)(F.lds + AT_V_OFF);
    const int lane = F.lane, w = F.wave, g = w >> 1, hh = w & 1, half = lane >> 5, ql = lane & 31;
    const int rowbase = lat ? NCTX + b * SEQ : b * CTXL;
    const int tq = 64 * qt + 32 * hh + ql;
    const int qrow = rowbase + tq, head = kvh * 4 + g;
    bf16x8 qf[4];
#pragma unroll
    for (int ks = 0; ks < 4; ++ks) qf[ks] = *(const GAS bf16x8*)(QR + (size_t)qrow * 512 + head * 64 + 16 * ks + 8 * half);
    float m_run = F.in[I_SINK + F.z][l * 8 + head] * 1.4426950408889634f, l_run = 1.0f;
    f32x16 o0 = zero16(), o1 = zero16();
    const LAS bf16* vbase = VL + (4 * half + ((lane & 15) >> 2)) * AT_VP + 16 * ((lane >> 4) & 1) + 4 * (lane & 3);
#pragma unroll 1
    for (int stage = lat ? 0 : 1; stage < 2; ++stage) {
        const int nkeys = stage == 0 ? 320 : 256;
        const int kbase = stage == 0 ? 64 * qt - 128 : 0;
        const int krow0 = stage == 0 ? NCTX + b * SEQ : b * CTXL;
        const int klimit = stage == 0 ? SEQ : CTXL;
        __syncthreads();
        { u32x4 kv[5], vv[5];
#pragma unroll
          for (int k = 0; k < 5; ++k) { const int i = F.tid + 512 * k, kk = i >> 3, c = i & 7, kp = kbase + kk; kv[k] = (u32x4){0u, 0u, 0u, 0u}; vv[k] = kv[k];
              if (i < nkeys * 8 && kp >= 0 && kp < klimit) { kv[k] = *(const GAS u32x4*)(KR + (size_t)(krow0 + kp) * 128 + kvh * 64 + 8 * c); vv[k] = *(const GAS u32x4*)(P + (size_t)(krow0 + kp) * INW + K_END + kvh * 64 + 8 * c); } }
#pragma unroll
          for (int k = 0; k < 5; ++k) { const int i = F.tid + 512 * k, kk = i >> 3, c = i & 7;
              if (i < nkeys * 8) { *(LAS u32x4*)(KL + (kk * AT_KP + 8 * c) * 2) = kv[k]; *(LAS u32x4*)(VL + kk * AT_VP + 8 * c) = vv[k]; } } }
        __syncthreads();
        const int ntile = stage == 0 ? 9 : 8, kk00 = stage == 0 ? 32 * hh : 0;
#pragma unroll 1
        for (int tt = 0; tt < ntile; ++tt) {
            const int kk0 = kk00 + 32 * tt;
            f32x16 st;
#pragma unroll
            for (int r = 0; r < 16; ++r) st[r] = -m_run;
            asm volatile("" : "+v"(st));
#pragma unroll
            for (int ks = 0; ks < 4; ++ks) { const bf16x8 kf = *(const LAS bf16x8*)(KL + ((kk0 + ql) * AT_KP + 16 * ks + 8 * half) * 2); st = __builtin_amdgcn_mfma_f32_32x32x16_bf16(kf, qf[ks], st, 0, 0, 0); }
            const int kp0 = kbase + kk0;
            if (stage == 0 && (tt == 0 || tt == 8 || kp0 < 0 || kp0 + 32 > SEQ)) {
#pragma unroll
                for (int r = 0; r < 16; ++r) { const int kp = kp0 + 8 * (r >> 2) + 4 * half + (r & 3); const int dd = kp - tq; const bool ok = (dd <= 128) && (dd >= -128) && (kp >= 0) && (kp < SEQ); st[r] = ok ? st[r] : -1e30f; } }
            float mx = st[0];
#pragma unroll
            for (int r = 1; r < 16; ++r) mx = fmaxf(mx, st[r]);
            mx = pair32_max(mx);
            if (__builtin_amdgcn_ballot_w64(mx > 8.0f) != 0ull) {
                const float delta = fmaxf(mx, 0.f), alpha = __builtin_amdgcn_exp2f(-delta);
                m_run += delta; l_run *= alpha;
#pragma unroll
                for (int r = 0; r < 16; ++r) { st[r] -= delta; o0[r] *= alpha; o1[r] *= alpha; } }
#pragma unroll
            for (int r = 0; r < 16; ++r) st[r] = __builtin_amdgcn_exp2f(st[r]);
            f32x2 rs2 = (f32x2){st[0], st[1]};
#pragma unroll
            for (int r = 1; r < 8; ++r) rs2 += (f32x2){st[2 * r], st[2 * r + 1]};
            float rsum = pair32_sum(rs2[0] + rs2[1]);
            l_run += rsum;
#pragma unroll
            for (int ks = 0; ks < 2; ++ks) {
                union { bf16x8 v; unsigned w[4]; } pf;
                pf.w[0] = pk2(st[8 * ks + 0], st[8 * ks + 1]); pf.w[1] = pk2(st[8 * ks + 2], st[8 * ks + 3]); pf.w[2] = pk2(st[8 * ks + 4], st[8 * ks + 5]); pf.w[3] = pk2(st[8 * ks + 6], st[8 * ks + 7]);
                union { bf16x8 v; s16x4 h[2]; } v0, v1;
                const LAS bf16* vp = vbase + (kk0 + 16 * ks) * AT_VP;
                v0.h[0] = __builtin_amdgcn_ds_read_tr16_b64_v4i16((LAS s16x4*)vp); v0.h[1] = __builtin_amdgcn_ds_read_tr16_b64_v4i16((LAS s16x4*)(vp + 8 * AT_VP));
                v1.h[0] = __builtin_amdgcn_ds_read_tr16_b64_v4i16((LAS s16x4*)(vp + 32)); v1.h[1] = __builtin_amdgcn_ds_read_tr16_b64_v4i16((LAS s16x4*)(vp + 8 * AT_VP + 32));
                o0 = __builtin_amdgcn_mfma_f32_32x32x16_bf16(v0.v, pf.v, o0, 0, 0, 0);
                o1 = __builtin_amdgcn_mfma_f32_32x32x16_bf16(v1.v, pf.v, o1, 0, 0, 0);
            }
        }
    }
    const float inv = 1.0f / l_run;
    GAS bf16* orow = ATT + (size_t)qrow * 512 + head * 64;
#pragma unroll
    for (int rg = 0; rg < 4; ++rg) { const int d = 8 * rg + 4 * half;
        u32x2 a; a.x = pk2(o0[4 * rg] * inv, o0[4 * rg + 1] * inv); a.y = pk2(o0[4 * rg + 2] * inv, o0[4 * rg + 3] * inv); *(GAS u32x2*)(orow + d) = a;
        u32x2 c; c.x = pk2(o1[4 * rg] * inv, o1[4 * rg + 1] * inv); c.y = pk2(o1[4 * rg + 2] * inv, o1[4 * rg + 3] * inv); *(GAS u32x2*)(orow + 32 + d) = c; }
    __syncthreads();
}

__device__ __forceinline__ size_t s5_state_off(int cid, int b, int dir, int g) { return ((((size_t)cid * NB + b) * 2 + dir) * 16 + g) * 128; }
__device__ __forceinline__ int s5_row0(int cid, int b) { return cid < 8 ? b * CTXL + 32 * cid : NCTX + b * SEQ + 32 * (cid - 8); }
__device__ __forceinline__ void cmac(float& sr, float& si, float ar, float ai, float br, float bi) {
    float nr, ni;
    asm volatile("v_fma_f32 %0, %2, %3, %6\n\tv_fma_f32 %1, %2, %4, %7\n\tv_fma_f32 %0, -%5, %4, %0\n\tv_fma_f32 %1, %5, %3, %1" : "=&v"(nr), "=&v"(ni) : "v"(ar), "v"(sr), "v"(si), "v"(ai), "v"(br), "v"(bi));
    sr = nr; si = ni;
}
constexpr int S5_SP = 132;
template <int MODE> __device__ __forceinline__ void unit_s5(Frame& F, int l, int u) {
    LAUNDER(F);
    const int g = u >> 4, b = (u >> 1) & 7, hf = u & 1;
    const int lane = F.lane, w = F.wave, half = lane >> 5, ql = lane & 31;
    const GAS bf16* P = (const GAS bf16*)(F.ws + WS_U + U_P);
    LAS float* Sb = (LAS float*)(F.lds + w * (32 * S5_SP * 4));
    GAS float* LOC = (GAS float*)(F.ws + WS_LOC); const GAS float* SPREV = (const GAS float*)(F.ws + WS_SPREV); GAS bf16* S5Y = (GAS bf16*)(F.ws + WS_S5Y);
    __syncthreads();
    bf16x8 bfr[2][4], cfr[2][4]; f32x2 abv[2];
#pragma unroll
    for (int dir = 0; dir < 2; ++dir) { const int idx = (l * 2 + dir) * 16 + g;
        const GAS bf16* BbT = (const GAS bf16*)(F.ws + WS_S5T + S5_BBT) + (size_t)idx * 2048; const GAS bf16* CmT = (const GAS bf16*)(F.ws + WS_S5T + S5_CMT) + (size_t)idx * 2048;
#pragma unroll
        for (int nt = 0; nt < 4; ++nt) { bfr[dir][nt] = *(const GAS bf16x8*)(BbT + (32 * nt + ql) * 16 + 8 * half); if (MODE == 1) cfr[dir][nt] = *(const GAS bf16x8*)(CmT + (lane & 15) * 128 + 32 * nt + 8 * (lane >> 4)); }
        abv[dir] = ((const GAS f32x2*)(F.ws + WS_S5T + S5_AB))[idx * 64 + lane]; }
    int cid = 68 * hf + w;
    bf16x8 uf_n = *(const GAS bf16x8*)(P + (size_t)(s5_row0(cid, b) + ql) * INW + V_END + 16 * g + 8 * half);
    const int c0 = 4 * (lane >> 4);
    f32x4 dsk = (f32x4){0.f, 0.f, 0.f, 0.f}; float sp_n[2][2] = {{0.f, 0.f}, {0.f, 0.f}}; u32x2 uu_n[2] = {(u32x2){0u, 0u}, (u32x2){0u, 0u}};
#define S5_PREFETCH(cd) do { _Pragma("unroll") for (int d_ = 0; d_ < 2; ++d_) { const GAS float* q_ = SPREV + s5_state_off((cd), b, d_, g); sp_n[d_][0] = q_[lane]; sp_n[d_][1] = q_[64 + lane]; } \
        _Pragma("unroll") for (int n_ = 0; n_ < 2; ++n_) uu_n[n_] = *(const GAS u32x2*)(P + (size_t)(s5_row0((cd), b) + 16 * n_ + (lane & 15)) * INW + V_END + 16 * g + c0); } while (0)
    if (MODE == 1) { dsk = *(const GAS f32x4*)(F.in[I_S5D + F.z] + l * 256 + 16 * g + c0); S5_PREFETCH(cid); }
#pragma unroll 1
    for (; cid < 68 * hf + 68; cid += 8) {
        const int row0 = s5_row0(cid, b);
        const bool skip_out = (MODE == 1) && (l == DEPTH - 1) && (cid < 8);
        const bf16x8 uf = uf_n;
        const float sp_c[2][2] = {{sp_n[0][0], sp_n[0][1]}, {sp_n[1][0], sp_n[1][1]}}; const u32x2 uu_c[2] = {uu_n[0], uu_n[1]};
        if (cid + 8 < 68 * hf + 68) { uf_n = *(const GAS bf16x8*)(P + (size_t)(s5_row0(cid + 8, b) + ql) * INW + V_END + 16 * g + 8 * half);
            if (MODE == 1) S5_PREFETCH(cid + 8); }
        f32x4 yacc[2] = {zero4(), zero4()};
#pragma unroll
        for (int dir = 0; dir < 2; ++dir) { if (skip_out) continue;
#pragma unroll
            for (int nt = 0; nt < 4; ++nt) {
                f32x16 acc = (f32x16){0.f, 0.f, 0.f, 0.f, 0.f, 0.f, 0.f, 0.f, 0.f, 0.f, 0.f, 0.f, 0.f, 0.f, 0.f, 0.f};
                acc = __builtin_amdgcn_mfma_f32_32x32x16_bf16(uf, bfr[dir][nt], acc, 0, 0, 0);
                asm volatile("s_nop 15\n\ts_nop 3" : "+v"(acc));
                u32x4 w0, w1;
                w0.x = pk2(acc[0], acc[1]); w0.y = pk2(acc[2], acc[3]); w0.z = pk2(acc[4], acc[5]); w0.w = pk2(acc[6], acc[7]);
                w1.x = pk2(acc[8], acc[9]); w1.y = pk2(acc[10], acc[11]); w1.z = pk2(acc[12], acc[13]); w1.w = pk2(acc[14], acc[15]);
                LAS unsigned char* bq = (LAS unsigned char*)Sb + (32 * nt + ql) * 80 + 32 * half;
                *(LAS u32x4*)bq = w0; *(LAS u32x4*)(bq + 16) = w1; }
            LDS_WAIT(); __builtin_amdgcn_wave_barrier();
            { const f32x2 ab = abv[dir]; float sr = 0.f, si = 0.f;
              if (MODE == 1) { sr = sp_c[dir][0]; si = sp_c[dir][1]; }
              float br[32], bi[32];
              { u32x4 qr[4], qi[4];
#pragma unroll
                for (int c = 0; c < 4; ++c) { qr[c] = *(const LAS u32x4*)((const LAS unsigned char*)Sb + lane * 80 + 16 * c); qi[c] = *(const LAS u32x4*)((const LAS unsigned char*)Sb + (64 + lane) * 80 + 16 * c); }
#pragma unroll
                for (int k = 0; k < 32; ++k) { const int pos = 16 * ((k >> 2) & 1) + 4 * (k >> 3) + (k & 3), d = pos >> 1; const unsigned wr_ = qr[d >> 2][d & 3], wi_ = qi[d >> 2][d & 3];
                    br[k] = (pos & 1) ? bfhi(wr_) : bflo(wr_); bi[k] = (pos & 1) ? bfhi(wi_) : bflo(wi_); } }
              if (dir == 0) {
#pragma unroll
                  for (int k = 0; k < 32; ++k) { cmac(sr, si, ab.x, ab.y, br[k], bi[k]); br[k] = sr; bi[k] = si; }
              } else {
#pragma unroll
                  for (int k = 31; k >= 0; --k) { cmac(sr, si, ab.x, ab.y, br[k], bi[k]); br[k] = sr; bi[k] = si; }
              }
              if (MODE == 1) {
#pragma unroll
                  for (int c = 0; c < 4; ++c) { u32x4 wr_, wi_;
#pragma unroll
                      for (int e = 0; e < 4; ++e) { const int m = 4 * c + e, k = 8 * ((m >> 1) & 3) + 4 * (m >> 3) + 2 * (m & 1); wr_[e] = pk2(br[k], br[k + 1]); wi_[e] = pk2(bi[k], bi[k + 1]); }
                      *(LAS u32x4*)((LAS unsigned char*)Sb + lane * 80 + 16 * c) = wr_; *(LAS u32x4*)((LAS unsigned char*)Sb + (64 + lane) * 80 + 16 * c) = wi_; } }
              if (MODE == 0) { GAS float* lp = LOC + s5_state_off(cid, b, dir, g); lp[lane] = sr; lp[64 + lane] = si; } }
            if (MODE == 1) {
                LDS_WAIT(); __builtin_amdgcn_wave_barrier();
                const int kq = lane >> 4, gq = (lane & 15) >> 2, gp = lane & 3;
                const LAS unsigned char* tb = (const LAS unsigned char*)Sb + (8 * kq + gq) * 80 + 32 * (gp & 1) + 8 * (gp >> 1);
#pragma unroll
                for (int ks = 0; ks < 4; ++ks) { const bf16x8 cf = cfr[dir][ks];
#pragma unroll
                    for (int ntk = 0; ntk < 2; ++ntk) { const LAS unsigned char* tp = tb + (32 * ks) * 80 + 16 * ntk;
                        union { bf16x8 v; s16x4 h[2]; } sf;
                        sf.h[0] = __builtin_amdgcn_ds_read_tr16_b64_v4i16((LAS s16x4*)tp); sf.h[1] = __builtin_amdgcn_ds_read_tr16_b64_v4i16((LAS s16x4*)(tp + 4 * 80));
                        yacc[ntk] = __builtin_amdgcn_mfma_f32_16x16x32_bf16(cf, sf.v, yacc[ntk], 0, 0, 0); } }
                LDS_WAIT(); __builtin_amdgcn_wave_barrier();
            }
        }
        if (MODE == 1 && !skip_out) {
#pragma unroll
            for (int ntk = 0; ntk < 2; ++ntk) { const int row = row0 + 16 * ntk + (lane & 15);
                const u32x2 uu = uu_c[ntk];
                const float y0 = yacc[ntk][0] + bflo(uu.x) * dsk[0], y1 = yacc[ntk][1] + bfhi(uu.x) * dsk[1], y2 = yacc[ntk][2] + bflo(uu.y) * dsk[2], y3 = yacc[ntk][3] + bfhi(uu.y) * dsk[3];
                u32x2 o; o.x = pk2(y0, y1); o.y = pk2(y2, y3); *(GAS u32x2*)(S5Y + (size_t)row * 256 + 16 * g + c0) = o; }
        }
    }
#undef S5_PREFETCH
    __syncthreads();
}
__device__ __forceinline__ void unit_s5_carry(Frame& F, int l, int u) {
    LAUNDER(F);
    const int gt = u * 512 + F.tid, p = gt & 63, g = (gt >> 6) & 15, dir = (gt >> 10) & 1, b = gt >> 11;
    const GAS float* LOC = (const GAS float*)(F.ws + WS_LOC); GAS float* SPREV = (GAS float*)(F.ws + WS_SPREV);
    const f32x2 a32 = ((const GAS f32x2*)(F.ws + WS_S5T + S5_A32))[((l * 2 + dir) * 16 + g) * 64 + p];
    float sr = 0.f, si = 0.f;
#pragma unroll 1
    for (int k0 = 0; k0 < NCH; k0 += 8) {
        float lr[8], li[8];
#pragma unroll
        for (int j = 0; j < 8; ++j) { const int k = k0 + j, cid = dir == 0 ? k : (k < 8 ? 7 - k : 143 - k); const GAS float* lp = LOC + s5_state_off(cid, b, dir, g); lr[j] = lp[p]; li[j] = lp[64 + p]; }
#pragma unroll
        for (int j = 0; j < 8; ++j) { const int k = k0 + j, cid = dir == 0 ? k : (k < 8 ? 7 - k : 143 - k); GAS float* sp = SPREV + s5_state_off(cid, b, dir, g); sp[p] = sr; sp[64 + p] = si;
            cmac(sr, si, a32.x, a32.y, lr[j], li[j]); }
    }
}

constexpr int MX_P = 1032, GA_P = 264, MX_BYTES = 32 * MX_P * 2  , GA_OFF = MX_BYTES;
__device__ __forceinline__ float gelu_tanh(float x) { const float t = 0.7978845608028654f * (x + 0.044715f * x * x * x); const float e = __expf(2.0f * t); return 0.5f * x * (1.0f + (1.0f - 2.0f * __builtin_amdgcn_rcpf(e + 1.0f))); }
__device__ __forceinline__ void unit_mixfinal(Frame& F, int l, int u) {
    LAUNDER(F);
    const int row0 = u * 32, lane = F.lane, w = F.wave;
    LAS bf16* MX = (LAS bf16*)F.lds; LAS bf16* GA = (LAS bf16*)(F.lds + GA_OFF);
    const GAS bf16* ATT = (const GAS bf16*)(F.ws + WS_U + U_ATT); const GAS bf16* S5Y = (const GAS bf16*)(F.ws + WS_S5Y);
    bf16x8 wfr[8][2]; f32x4 gbv[2];
    { const GAS bf16* GLUT = (const GAS bf16*)(F.ws + WS_S5T + S5_GLUT) + (size_t)l * 256 * 256;
#pragma unroll
      for (int ks = 0; ks < 8; ++ks)
#pragma unroll
          for (int nt = 0; nt < 2; ++nt) wfr[ks][nt] = *(const GAS bf16x8*)(GLUT + (size_t)(32 * w + 16 * nt + (lane & 15)) * 256 + 32 * ks + 8 * (lane >> 4));
#pragma unroll
      for (int nt = 0; nt < 2; ++nt) gbv[nt] = *(const GAS f32x4*)(F.in[I_GLUB + F.z] + l * 256 + 32 * w + 16 * nt + 4 * (lane >> 4)); }
    __syncthreads();
    const bool isctx = row0 < NCTX; const int bq = isctx ? 0 : (row0 - NCTX) / SEQ, t0 = isctx ? 0 : (row0 - NCTX) % SEQ;
    u32x4 hyv[2], atv[4], s5v[2];
#pragma unroll
    for (int k = 0; k < 2; ++k) { const int i = F.tid + 512 * k;
        if (isctx) { const int r = i >> 5, c = i & 31; hyv[k] = *(const GAS u32x4*)((const GAS bf16*)(F.ws + WS_HYC) + (size_t)(row0 + r) * 256 + 8 * c); }
        else { const int ch = i >> 2, part = i & 3; hyv[k] = *(const GAS u32x4*)((const GAS bf16*)(F.ws + WS_U + U_HYT) + ((size_t)ch * NB + bq) * SEQ + t0 + 8 * part); }
        { const int r = i >> 5, c = i & 31; s5v[k] = *(const GAS u32x4*)(S5Y + (size_t)(row0 + r) * 256 + 8 * c); } }
#pragma unroll
    for (int k = 0; k < 4; ++k) { const int i = F.tid + 512 * k, r = i >> 6, c = i & 63; atv[k] = *(const GAS u32x4*)(ATT + (size_t)(row0 + r) * 512 + 8 * c); }
#pragma unroll
    for (int k = 0; k < 2; ++k) { const int i = F.tid + 512 * k;
        if (isctx) { const int r = i >> 5, c = i & 31; *(LAS u32x4*)(MX + r * MX_P + 8 * c) = hyv[k]; }
        else { const int ch = i >> 2, part = i & 3; const unsigned vw[4] = {hyv[k].x, hyv[k].y, hyv[k].z, hyv[k].w};
#pragma unroll
            for (int j = 0; j < 4; ++j) { MX[(8 * part + 2 * j) * MX_P + ch] = (bf16)(vw[j] & 0xffffu); MX[(8 * part + 2 * j + 1) * MX_P + ch] = (bf16)(vw[j] >> 16); } }
        { const int r = i >> 5, c = i & 31; const u32x4 v = s5v[k];
          u32x4 o; o.x = pk2(gelu_tanh(bflo(v.x)), gelu_tanh(bfhi(v.x))); o.y = pk2(gelu_tanh(bflo(v.y)), gelu_tanh(bfhi(v.y))); o.z = pk2(gelu_tanh(bflo(v.z)), gelu_tanh(bfhi(v.z))); o.w = pk2(gelu_tanh(bflo(v.w)), gelu_tanh(bfhi(v.w)));
          *(LAS u32x4*)(GA + r * GA_P + 8 * c) = o; } }
#pragma unroll
    for (int k = 0; k < 4; ++k) { const int i = F.tid + 512 * k, r = i >> 6, c = i & 63; *(LAS u32x4*)(MX + r * MX_P + 256 + 8 * c) = atv[k]; }
    __syncthreads();
    { const int c16 = lane & 15, kq = lane >> 4;
      f32x4 acc[2][2];
#pragma unroll
      for (int mt = 0; mt < 2; ++mt)
#pragma unroll
          for (int nt = 0; nt < 2; ++nt) acc[mt][nt] = zero4();
#pragma unroll
      for (int ks = 0; ks < 8; ++ks) {
          bf16x8 wf[2], gf[2];
#pragma unroll
          for (int nt = 0; nt < 2; ++nt) wf[nt] = wfr[ks][nt];
#pragma unroll
          for (int mt = 0; mt < 2; ++mt) gf[mt] = *(const LAS bf16x8*)(GA + (16 * mt + c16) * GA_P + 32 * ks + 8 * kq);
#pragma unroll
          for (int mt = 0; mt < 2; ++mt)
#pragma unroll
              for (int nt = 0; nt < 2; ++nt) acc[mt][nt] = __builtin_amdgcn_mfma_f32_16x16x32_bf16(wf[nt], gf[mt], acc[mt][nt], 0, 0, 0); }
#pragma unroll
      for (int mt = 0; mt < 2; ++mt)
#pragma unroll
          for (int nt = 0; nt < 2; ++nt) { const int n0 = 32 * w + 16 * nt + 4 * kq, tok = 16 * mt + c16;
              const f32x4 gb = gbv[nt]; const u32x2 gg = *(const LAS u32x2*)(GA + tok * GA_P + n0);
              const float g0 = bflo(gg.x), g1 = bfhi(gg.x), g2 = bflo(gg.y), g3 = bfhi(gg.y);
              u32x2 o; o.x = pk2(g0 * __builtin_amdgcn_rcpf(1.0f + __expf(-(acc[mt][nt][0] + gb[0]))), g1 * __builtin_amdgcn_rcpf(1.0f + __expf(-(acc[mt][nt][1] + gb[1]))));
              o.y = pk2(g2 * __builtin_amdgcn_rcpf(1.0f + __expf(-(acc[mt][nt][2] + gb[2]))), g3 * __builtin_amdgcn_rcpf(1.0f + __expf(-(acc[mt][nt][3] + gb[3]))));
              *(LAS u32x2*)(MX + tok * MX_P + 768 + n0) = o; } }
    __syncthreads();
    { GAS bf16* MIXN = (GAS bf16*)(F.ws + WS_U + U_MIXN);
      const int c0 = lane < 32 ? 256 + 16 * lane : lane < 48 ? 16 * (lane - 32) : 768 + 16 * (lane - 48);
      const GAS float* gn = F.in[I_MIXG + F.z] + l * 1024 + c0;
      f32x4 gv[4];
#pragma unroll
      for (int j = 0; j < 4; ++j) gv[j] = *(const GAS f32x4*)(gn + 4 * j);
      float x[4][16], ss[4];
#pragma unroll
      for (int k = 0; k < 4; ++k) { const int tok = 4 * w + k; const u32x4 a = *(const LAS u32x4*)(MX + tok * MX_P + c0), c = *(const LAS u32x4*)(MX + tok * MX_P + c0 + 8);
          const unsigned ww[8] = {a.x, a.y, a.z, a.w, c.x, c.y, c.z, c.w}; float s_ = 0.f;
#pragma unroll
          for (int j = 0; j < 8; ++j) { x[k][2 * j] = bflo(ww[j]); x[k][2 * j + 1] = bfhi(ww[j]); s_ += x[k][2 * j] * x[k][2 * j] + x[k][2 * j + 1] * x[k][2 * j + 1]; }
          ss[k] = s_; }
#pragma unroll
      for (int o = 1; o < 16; o <<= 1)
#pragma unroll
          for (int k = 0; k < 4; ++k) ss[k] += lane_xor(ss[k], lane, o);
#pragma unroll
      for (int k = 0; k < 4; ++k) { const float t = lane_xor(ss[k], lane, 16); ss[k] += lane < 32 ? t : 0.f; }
      const float invw = lane < 32 ? 1.0f / 512.0f : 1.0f / 256.0f;
#pragma unroll
      for (int k = 0; k < 4; ++k) { const int tok = 4 * w + k; const float rs = 1.0f / sqrtf(ss[k] * invw + EPS);
          u32x4 o8;
          o8.x = pk4_fp8(x[k][0] * rs * gv[0][0], x[k][1] * rs * gv[0][1], x[k][2] * rs * gv[0][2], x[k][3] * rs * gv[0][3]);
          o8.y = pk4_fp8(x[k][4] * rs * gv[1][0], x[k][5] * rs * gv[1][1], x[k][6] * rs * gv[1][2], x[k][7] * rs * gv[1][3]);
          o8.z = pk4_fp8(x[k][8] * rs * gv[2][0], x[k][9] * rs * gv[2][1], x[k][10] * rs * gv[2][2], x[k][11] * rs * gv[2][3]);
          o8.w = pk4_fp8(x[k][12] * rs * gv[3][0], x[k][13] * rs * gv[3][1], x[k][14] * rs * gv[3][2], x[k][15] * rs * gv[3][3]);
          *(GAS u32x4*)((GAS unsigned char*)MIXN + (size_t)(row0 + tok) * 1024 + c0) = o8; } }
    __syncthreads();
}

constexpr int PH_PER_LAYER = 11, PH_L0 = 2, PH_FINAL = PH_L0 + PH_PER_LAYER * DEPTH, NPH = PH_FINAL + 1;

__global__ void __launch_bounds__(512, 2) fwd_kernel(Params p) {
    extern __shared__ __attribute__((aligned(16))) unsigned char lds_raw[];
    Frame F;
    F.lds = (LAS unsigned char*)lds_raw; F.ws = p.ws; F.ctl = (GAS unsigned*)(p.ws + WS_CTL); F.in = p.in; F.out = p.out;
    F.tid = threadIdx.x; F.lane = F.tid & 63; F.wave = __builtin_amdgcn_readfirstlane(F.tid >> 6); F.G = gridDim.x; F.bid = blockIdx.x; F.z = 0;
    if (F.tid < 16) ((volatile LAS unsigned*)(F.lds + LDS_MISC))[F.tid] = 0u;
    __syncthreads();
#if MK_ONE_LAUNCH
    XcdBarrier bar = xcd_barrier_post((unsigned*)(F.ctl + CW_BAR), (volatile LAS unsigned*)(F.lds + LDS_MISC));
#ifndef PROBE_STAMPS
#define PROBE_STAMPS 0
#endif
#ifndef SEL1
#define SEL1 3
#endif
#ifndef SEL2
#define SEL2 4
#endif
#define STAMP(k) do { if (PROBE_STAMPS && F.bid == 0 && F.tid == 0) ((GAS unsigned long long*)(F.ctl + 80000))[(k)] = __builtin_amdgcn_s_memrealtime(); } while (0)
#define SEAM(k) do { if (p.ph_lo <= (k) && (k) + 1 < p.ph_hi) xcd_barrier(bar); STAMP((k) + 1); } while (0)
#else
#define SEAM(k) do { } while (0)
#endif
#ifndef PHMASK
#define PHMASK 0xFFFFFFFFu
#endif
#define IN(k) (p.ph_lo <= (k) && (k) < p.ph_hi)
#ifndef REP_PRO
#define REP_PRO 1
#endif
#ifndef REP_M1
#define REP_M1 1
#endif
#ifndef REP_M2
#define REP_M2 1
#endif
#ifndef REP_M3
#define REP_M3 1
#endif
#ifndef REP_MIX
#define REP_MIX 1
#endif
#ifndef REP_GATHER
#define REP_GATHER 1
#endif
#ifndef REP_GIN
#define REP_GIN 1
#endif
#ifndef REP_UP
#define REP_UP 1
#endif
#ifndef REP_DOWN
#define REP_DOWN 1
#endif
#ifndef STATIC_Q
#define STATIC_Q 0
#endif
#define ON(b) (((PHMASK) >> (b)) & 1u)
#define TAIL_WCONV(total_units) do { if (l + 1 < DEPTH) { const int tot_ = (total_units), rounds_ = (tot_ + F.G - 1) / F.G, mine_ = (tot_ > F.bid) ? (tot_ - F.bid + F.G - 1) / F.G : 0; \
        if (mine_ < rounds_) { for (int k_ = 0; k_ < 2; ++k_) { const int u_ = wq_next(F, 16 + l + 1); if (u_ >= 768) break; unit_wconv(F, l + 1, u_); } } } } while (0)
#define FRESH() do { asm volatile("s_mov_b32 %0, 0" : "=s"(F.z)); asm volatile("" : "+s"(F.ws), "+s"(F.lds), "+v"(F.tid), "+v"(F.lane)); F.ctl = (GAS unsigned*)(F.ws + WS_CTL); } while (0)
    const int lo = p.ph_lo, hi = p.ph_hi; (void)lo; (void)hi;
    unsigned long long ut0_ = 0; (void)ut0_;
#define UT0() do { if (PROBE_STAMPS) ut0_ = __builtin_amdgcn_s_memrealtime(); } while (0)
#define UT1(k) do { if (PROBE_STAMPS) { const unsigned long long d_ = __builtin_amdgcn_s_memrealtime() - ut0_; if (F.bid == 0 && F.tid == 0) { GAS unsigned long long* s_ = (GAS unsigned long long*)(F.ctl + 80000); s_[100 + 2 * (k)] += d_; s_[101 + 2 * (k)] += 1; } } } while (0)

    STAMP(0);
    if (ON(11) && IN(0)) for (int rep = 0; rep < REP_PRO; ++rep) { FRESH(); ph_prologue0(F); }
    SEAM(0);
    if (ON(12) && IN(1)) for (int rep = 0; rep < REP_PRO; ++rep) { FRESH(); ph_prologue1(F); }
    SEAM(1);
    { constexpr int l = 0;
        const int pb = PH_L0 + PH_PER_LAYER * l;
        if (ON(0) && IN(pb + 0)) { FRESH(); ph_norm1(F, l); }
        SEAM(pb + 0);
        if (ON(1) && IN(pb + 1)) for (int rep = 0; rep < REP_GIN; ++rep) { FRESH();
            SchedStd S; S.so.init(NTOK, INW, F.G, F.bid); S.row_off = 0; S.A = (const GAS char*)(F.ws + WS_H); S.Bt = (const GAS char*)(F.ws + WS_WIN) + (size_t)l * INW * D * 2;
            EpiP E{(GAS bf16*)(F.ws + WS_U + U_P), INW};
            pg8::gemm_phase<EpiP, SchedStd>(F.lds, S, E, F.tid);
            TAIL_WCONV((NTOK / 256) * (INW / 256));
        }
        SEAM(pb + 1);
        if (ON(2) && IN(pb + 2)) for (int rep = 0; rep < REP_M1; ++rep) { FRESH();
            constexpr int N0 = 544, N1 = N0 + 768, N2 = N1 + 256, N3 = N2;
            for (int u_ = F.bid;; u_ += F.G) { __syncthreads(); const int u = STATIC_Q ? u_ : wq_next(F, l * 4 + 0); if (u >= N3) break;
                if (u < N0) unit_prep_qk(F, u);
                else if (u < N1) unit_hy_prep(F, l, u - N0);
                else unit_s5<0>(F, l, u - N1); }
        }
        SEAM(pb + 2);
        if (ON(3) && IN(pb + 3)) for (int rep = 0; rep < REP_M2; ++rep) { FRESH();
            constexpr int N0 = 32, N1 = N0 + 256, N2 = N1 + 1088, N3 = N2 + 256;
            for (int u_ = F.bid;; u_ += F.G) { __syncthreads(); const int u = STATIC_Q ? u_ : wq_next(F, l * 4 + 1); if (u >= N3) break;
                if (u < N0) unit_s5_carry(F, l, u);
                else if (u < N1) { UT0(); unit_hy_conv(F, l, 0, u - N0); UT1(1); }
                else if (u < N2) { if (!(l == DEPTH - 1 && u - N1 >= 1024)) { UT0(); unit_attn(F, l, u - N1); UT1(0); } }
                else if (l < DEPTH - 1) unit_hy_ctx(F, l, u - N2); }
        }
        SEAM(pb + 3);
        if (ON(4) && IN(pb + 4)) for (int rep = 0; rep < REP_M3; ++rep) { FRESH();
            constexpr int N0 = 256, N1 = N0 + 256;
            for (int u_ = F.bid;; u_ += F.G) { __syncthreads(); const int u = STATIC_Q ? u_ : wq_next(F, l * 4 + 2); if (u >= N1) break;
                if (u < N0) { UT0(); unit_hy_conv(F, l, 1, u); UT1(2); }
                else { UT0(); unit_s5<1>(F, l, u - N0); UT1(3); } }
            for (;;) { const int u = wq_next(F, 16 + l); if (u >= 768) break; unit_wconv(F, l, u); }
        }
        SEAM(pb + 4);
        if (ON(5) && IN(pb + 5)) for (int rep = 0; rep < REP_MIX; ++rep) { FRESH(); for (;;) { const int u = wq_next(F, l * 4 + 3) + ((l == DEPTH - 1) ? NCTX / 32 : 0); if (u >= NTOK / 32) break; unit_mixfinal(F, l, u); } }
        SEAM(pb + 5);
        if (ON(6) && IN(pb + 6)) { FRESH();
            const int roff = (l == DEPTH - 1) ? NCTX : 0;
            SchedStd8 S; S.so.init(NTOK - roff, D, F.G, F.bid); S.row_off = roff; S.A = (const GAS char*)(F.ws + WS_U + U_MIXN); S.Bt = (const GAS char*)(F.ws + WS_WOUT) + (size_t)l * D * D;
            EpiOut E{(GAS bf16*)(F.ws + WS_U + U_DELTA), (const GAS float*)(F.ws + WS_MOD) + (size_t)l * 9 * 6144};
            pg8::gemm_phase<EpiOut, SchedStd8>(F.lds, S, E, F.tid);
            TAIL_WCONV(((NTOK - roff) / 256) * (D / 256));
        }
        SEAM(pb + 6);
        if (ON(7) && IN(pb + 7)) { FRESH(); ph_norm2_router(F, l); }
        SEAM(pb + 7);
        if (ON(8) && IN(pb + 8)) { }
        if (ON(9) && IN(pb + 9)) for (int rep = 0; rep < REP_UP; ++rep) { FRESH();
            volatile LAS int* tab = (volatile LAS int*)(F.lds + LDS_BYTES - 512);
            moe_tables(F, l, tab);
            {
              const GAS unsigned* ELIST = (const GAS unsigned*)(F.ws + WS_ELIST); LAS unsigned* gt = (LAS unsigned*)(F.lds + pg8::GATHER_TAB);
              const int total = tab[16] * 8;
              for (int it = F.tid; it < 16 * 256; it += 512) { const int k = it >> 8, r = it & 255, L = k * F.G + F.bid;
                  if (L < total) { const int mg = L >> 3; int e = 0; for (int q = 1; q < 16; ++q) e += (mg >= tab[q]) ? 1 : 0; const int pos = 256 * (mg - tab[e]) + r;
                      gt[it] = pos < tab[32 + e] ? (ELIST[(size_t)e * ECAP + pos] >> 1) * 1024u : 0u; } }
              __syncthreads(); }
            SchedMoe<0> S; S.tab = tab; S.G = F.G; S.c = F.bid; S.A = (const GAS char*)(F.ws + WS_H); S.W0 = (const GAS char*)(F.ws + wmoe_off(l)); S.W1 = (const GAS char*)(F.ws + wmoe_off(l) + 32 * MiB);
            EpiUp E{(GAS unsigned char*)(F.ws + WS_U + U_ACT)};
            pg8::gemm_phase<EpiUp, SchedMoe<0>>(F.lds, S, E, F.tid);
            TAIL_WCONV(tab[16] * 8);
        }
        SEAM(pb + 9);
        if (ON(10) && IN(pb + 10)) for (int rep = 0; rep < REP_DOWN; ++rep) { FRESH();
            volatile LAS int* tab = (volatile LAS int*)(F.lds + LDS_BYTES - 512);
            moe_tables(F, l, tab);
            SchedMoe<1> S; S.tab = tab; S.G = F.G; S.c = F.bid; S.A = (const GAS char*)(F.ws + WS_U + U_ACT); S.W0 = (const GAS char*)(F.ws + wmoe_off(l) + 64 * MiB); S.W1 = nullptr;
            EpiDown E{(GAS bf16*)(F.ws + WS_U + U_YB), (const GAS unsigned*)(F.ws + WS_ELIST), (const GAS float*)(F.ws + WS_WLIST)};
            pg8::gemm_phase<EpiDown, SchedMoe<1>>(F.lds, S, E, F.tid);
            TAIL_WCONV(tab[16] * 4);
        }
        SEAM(pb + 10);
        }
    { constexpr int l = 1;
        const int pb = PH_L0 + PH_PER_LAYER * l;
        if (ON(0) && IN(pb + 0)) { FRESH(); ph_norm1(F, l); }
        SEAM(pb + 0);
        if (ON(1) && IN(pb + 1)) for (int rep = 0; rep < REP_GIN; ++rep) { FRESH();
            SchedStd S; S.so.init(NTOK, INW, F.G, F.bid); S.row_off = 0; S.A = (const GAS char*)(F.ws + WS_H); S.Bt = (const GAS char*)(F.ws + WS_WIN) + (size_t)l * INW * D * 2;
            EpiP E{(GAS bf16*)(F.ws + WS_U + U_P), INW};
            pg8::gemm_phase<EpiP, SchedStd>(F.lds, S, E, F.tid);
            TAIL_WCONV((NTOK / 256) * (INW / 256));
        }
        SEAM(pb + 1);
        if (ON(2) && IN(pb + 2)) for (int rep = 0; rep < REP_M1; ++rep) { FRESH();
            constexpr int N0 = 544, N1 = N0 + 768, N2 = N1 + 256, N3 = N2;
            for (int u_ = F.bid;; u_ += F.G) { __syncthreads(); const int u = STATIC_Q ? u_ : wq_next(F, l * 4 + 0); if (u >= N3) break;
                if (u < N0) unit_prep_qk(F, u);
                else if (u < N1) unit_hy_prep(F, l, u - N0);
                else unit_s5<0>(F, l, u - N1); }
        }
        SEAM(pb + 2);
        if (ON(3) && IN(pb + 3)) for (int rep = 0; rep < REP_M2; ++rep) { FRESH();
            constexpr int N0 = 32, N1 = N0 + 256, N2 = N1 + 1088, N3 = N2 + 256;
            for (int u_ = F.bid;; u_ += F.G) { __syncthreads(); const int u = STATIC_Q ? u_ : wq_next(F, l * 4 + 1); if (u >= N3) break;
                if (u < N0) unit_s5_carry(F, l, u);
                else if (u < N1) { UT0(); unit_hy_conv(F, l, 0, u - N0); UT1(1); }
                else if (u < N2) { if (!(l == DEPTH - 1 && u - N1 >= 1024)) { UT0(); unit_attn(F, l, u - N1); UT1(0); } }
                else if (l < DEPTH - 1) unit_hy_ctx(F, l, u - N2); }
        }
        SEAM(pb + 3);
        if (ON(4) && IN(pb + 4)) for (int rep = 0; rep < REP_M3; ++rep) { FRESH();
            constexpr int N0 = 256, N1 = N0 + 256;
            for (int u_ = F.bid;; u_ += F.G) { __syncthreads(); const int u = STATIC_Q ? u_ : wq_next(F, l * 4 + 2); if (u >= N1) break;
                if (u < N0) { UT0(); unit_hy_conv(F, l, 1, u); UT1(2); }
                else { UT0(); unit_s5<1>(F, l, u - N0); UT1(3); } }
            for (;;) { const int u = wq_next(F, 16 + l); if (u >= 768) break; unit_wconv(F, l, u); }
        }
        SEAM(pb + 4);
        if (ON(5) && IN(pb + 5)) for (int rep = 0; rep < REP_MIX; ++rep) { FRESH(); for (;;) { const int u = wq_next(F, l * 4 + 3) + ((l == DEPTH - 1) ? NCTX / 32 : 0); if (u >= NTOK / 32) break; unit_mixfinal(F, l, u); } }
        SEAM(pb + 5);
        if (ON(6) && IN(pb + 6)) { FRESH();
            const int roff = (l == DEPTH - 1) ? NCTX : 0;
            SchedStd8 S; S.so.init(NTOK - roff, D, F.G, F.bid); S.row_off = roff; S.A = (const GAS char*)(F.ws + WS_U + U_MIXN); S.Bt = (const GAS char*)(F.ws + WS_WOUT) + (size_t)l * D * D;
            EpiOut E{(GAS bf16*)(F.ws + WS_U + U_DELTA), (const GAS float*)(F.ws + WS_MOD) + (size_t)l * 9 * 6144};
            pg8::gemm_phase<EpiOut, SchedStd8>(F.lds, S, E, F.tid);
            TAIL_WCONV(((NTOK - roff) / 256) * (D / 256));
        }
        SEAM(pb + 6);
        if (ON(7) && IN(pb + 7)) { FRESH(); ph_norm2_router(F, l); }
        SEAM(pb + 7);
        if (ON(8) && IN(pb + 8)) { }
        if (ON(9) && IN(pb + 9)) for (int rep = 0; rep < REP_UP; ++rep) { FRESH();
            volatile LAS int* tab = (volatile LAS int*)(F.lds + LDS_BYTES - 512);
            moe_tables(F, l, tab);
            {
              const GAS unsigned* ELIST = (const GAS unsigned*)(F.ws + WS_ELIST); LAS unsigned* gt = (LAS unsigned*)(F.lds + pg8::GATHER_TAB);
              const int total = tab[16] * 8;
              for (int it = F.tid; it < 16 * 256; it += 512) { const int k = it >> 8, r = it & 255, L = k * F.G + F.bid;
                  if (L < total) { const int mg = L >> 3; int e = 0; for (int q = 1; q < 16; ++q) e += (mg >= tab[q]) ? 1 : 0; const int pos = 256 * (mg - tab[e]) + r;
                      gt[it] = pos < tab[32 + e] ? (ELIST[(size_t)e * ECAP + pos] >> 1) * 1024u : 0u; } }
              __syncthreads(); }
            SchedMoe<0> S; S.tab = tab; S.G = F.G; S.c = F.bid; S.A = (const GAS char*)(F.ws + WS_H); S.W0 = (const GAS char*)(F.ws + wmoe_off(l)); S.W1 = (const GAS char*)(F.ws + wmoe_off(l) + 32 * MiB);
            EpiUp E{(GAS unsigned char*)(F.ws + WS_U + U_ACT)};
            pg8::gemm_phase<EpiUp, SchedMoe<0>>(F.lds, S, E, F.tid);
            TAIL_WCONV(tab[16] * 8);
        }
        SEAM(pb + 9);
        if (ON(10) && IN(pb + 10)) for (int rep = 0; rep < REP_DOWN; ++rep) { FRESH();
            volatile LAS int* tab = (volatile LAS int*)(F.lds + LDS_BYTES - 512);
            moe_tables(F, l, tab);
            SchedMoe<1> S; S.tab = tab; S.G = F.G; S.c = F.bid; S.A = (const GAS char*)(F.ws + WS_U + U_ACT); S.W0 = (const GAS char*)(F.ws + wmoe_off(l) + 64 * MiB); S.W1 = nullptr;
            EpiDown E{(GAS bf16*)(F.ws + WS_U + U_YB), (const GAS unsigned*)(F.ws + WS_ELIST), (const GAS float*)(F.ws + WS_WLIST)};
            pg8::gemm_phase<EpiDown, SchedMoe<1>>(F.lds, S, E, F.tid);
            TAIL_WCONV(tab[16] * 4);
        }
        SEAM(pb + 10);
        }
    { constexpr int l = 2;
        const int pb = PH_L0 + PH_PER_LAYER * l;
        if (ON(0) && IN(pb + 0)) { FRESH(); ph_norm1(F, l); }
        SEAM(pb + 0);
        if (ON(1) && IN(pb + 1)) for (int rep = 0; rep < REP_GIN; ++rep) { FRESH();
            SchedStd S; S.so.init(NTOK, INW, F.G, F.bid); S.row_off = 0; S.A = (const GAS char*)(F.ws + WS_H); S.Bt = (const GAS char*)(F.ws + WS_WIN) + (size_t)l * INW * D * 2;
            EpiP E{(GAS bf16*)(F.ws + WS_U + U_P), INW};
            pg8::gemm_phase<EpiP, SchedStd>(F.lds, S, E, F.tid);
            TAIL_WCONV((NTOK / 256) * (INW / 256));
        }
        SEAM(pb + 1);
        if (ON(2) && IN(pb + 2)) for (int rep = 0; rep < REP_M1; ++rep) { FRESH();
            constexpr int N0 = 544, N1 = N0 + 768, N2 = N1 + 256, N3 = N2;
            for (int u_ = F.bid;; u_ += F.G) { __syncthreads(); const int u = STATIC_Q ? u_ : wq_next(F, l * 4 + 0); if (u >= N3) break;
                if (u < N0) unit_prep_qk(F, u);
                else if (u < N1) unit_hy_prep(F, l, u - N0);
                else unit_s5<0>(F, l, u - N1); }
        }
        SEAM(pb + 2);
        if (ON(3) && IN(pb + 3)) for (int rep = 0; rep < REP_M2; ++rep) { FRESH();
            constexpr int N0 = 32, N1 = N0 + 256, N2 = N1 + 1088, N3 = N2 + 256;
            for (int u_ = F.bid;; u_ += F.G) { __syncthreads(); const int u = STATIC_Q ? u_ : wq_next(F, l * 4 + 1); if (u >= N3) break;
                if (u < N0) unit_s5_carry(F, l, u);
                else if (u < N1) { UT0(); unit_hy_conv(F, l, 0, u - N0); UT1(1); }
                else if (u < N2) { if (!(l == DEPTH - 1 && u - N1 >= 1024)) { UT0(); unit_attn(F, l, u - N1); UT1(0); } }
                else if (l < DEPTH - 1) unit_hy_ctx(F, l, u - N2); }
        }
        SEAM(pb + 3);
        if (ON(4) && IN(pb + 4)) for (int rep = 0; rep < REP_M3; ++rep) { FRESH();
            constexpr int N0 = 256, N1 = N0 + 256;
            for (int u_ = F.bid;; u_ += F.G) { __syncthreads(); const int u = STATIC_Q ? u_ : wq_next(F, l * 4 + 2); if (u >= N1) break;
                if (u < N0) { UT0(); unit_hy_conv(F, l, 1, u); UT1(2); }
                else { UT0(); unit_s5<1>(F, l, u - N0); UT1(3); } }
            for (;;) { const int u = wq_next(F, 16 + l); if (u >= 768) break; unit_wconv(F, l, u); }
        }
        SEAM(pb + 4);
        if (ON(5) && IN(pb + 5)) for (int rep = 0; rep < REP_MIX; ++rep) { FRESH(); for (;;) { const int u = wq_next(F, l * 4 + 3) + ((l == DEPTH - 1) ? NCTX / 32 : 0); if (u >= NTOK / 32) break; unit_mixfinal(F, l, u); } }
        SEAM(pb + 5);
        if (ON(6) && IN(pb + 6)) { FRESH();
            const int roff = (l == DEPTH - 1) ? NCTX : 0;
            SchedStd8 S; S.so.init(NTOK - roff, D, F.G, F.bid); S.row_off = roff; S.A = (const GAS char*)(F.ws + WS_U + U_MIXN); S.Bt = (const GAS char*)(F.ws + WS_WOUT) + (size_t)l * D * D;
            EpiOut E{(GAS bf16*)(F.ws + WS_U + U_DELTA), (const GAS float*)(F.ws + WS_MOD) + (size_t)l * 9 * 6144};
            pg8::gemm_phase<EpiOut, SchedStd8>(F.lds, S, E, F.tid);
            TAIL_WCONV(((NTOK - roff) / 256) * (D / 256));
        }
        SEAM(pb + 6);
        if (ON(7) && IN(pb + 7)) { FRESH(); ph_norm2_router(F, l); }
        SEAM(pb + 7);
        if (ON(8) && IN(pb + 8)) { }
        if (ON(9) && IN(pb + 9)) for (int rep = 0; rep < REP_UP; ++rep) { FRESH();
            volatile LAS int* tab = (volatile LAS int*)(F.lds + LDS_BYTES - 512);
            moe_tables(F, l, tab);
            {
              const GAS unsigned* ELIST = (const GAS unsigned*)(F.ws + WS_ELIST); LAS unsigned* gt = (LAS unsigned*)(F.lds + pg8::GATHER_TAB);
              const int total = tab[16] * 8;
              for (int it = F.tid; it < 16 * 256; it += 512) { const int k = it >> 8, r = it & 255, L = k * F.G + F.bid;
                  if (L < total) { const int mg = L >> 3; int e = 0; for (int q = 1; q < 16; ++q) e += (mg >= tab[q]) ? 1 : 0; const int pos = 256 * (mg - tab[e]) + r;
                      gt[it] = pos < tab[32 + e] ? (ELIST[(size_t)e * ECAP + pos] >> 1) * 1024u : 0u; } }
              __syncthreads(); }
            SchedMoe<0> S; S.tab = tab; S.G = F.G; S.c = F.bid; S.A = (const GAS char*)(F.ws + WS_H); S.W0 = (const GAS char*)(F.ws + wmoe_off(l)); S.W1 = (const GAS char*)(F.ws + wmoe_off(l) + 32 * MiB);
            EpiUp E{(GAS unsigned char*)(F.ws + WS_U + U_ACT)};
            pg8::gemm_phase<EpiUp, SchedMoe<0>>(F.lds, S, E, F.tid);
            TAIL_WCONV(tab[16] * 8);
        }
        SEAM(pb + 9);
        if (ON(10) && IN(pb + 10)) for (int rep = 0; rep < REP_DOWN; ++rep) { FRESH();
            volatile LAS int* tab = (volatile LAS int*)(F.lds + LDS_BYTES - 512);
            moe_tables(F, l, tab);
            SchedMoe<1> S; S.tab = tab; S.G = F.G; S.c = F.bid; S.A = (const GAS char*)(F.ws + WS_U + U_ACT); S.W0 = (const GAS char*)(F.ws + wmoe_off(l) + 64 * MiB); S.W1 = nullptr;
            EpiDown E{(GAS bf16*)(F.ws + WS_U + U_YB), (const GAS unsigned*)(F.ws + WS_ELIST), (const GAS float*)(F.ws + WS_WLIST)};
            pg8::gemm_phase<EpiDown, SchedMoe<1>>(F.lds, S, E, F.tid);
            TAIL_WCONV(tab[16] * 4);
        }
        SEAM(pb + 10);
        }
    { constexpr int l = 3;
        const int pb = PH_L0 + PH_PER_LAYER * l;
        if (ON(0) && IN(pb + 0)) { FRESH(); ph_norm1(F, l); }
        SEAM(pb + 0);
        if (ON(1) && IN(pb + 1)) for (int rep = 0; rep < REP_GIN; ++rep) { FRESH();
            SchedStd S; S.so.init(NTOK, INW, F.G, F.bid); S.row_off = 0; S.A = (const GAS char*)(F.ws + WS_H); S.Bt = (const GAS char*)(F.ws + WS_WIN) + (size_t)l * INW * D * 2;
            EpiP E{(GAS bf16*)(F.ws + WS_U + U_P), INW};
            pg8::gemm_phase<EpiP, SchedStd>(F.lds, S, E, F.tid);
            TAIL_WCONV((NTOK / 256) * (INW / 256));
        }
        SEAM(pb + 1);
        if (ON(2) && IN(pb + 2)) for (int rep = 0; rep < REP_M1; ++rep) { FRESH();
            constexpr int N0 = 544, N1 = N0 + 768, N2 = N1 + 256, N3 = N2;
            for (int u_ = F.bid;; u_ += F.G) { __syncthreads(); const int u = STATIC_Q ? u_ : wq_next(F, l * 4 + 0); if (u >= N3) break;
                if (u < N0) unit_prep_qk(F, u);
                else if (u < N1) unit_hy_prep(F, l, u - N0);
                else unit_s5<0>(F, l, u - N1); }
        }
        SEAM(pb + 2);
        if (ON(3) && IN(pb + 3)) for (int rep = 0; rep < REP_M2; ++rep) { FRESH();
            constexpr int N0 = 32, N1 = N0 + 256, N2 = N1 + 1088, N3 = N2 + 256;
            for (int u_ = F.bid;; u_ += F.G) { __syncthreads(); const int u = STATIC_Q ? u_ : wq_next(F, l * 4 + 1); if (u >= N3) break;
                if (u < N0) unit_s5_carry(F, l, u);
                else if (u < N1) { UT0(); unit_hy_conv(F, l, 0, u - N0); UT1(1); }
                else if (u < N2) { if (!(l == DEPTH - 1 && u - N1 >= 1024)) { UT0(); unit_attn(F, l, u - N1); UT1(0); } }
                else if (l < DEPTH - 1) unit_hy_ctx(F, l, u - N2); }
        }
        SEAM(pb + 3);
        if (ON(4) && IN(pb + 4)) for (int rep = 0; rep < REP_M3; ++rep) { FRESH();
            constexpr int N0 = 256, N1 = N0 + 256;
            for (int u_ = F.bid;; u_ += F.G) { __syncthreads(); const int u = STATIC_Q ? u_ : wq_next(F, l * 4 + 2); if (u >= N1) break;
                if (u < N0) { UT0(); unit_hy_conv(F, l, 1, u); UT1(2); }
                else { UT0(); unit_s5<1>(F, l, u - N0); UT1(3); } }
            for (;;) { const int u = wq_next(F, 16 + l); if (u >= 768) break; unit_wconv(F, l, u); }
        }
        SEAM(pb + 4);
        if (ON(5) && IN(pb + 5)) for (int rep = 0; rep < REP_MIX; ++rep) { FRESH(); for (;;) { const int u = wq_next(F, l * 4 + 3) + ((l == DEPTH - 1) ? NCTX / 32 : 0); if (u >= NTOK / 32) break; unit_mixfinal(F, l, u); } }
        SEAM(pb + 5);
        if (ON(6) && IN(pb + 6)) { FRESH();
            const int roff = (l == DEPTH - 1) ? NCTX : 0;
            SchedStd8 S; S.so.init(NTOK - roff, D, F.G, F.bid); S.row_off = roff; S.A = (const GAS char*)(F.ws + WS_U + U_MIXN); S.Bt = (const GAS char*)(F.ws + WS_WOUT) + (size_t)l * D * D;
            EpiOut E{(GAS bf16*)(F.ws + WS_U + U_DELTA), (const GAS float*)(F.ws + WS_MOD) + (size_t)l * 9 * 6144};
            pg8::gemm_phase<EpiOut, SchedStd8>(F.lds, S, E, F.tid);
            TAIL_WCONV(((NTOK - roff) / 256) * (D / 256));
        }
        SEAM(pb + 6);
        if (ON(7) && IN(pb + 7)) { FRESH(); ph_norm2_router(F, l); }
        SEAM(pb + 7);
        if (ON(8) && IN(pb + 8)) { }
        if (ON(9) && IN(pb + 9)) for (int rep = 0; rep < REP_UP; ++rep) { FRESH();
            volatile LAS int* tab = (volatile LAS int*)(F.lds + LDS_BYTES - 512);
            moe_tables(F, l, tab);
            {
              const GAS unsigned* ELIST = (const GAS unsigned*)(F.ws + WS_ELIST); LAS unsigned* gt = (LAS unsigned*)(F.lds + pg8::GATHER_TAB);
              const int total = tab[16] * 8;
              for (int it = F.tid; it < 16 * 256; it += 512) { const int k = it >> 8, r = it & 255, L = k * F.G + F.bid;
                  if (L < total) { const int mg = L >> 3; int e = 0; for (int q = 1; q < 16; ++q) e += (mg >= tab[q]) ? 1 : 0; const int pos = 256 * (mg - tab[e]) + r;
                      gt[it] = pos < tab[32 + e] ? (ELIST[(size_t)e * ECAP + pos] >> 1) * 1024u : 0u; } }
              __syncthreads(); }
            SchedMoe<0> S; S.tab = tab; S.G = F.G; S.c = F.bid; S.A = (const GAS char*)(F.ws + WS_H); S.W0 = (const GAS char*)(F.ws + wmoe_off(l)); S.W1 = (const GAS char*)(F.ws + wmoe_off(l) + 32 * MiB);
            EpiUp E{(GAS unsigned char*)(F.ws + WS_U + U_ACT)};
            pg8::gemm_phase<EpiUp, SchedMoe<0>>(F.lds, S, E, F.tid);
            TAIL_WCONV(tab[16] * 8);
        }
        SEAM(pb + 9);
        if (ON(10) && IN(pb + 10)) for (int rep = 0; rep < REP_DOWN; ++rep) { FRESH();
            volatile LAS int* tab = (volatile LAS int*)(F.lds + LDS_BYTES - 512);
            moe_tables(F, l, tab);
            SchedMoe<1> S; S.tab = tab; S.G = F.G; S.c = F.bid; S.A = (const GAS char*)(F.ws + WS_U + U_ACT); S.W0 = (const GAS char*)(F.ws + wmoe_off(l) + 64 * MiB); S.W1 = nullptr;
            EpiDown E{(GAS bf16*)(F.ws + WS_U + U_YB), (const GAS unsigned*)(F.ws + WS_ELIST), (const GAS float*)(F.ws + WS_WLIST)};
            pg8::gemm_phase<EpiDown, SchedMoe<1>>(F.lds, S, E, F.tid);
            TAIL_WCONV(tab[16] * 4);
        }
        SEAM(pb + 10);
        }
    if (ON(13) && IN(PH_FINAL)) { FRESH(); ph_norm1(F, DEPTH); }
#if PROBE_STAMPS && MK_ONE_LAUNCH
    xcd_barrier(bar); STAMP(PH_FINAL + 1);
    if (F.bid == 0 && F.tid == 0) {
        const GAS unsigned long long* st = (const GAS unsigned long long*)(F.ctl + 80000);
        const int sel = SEL1; unsigned long long t = 0;
        if (sel < 11) { for (int l = 0; l < DEPTH; ++l) { const int k = PH_L0 + PH_PER_LAYER * l + sel; t += st[k + 1] - st[k]; } }
        else if (sel == 100) t = st[2] - st[0]; else if (sel >= 200) t = st[100 + (sel - 200)]; else t = st[PH_FINAL + 1] - st[PH_FINAL];
        const unsigned long long t0 = __builtin_amdgcn_s_memrealtime();
        while (__builtin_amdgcn_s_memrealtime() - t0 < 8ull * t) __builtin_amdgcn_s_sleep(8);
    }
#endif
}

extern "C" void kernel_launch(void* const* d_in, const int* in_sizes, int n_in, void* d_out, int out_size, void* d_ws, size_t ws_size, hipStream_t stream) {
    static int grid = 0;
    if (grid == 0) {
        if (n_in != 38 || out_size != NLAT * D || ws_size < WS_END) { fprintf(stderr, "kernel_launch: unexpected shapes: n_in %d out %d ws %zu (need %zu)\n", n_in, out_size, ws_size, (size_t)WS_END); grid = -1; return; }
        int dev = 0, cus = 0, per_cu = 0;
        if (hipGetDevice(&dev) != hipSuccess || hipDeviceGetAttribute(&cus, hipDeviceAttributeMultiprocessorCount, dev) != hipSuccess) { grid = -1; return; }
        if (hipFuncSetAttribute((const void*)fwd_kernel, hipFuncAttributeMaxDynamicSharedMemorySize, LDS_BYTES) != hipSuccess) { fprintf(stderr, "kernel_launch: hipFuncSetAttribute failed\n"); grid = -1; return; }
        if (hipOccupancyMaxActiveBlocksPerMultiprocessor(&per_cu, (const void*)fwd_kernel, 512, LDS_BYTES) != hipSuccess || per_cu < 1) fprintf(stderr, "kernel_launch: occupancy query reports %d per CU\n", per_cu);
        grid = cus > 0 ? cus : 256;
    }
    if (grid < 0) return;
    (void)in_sizes;
    hipMemsetAsync((char*)d_ws + WS_CTL, 0, CTL_BYTES, stream);
    Params p{};
    for (int i = 0; i < 38; ++i) p.in[i] = (const GAS float*)d_in[i];
    p.out = (GAS float*)d_out; p.ws = (GAS unsigned char*)d_ws;
#if MK_ONE_LAUNCH
    p.ph_lo = 0; p.ph_hi = NPH;
    hipLaunchKernelGGL(fwd_kernel, dim3(grid), dim3(512), LDS_BYTES, stream, p);
#else
    for (int k = 0; k < NPH; ++k) { p.ph_lo = k; p.ph_hi = k + 1; hipLaunchKernelGGL(fwd_kernel, dim3(grid), dim3(512), LDS_BYTES, stream, p); }
#endif
}
```
